# Optimizing an MI355X kernel written in HIP

```python
import jax, jax.numpy as jnp
from jax import lax
import numpy as np

D_MODEL = 1024
BATCH = 8
SEQ = 4096
DEPTH = 1

CHUNK = 64
PLE_DIM = 256
D_FF = 2816
MLSTM_HEADS = 4
MLSTM_DQK = 64
MLSTM_DV = 128
CONV_WIDTH = 4
FOX_HEADS = 8
FOX_DH = 64
Q_BLOCK = 128
EPS = 1e-6

MLSTM_QK = MLSTM_HEADS * MLSTM_DQK
MLSTM_V = MLSTM_HEADS * MLSTM_DV
FOX_W = FOX_HEADS * FOX_DH
IN_SPLITS = (2 * MLSTM_QK, MLSTM_V, MLSTM_V, MLSTM_HEADS, MLSTM_HEADS,
             FOX_W, FOX_W, FOX_W, FOX_HEADS, D_MODEL, D_MODEL)
IN_WIDTH = sum(IN_SPLITS)
IN_OFFSETS = tuple(sum(IN_SPLITS[:i + 1]) for i in range(len(IN_SPLITS) - 1))

kernel_name = "hybrid_mlstm_fox_macaron_block"


def rms_norm(x, g):
    xf = x.astype(jnp.float32)
    y = xf * lax.rsqrt(jnp.mean(xf * xf, axis=-1, keepdims=True) + EPS)
    return (y * g.astype(jnp.float32)).astype(x.dtype)


def swiglu(x, w_gate, w_up, w_down):
    return (jax.nn.silu(x @ w_gate) * (x @ w_up)) @ w_down


def causal_conv(x, w, b):
    k_w = w.shape[0]
    s = x.shape[1]
    xp = jnp.pad(x, ((0, 0), (k_w - 1, 0), (0, 0)))
    return b + sum(w[j] * xp[:, j:j + s] for j in range(k_w))


def mlstm_chunkwise(q, k, v, i_pre, f_pre):
    b_, s_, n_h, d_k = q.shape
    d_v = v.shape[-1]
    nc = s_ // CHUNK

    def to_chunks(t):
        t = t.astype(jnp.float32).reshape((b_, nc, CHUNK) + t.shape[2:])
        return jnp.moveaxis(t, (1, 3), (0, 2))

    qc, kc, vc = to_chunks(q), to_chunks(k), to_chunks(v)
    ic = to_chunks(i_pre)
    fc = jax.nn.log_sigmoid(to_chunks(f_pre))
    tri = jnp.tril(jnp.ones((CHUNK, CHUNK), dtype=bool))

    def step(carry, xs):
        c_st, n_st, m_st = carry
        qq, kk, vv, ig, lf = xs
        bcum = jnp.cumsum(lf, axis=-1)
        log_d = bcum[..., :, None] - bcum[..., None, :] + ig[..., None, :]
        log_d = jnp.where(tri, log_d, -jnp.inf)
        log_inter = bcum + m_st[..., None]
        m_t = jnp.maximum(log_inter, jnp.max(log_d, axis=-1))
        dmat = jnp.exp(log_d - m_t[..., None])
        inter = jnp.exp(log_inter - m_t)
        sc = jnp.einsum('bhtd,bhsd->bhts', qq, kk) * dmat
        num = jnp.einsum('bhts,bhsv->bhtv', sc, vv) + inter[..., None] * jnp.einsum('bhtd,bhdv->bhtv', qq, c_st)
        den = jnp.sum(sc, axis=-1) + inter * jnp.einsum('bhtd,bhd->bht', qq, n_st)
        h = num / jnp.maximum(jnp.abs(den), jnp.exp(-m_t))[..., None]
        b_last = bcum[..., -1]
        log_w = b_last[..., None] - bcum + ig
        m_new = jnp.maximum(b_last + m_st, jnp.max(log_w, axis=-1))
        w = jnp.exp(log_w - m_new[..., None])
        decay = jnp.exp(b_last + m_st - m_new)
        c_new = decay[..., None, None] * c_st + jnp.einsum('bhs,bhsd,bhsv->bhdv', w, kk, vv)
        n_new = decay[..., None] * n_st + jnp.einsum('bhs,bhsd->bhd', w, kk)
        return (c_new, n_new, m_new), h

    init = (jnp.zeros((b_, n_h, d_k, d_v), jnp.float32),
            jnp.zeros((b_, n_h, d_k), jnp.float32),
            jnp.zeros((b_, n_h), jnp.float32))
    _, hs = lax.scan(step, init, (qc, kc, vc, ic, fc))
    return jnp.moveaxis(hs, (0, 2), (1, 3)).reshape(b_, s_, n_h, d_v)


def forgetting_attention(q, k, v, f_pre):
    b_, s_, n_h, d_h = q.shape
    nb = s_ // Q_BLOCK
    qf = q.astype(jnp.float32) * (d_h ** -0.5)
    kf = k.astype(jnp.float32)
    vf = v.astype(jnp.float32)
    c = jnp.cumsum(jax.nn.log_sigmoid(f_pre.astype(jnp.float32)), axis=1)
    c_t = jnp.transpose(c, (0, 2, 1))
    qb = jnp.moveaxis(qf.reshape(b_, nb, Q_BLOCK, n_h, d_h), 1, 0)
    cb = jnp.moveaxis(c_t.reshape(b_, n_h, nb, Q_BLOCK), 2, 0)
    qpos = jnp.arange(s_, dtype=jnp.int32).reshape(nb, Q_BLOCK)
    kpos = jnp.arange(s_, dtype=jnp.int32)

    def block(args):
        qblk, cblk, pq = args
        logits = jnp.einsum('bqhd,bkhd->bhqk', qblk, kf)
        logits = logits + cblk[..., None] - c_t[:, :, None, :]
        logits = jnp.where(pq[:, None] >= kpos[None, :], logits, -jnp.inf)
        probs = jax.nn.softmax(logits, axis=-1)
        return jnp.einsum('bhqk,bkhd->bqhd', probs, vf)

    out = lax.map(block, (qb, cb, qpos))
    return jnp.moveaxis(out, 0, 1).reshape(b_, s_, n_h * d_h)


def head_layer_norm(h, g):
    mu = jnp.mean(h, axis=-1, keepdims=True)
    var = jnp.mean(jnp.square(h - mu), axis=-1, keepdims=True)
    hn = (h - mu) * lax.rsqrt(var + EPS)
    return hn.reshape(h.shape[0], h.shape[1], -1) * g.astype(jnp.float32)


def setup_inputs(seed: int = 0) -> dict:
    key = jax.random.key(seed)
    ks = jax.random.split(key, 40)
    f32 = jnp.float32

    def dense(k, fan_in, fan_out):
        return jax.random.normal(k, (DEPTH, fan_in, fan_out), f32) * fan_in ** -0.5

    def gain(k, n):
        return 1.0 + 0.05 * jax.random.normal(k, (DEPTH, n), f32)

    def small(k, shape, s=0.02):
        return s * jax.random.normal(k, shape, f32)

    return {
        "x": jax.random.normal(ks[0], (BATCH, SEQ, D_MODEL), f32),
        "p": jax.random.normal(ks[1], (DEPTH, BATCH, SEQ, PLE_DIM), f32),
        "ffn1_pre_g": gain(ks[2], D_MODEL),
        "ffn1_w_gate": dense(ks[3], D_MODEL, D_FF),
        "ffn1_w_up": dense(ks[4], D_MODEL, D_FF),
        "ffn1_w_down": dense(ks[5], D_FF, D_MODEL),
        "ffn1_post_g": gain(ks[6], D_MODEL),
        "mix_pre_g": gain(ks[7], D_MODEL),
        "w_in": dense(ks[8], D_MODEL, IN_WIDTH),
        "conv_w": 0.5 * jax.random.normal(ks[9], (DEPTH, CONV_WIDTH, 2 * MLSTM_QK), f32),
        "conv_b": small(ks[10], (DEPTH, 2 * MLSTM_QK)),
        "mlstm_i_bias": small(ks[11], (DEPTH, MLSTM_HEADS), 0.1),
        "mlstm_f_bias": jnp.linspace(3.0, 6.0, MLSTM_HEADS, dtype=f32)[None, :] + small(ks[12], (DEPTH, MLSTM_HEADS), 0.1),
        "mlstm_norm_g": gain(ks[13], MLSTM_V),
        "fox_f_bias": jnp.linspace(1.0, 6.0, FOX_HEADS, dtype=f32)[None, :] + small(ks[14], (DEPTH, FOX_HEADS), 0.1),
        "branch_gate_bias": small(ks[15], (DEPTH, 2 * D_MODEL)),
        "w_branch_a": dense(ks[16], MLSTM_V, D_MODEL),
        "w_branch_b": dense(ks[17], FOX_W, D_MODEL),
        "w_out": dense(ks[18], D_MODEL, D_MODEL),
        "mix_post_g": gain(ks[19], D_MODEL),
        "ffn2_pre_g": gain(ks[20], D_MODEL),
        "ffn2_w_gate": dense(ks[21], D_MODEL, D_FF),
        "ffn2_w_up": dense(ks[22], D_MODEL, D_FF),
        "ffn2_w_down": dense(ks[23], D_FF, D_MODEL),
        "ffn2_post_g": gain(ks[24], D_MODEL),
        "ple_pre_g": gain(ks[25], D_MODEL),
        "ple_w_gate": dense(ks[26], D_MODEL, D_MODEL),
        "ple_b_gate": small(ks[27], (DEPTH, D_MODEL)),
        "ple_w_proj": dense(ks[28], PLE_DIM, D_MODEL),
        "ple_post_g": gain(ks[29], D_MODEL),
    }


def reference(x, p, ffn1_pre_g, ffn1_w_gate, ffn1_w_up, ffn1_w_down, ffn1_post_g,
              mix_pre_g, w_in, conv_w, conv_b, mlstm_i_bias, mlstm_f_bias, mlstm_norm_g,
              fox_f_bias, branch_gate_bias, w_branch_a, w_branch_b, w_out, mix_post_g,
              ffn2_pre_g, ffn2_w_gate, ffn2_w_up, ffn2_w_down, ffn2_post_g,
              ple_pre_g, ple_w_gate, ple_b_gate, ple_w_proj, ple_post_g):
    b_, s_, _ = x.shape
    h = x
    for layer in range(DEPTH):
        y = swiglu(rms_norm(h, ffn1_pre_g[layer]), ffn1_w_gate[layer], ffn1_w_up[layer], ffn1_w_down[layer])
        h = h + 0.5 * rms_norm(y, ffn1_post_g[layer])

        u = rms_norm(h, mix_pre_g[layer])
        z = u @ w_in[layer]
        (m_qk, m_v, m_o, m_i, m_f, f_q, f_k, f_v, f_f, g_a, g_b) = jnp.split(z, IN_OFFSETS, axis=-1)

        m_qk = jax.nn.silu(causal_conv(m_qk, conv_w[layer], conv_b[layer]))
        m_q, m_k = jnp.split(m_qk, 2, axis=-1)
        m_q = m_q.reshape(b_, s_, MLSTM_HEADS, MLSTM_DQK)
        m_k = m_k.reshape(b_, s_, MLSTM_HEADS, MLSTM_DQK) * (MLSTM_DQK ** -0.5)
        m_v = m_v.reshape(b_, s_, MLSTM_HEADS, MLSTM_DV)
        hm = mlstm_chunkwise(m_q, m_k, m_v, m_i + mlstm_i_bias[layer], m_f + mlstm_f_bias[layer])
        y_a = (jax.nn.sigmoid(m_o.astype(jnp.float32)) * head_layer_norm(hm, mlstm_norm_g[layer])).astype(x.dtype)

        y_b = forgetting_attention(f_q.reshape(b_, s_, FOX_HEADS, FOX_DH),
                                   f_k.reshape(b_, s_, FOX_HEADS, FOX_DH),
                                   f_v.reshape(b_, s_, FOX_HEADS, FOX_DH),
                                   f_f + fox_f_bias[layer]).astype(x.dtype)

        gate_a = jax.nn.sigmoid(g_a + branch_gate_bias[layer, :D_MODEL])
        gate_b = jax.nn.sigmoid(g_b + branch_gate_bias[layer, D_MODEL:])
        merged = gate_a * (y_a @ w_branch_a[layer]) + gate_b * (y_b @ w_branch_b[layer])
        h = h + rms_norm(merged @ w_out[layer], mix_post_g[layer])

        y = swiglu(rms_norm(h, ffn2_pre_g[layer]), ffn2_w_gate[layer], ffn2_w_up[layer], ffn2_w_down[layer])
        h = h + 0.5 * rms_norm(y, ffn2_post_g[layer])

        gate = jax.nn.sigmoid(rms_norm(h, ple_pre_g[layer]) @ ple_w_gate[layer] + ple_b_gate[layer])
        emb = p[layer] @ ple_w_proj[layer]
        h = h + rms_norm(gate * emb, ple_post_g[layer])
    return h
```

```cpp
#include <hip/hip_runtime.h>
#include <hip/hip_bf16.h>
#include <cstdio>
#include <cstdint>
#include <cmath>
namespace pg8 {
#define PG8_LAS __attribute__((address_space(3)))
typedef unsigned short bf16_t;
typedef short bf16x8 __attribute__((ext_vector_type(8)));
typedef float f32x4 __attribute__((ext_vector_type(4)));
typedef unsigned u32x4 __attribute__((ext_vector_type(4)));
constexpr int BM = 256, BK = 64, HALF = 128, HTB = HALF * BK * 2  , STAGE_BYTES = 8 * HTB, NXCD = 8, WGM = 8;

__host__ __device__ __forceinline__ int lds_byte(int r, int c) { const int st = (r >> 4) * 2 + (c >> 5), rr = r & 15, cc = c & 31, ob = rr * 64 + cc * 2; return st * 1024 + (ob ^ (((ob >> 9) & 1) << 5)); }
__host__ __device__ __forceinline__ void stage_rc(int b, int& R, int& C) { const int st = b / 1024, sb = b % 1024, swz = sb ^ (((sb >> 9) & 1) << 5); R = (st >> 1) * 16 + swz / 64; C = (st & 1) * 32 + (swz % 64) / 2; }
__host__ __device__ __forceinline__ int perm32(int rho) { const int n = rho >> 4, i = rho & 15; return 8 * (i >> 2) + 4 * n + (i & 3); }

struct Unit { int pm, pn; };
struct Gemm { const bf16_t* A; const bf16_t* Bt; int lda, ldb, K; };

struct StaticOrder {
    int nM, nN, nwg, G, c;
    __host__ __device__ void init(int M, int N, int G_, int c_) { nM = M / BM; nN = N / BM; nwg = nM * nN; G = G_; c = c_; }
    __host__ __device__ bool next(int i, Unit& u) const {
        const long L = (long)i * G + c; if (L >= nwg) return false;
        int wgid = (int)L; { const int q = nwg / NXCD, r = nwg % NXCD, xcd = wgid % NXCD, off = wgid / NXCD; wgid = (xcd < r ? xcd * (q + 1) : r * (q + 1) + (xcd - r) * q) + off; }
        const int nig = WGM * nN, gid = wgid / nig, fm = gid * WGM, gsz = (nM - fm) < WGM ? (nM - fm) : WGM;
        u.pm = fm + ((wgid % nig) % gsz); u.pn = (wgid % nig) / gsz; return true;
    }
};

__device__ __forceinline__ unsigned cvt_pk_bf16(float lo, float hi) { unsigned r; asm volatile("v_cvt_pk_bf16_f32 %0, %1, %2" : "=v"(r) : "v"(lo), "v"(hi)); return r; }
__device__ __forceinline__ float bf_lo(unsigned w) { return __uint_as_float(w << 16); }
__device__ __forceinline__ float bf_hi(unsigned w) { return __uint_as_float(w & 0xffff0000u); }
__device__ __forceinline__ float sigmoid_f(float x) { return __builtin_amdgcn_rcpf(1.0f + __builtin_amdgcn_exp2f(-1.4426950408889634f * x)); }

template <class Epi, class Sched, bool ALIGN_EPI = false>
__device__ __forceinline__ void gemm_phase(PG8_LAS unsigned char* lds, const Gemm g, const Sched& S, const Epi& E) {
    const int tid = threadIdx.x, wid = __builtin_amdgcn_readfirstlane(tid >> 6), lane = tid & 63, wr = wid >> 2, wc = wid & 3, fr = lane & 15, fq = lane >> 4;
    const int K = g.K, nt = K / BK;
    unsigned voffA[2], voffB[2];
#pragma unroll
    for (int i = 0; i < 2; ++i) { int R, C; stage_rc(tid * 16 + i * 8192, R, C); const int Rb = Epi::PERM ? ((R & ~31) + perm32(R & 31)) : R;
        voffA[i] = (unsigned)(R * g.lda + C) * 2u; voffB[i] = (unsigned)(Rb * g.ldb + C) * 2u; }
    const size_t kstep = (size_t)(BK * 2);
    const size_t hstepA = (size_t)HALF * g.lda * 2, hstepB = (size_t)HALF * g.ldb * 2;
    const size_t tstepA = 2 * hstepA, tstepB = 2 * hstepB;
    const unsigned ldsw = (unsigned)wid * 1024u;
    const int aoff = lds_byte(wr * 64 + fr, fq * 8), boff = lds_byte(wc * 32 + fr, fq * 8);
#define PG8_SA(b, h) (((b) * 2 + (h)) * HTB)
#define PG8_SB(b, h) ((4 + (b) * 2 + (h)) * HTB)
#define PG8_STAGE(bufoff, gbase, voff) do { _Pragma("unroll") for (int _i = 0; _i < 2; ++_i) \
        __builtin_amdgcn_global_load_lds((const unsigned*)((const char*)(gbase) + (voff)[_i]), (PG8_LAS unsigned*)(lds + (bufoff) + ldsw + _i * 8192), 16, 0, 0); } while (0)
#define PG8_LDA(dst, b, h) do { _Pragma("unroll") for (int m = 0; m < 4; ++m) _Pragma("unroll") for (int k = 0; k < 2; ++k) dst[m][k] = *(const PG8_LAS bf16x8*)(lds + PG8_SA(b, h) + aoff + m * 2048 + k * 1024); } while (0)
#define PG8_LDB(dst, b, h) do { _Pragma("unroll") for (int n = 0; n < 2; ++n) _Pragma("unroll") for (int k = 0; k < 2; ++k) dst[n][k] = *(const PG8_LAS bf16x8*)(lds + PG8_SB(b, h) + boff + n * 2048 + k * 1024); } while (0)
#define PG8_MMA(ai, bj, At, Bt) do { __builtin_amdgcn_s_setprio(1); _Pragma("unroll") for (int m = 0; m < 4; ++m) _Pragma("unroll") for (int n = 0; n < 2; ++n) _Pragma("unroll") for (int k = 0; k < 2; ++k) \
        acc[ai][bj][m][n] = __builtin_amdgcn_mfma_f32_16x16x32_bf16(Bt[n][k], At[m][k], acc[ai][bj][m][n], 0, 0, 0); __builtin_amdgcn_s_setprio(0); } while (0)
#define PG8_WAIT_V(n) asm volatile("s_waitcnt vmcnt(" #n ")" ::: "memory")
#define PG8_WAIT_L(n) asm volatile("s_waitcnt lgkmcnt(" #n ")" ::: "memory")
#define PG8_BAR __builtin_amdgcn_s_barrier()
#define PG8_SCHED __builtin_amdgcn_sched_barrier(0)
    Unit cur, nxt; int ui = 0;
    if (!S.next(0, cur)) return;
    f32x4 acc[2][2][4][2];
#pragma unroll
    for (int a = 0; a < 2; ++a)
#pragma unroll
        for (int b = 0; b < 2; ++b)
#pragma unroll
            for (int m = 0; m < 4; ++m)
#pragma unroll
                for (int n = 0; n < 2; ++n) acc[a][b][m][n] = (f32x4){0.f, 0.f, 0.f, 0.f};
    bf16x8 At[4][2], B0[2][2], B1[2][2];
    const char* cA = (const char*)g.A + (size_t)cur.pm * tstepA; const char* cB = (const char*)g.Bt + (size_t)cur.pn * tstepB;
    PG8_STAGE(PG8_SB(0, 0), cB, voffB); PG8_STAGE(PG8_SB(0, 1), cB + hstepB, voffB); PG8_STAGE(PG8_SA(0, 0), cA, voffA); PG8_STAGE(PG8_SA(0, 1), cA + hstepA, voffA);
    if (wr == 1) PG8_BAR;
    PG8_WAIT_V(2); PG8_BAR;
    PG8_STAGE(PG8_SB(1, 0), cB + kstep, voffB); PG8_STAGE(PG8_SA(1, 0), cA + kstep, voffA); PG8_STAGE(PG8_SB(1, 1), cB + hstepB + kstep, voffB);
    PG8_WAIT_V(6); PG8_BAR;
    for (;;) {
        const bool has_next = S.next(ui + 1, nxt);
        const char* nA = has_next ? (const char*)g.A + (size_t)nxt.pm * tstepA : cA; const char* nB = has_next ? (const char*)g.Bt + (size_t)nxt.pn * tstepB : cB;
        for (int t = 0; t < nt; t += 2) {
            const bool last = (t == nt - 2);
            if constexpr (Epi::MID) { if (t == (nt >> 1)) E.mid(acc, cur, wr, wc, fr, fq); }
            const char* a1 = cA + (size_t)(t + 1) * kstep;
            const char* a2 = last ? nA : cA + (size_t)(t + 2) * kstep; const char* b2 = last ? nB : cB + (size_t)(t + 2) * kstep;
            const char* a3 = a2 + kstep; const char* b3 = b2 + kstep;
            PG8_LDB(B0, 0, 0); PG8_LDB(B1, 0, 1); PG8_SCHED; PG8_LDA(At, 0, 0); PG8_STAGE(PG8_SA(1, 1), a1 + hstepA, voffA);
            PG8_WAIT_V(8); PG8_WAIT_L(0); PG8_BAR; PG8_MMA(0, 0, At, B0); PG8_MMA(0, 1, At, B1); PG8_BAR; PG8_SCHED;
            PG8_LDA(At, 0, 1); PG8_STAGE(PG8_SB(0, 0), b2, voffB); PG8_STAGE(PG8_SB(0, 1), b2 + hstepB, voffB); PG8_STAGE(PG8_SA(0, 0), a2, voffA);
            PG8_WAIT_V(8); PG8_WAIT_L(0); PG8_BAR; PG8_MMA(1, 0, At, B0); PG8_MMA(1, 1, At, B1); PG8_BAR; PG8_SCHED;
            PG8_LDB(B0, 1, 0); PG8_LDB(B1, 1, 1); PG8_SCHED; PG8_LDA(At, 1, 0); PG8_STAGE(PG8_SA(0, 1), a2 + hstepA, voffA);
            PG8_WAIT_V(8); PG8_WAIT_L(0); PG8_BAR; PG8_MMA(0, 0, At, B0); PG8_MMA(0, 1, At, B1); PG8_BAR; PG8_SCHED;
            PG8_LDA(At, 1, 1); PG8_STAGE(PG8_SB(1, 0), b3, voffB); PG8_STAGE(PG8_SB(1, 1), b3 + hstepB, voffB); PG8_STAGE(PG8_SA(1, 0), a3, voffA);
            PG8_WAIT_V(8); PG8_WAIT_L(0); PG8_BAR; PG8_MMA(1, 0, At, B0); PG8_MMA(1, 1, At, B1); PG8_BAR; PG8_SCHED;
        }
        if constexpr (ALIGN_EPI) { if (wr == 0) PG8_BAR; }
        E(acc, cur, wr, wc, fr, fq);
        if (!has_next) break;
#pragma unroll
        for (int a = 0; a < 2; ++a)
#pragma unroll
            for (int b = 0; b < 2; ++b)
#pragma unroll
                for (int m = 0; m < 4; ++m)
#pragma unroll
                    for (int n = 0; n < 2; ++n) acc[a][b][m][n] = (f32x4){0.f, 0.f, 0.f, 0.f};
        cur = nxt; cA = nA; cB = nB; ++ui;
        if constexpr (ALIGN_EPI) { if (wr == 1) PG8_BAR; }
    }
    PG8_WAIT_V(0);
    if constexpr (!ALIGN_EPI) { if (wr == 0) PG8_BAR; }
    PG8_BAR;
#undef PG8_SA
#undef PG8_SB
#undef PG8_STAGE
#undef PG8_LDA
#undef PG8_LDB
#undef PG8_MMA
#undef PG8_WAIT_V
#undef PG8_WAIT_L
#undef PG8_BAR
#undef PG8_SCHED
}
}
namespace pg8 {
struct EpiBf16 {
    static constexpr bool PERM = true, MID = false;
    bf16_t* O; int ldc;
    __device__ __forceinline__ void operator()(const f32x4 (&acc)[2][2][4][2], const Unit& u, int wr, int wc, int fr, int fq) const {
        const int row0 = u.pm * BM + wr * 64 + fr, col0 = u.pn * BM + wc * 32 + 8 * fq;
#pragma unroll
        for (int ai = 0; ai < 2; ++ai)
#pragma unroll
            for (int m = 0; m < 4; ++m) { bf16_t* rowp = O + (size_t)(row0 + ai * HALF + m * 16) * ldc + col0;
#pragma unroll
                for (int bj = 0; bj < 2; ++bj) { const f32x4 v0 = acc[ai][bj][m][0], v1 = acc[ai][bj][m][1];
                    u32x4 w; w.x = cvt_pk_bf16(v0[0], v0[1]); w.y = cvt_pk_bf16(v0[2], v0[3]); w.z = cvt_pk_bf16(v1[0], v1[1]); w.w = cvt_pk_bf16(v1[2], v1[3]);
                    *(u32x4*)(rowp + bj * HALF) = w; } }
    }
};
struct EpiSwiGLU {
    static constexpr bool PERM = true, MID = false;
    bf16_t* O; int ldc;
    __device__ __forceinline__ void operator()(const f32x4 (&acc)[2][2][4][2], const Unit& u, int wr, int wc, int fr, int fq) const {
        const int row0 = u.pm * BM + wr * 64 + fr, col0 = u.pn * HALF + wc * 32 + 8 * fq;
#pragma unroll
        for (int ai = 0; ai < 2; ++ai)
#pragma unroll
            for (int m = 0; m < 4; ++m) { bf16_t* rowp = O + (size_t)(row0 + ai * HALF + m * 16) * ldc + col0;
                float h[8];
#pragma unroll
                for (int n = 0; n < 2; ++n)
#pragma unroll
                    for (int e = 0; e < 4; ++e) { const float gt = acc[ai][0][m][n][e], up = acc[ai][1][m][n][e]; h[n * 4 + e] = gt * sigmoid_f(gt) * up; }
                u32x4 w; w.x = cvt_pk_bf16(h[0], h[1]); w.y = cvt_pk_bf16(h[2], h[3]); w.z = cvt_pk_bf16(h[4], h[5]); w.w = cvt_pk_bf16(h[6], h[7]);
                *(u32x4*)rowp = w; }
    }
};
struct EpiWin {
    static constexpr bool PERM = true, MID = false;
    bf16_t* seg0; bf16_t* ga; bf16_t* gb; float* gates; const float* bgate; const float* ib; const float* fb; const float* xb; float qscale;
    __device__ __forceinline__ void operator()(const f32x4 (&acc)[2][2][4][2], const Unit& u, int wr, int wc, int fr, int fq) const {
        const int pn = u.pn; const int row0 = u.pm * BM + wr * 64 + fr;
        if (pn < 20) {
            bf16_t* dst; int ldc, ccol, op; const float* bias = nullptr;
            if (pn < 12) { const int sg = pn >> 1; dst = seg0 + (size_t)sg * (size_t)(16u << 20); ldc = 512; ccol = (pn & 1) * 256; op = (sg == 2) ? 2 : (sg == 3) ? 1 : 0; }
            else { const int sg = (pn - 12) >> 2; dst = sg ? gb : ga; ldc = 1024; ccol = ((pn - 12) & 3) * 256; op = 2; bias = bgate + sg * 1024 + ccol; }
            const int col0 = ccol + wc * 32 + 8 * fq;
            f32x4 bv[2][2];
#pragma unroll
            for (int bj = 0; bj < 2; ++bj)
#pragma unroll
                for (int n = 0; n < 2; ++n) bv[bj][n] = bias ? *(const f32x4*)(bias + wc * 32 + 8 * fq + bj * HALF + 4 * n) : (f32x4){0.f, 0.f, 0.f, 0.f};
#pragma unroll
            for (int ai = 0; ai < 2; ++ai)
#pragma unroll
                for (int m = 0; m < 4; ++m) { bf16_t* rowp = dst + (size_t)(row0 + ai * HALF + m * 16) * ldc + col0;
#pragma unroll
                    for (int bj = 0; bj < 2; ++bj) { f32x4 v0 = acc[ai][bj][m][0], v1 = acc[ai][bj][m][1];
                        if (op == 1) { v0 = v0 * qscale; v1 = v1 * qscale; }
                        else if (op == 2) { v0 = v0 + bv[bj][0]; v1 = v1 + bv[bj][1];
#pragma unroll
                            for (int e = 0; e < 4; ++e) { v0[e] = sigmoid_f(v0[e]); v1[e] = sigmoid_f(v1[e]); } }
                        u32x4 w; w.x = cvt_pk_bf16(v0[0], v0[1]); w.y = cvt_pk_bf16(v0[2], v0[3]); w.z = cvt_pk_bf16(v1[0], v1[1]); w.w = cvt_pk_bf16(v1[2], v1[3]);
                        *(u32x4*)(rowp + bj * HALF) = w; } }
        } else {
            if (wc == 0 && fq < 2) {
                const float* p0 = fq ? xb : ib; const float* p1 = fq ? xb + 4 : fb; const f32x4 b0 = (f32x4){p0[0], p0[1], p0[2], p0[3]}, b1 = (f32x4){p1[0], p1[1], p1[2], p1[3]};
#pragma unroll
                for (int ai = 0; ai < 2; ++ai)
#pragma unroll
                    for (int m = 0; m < 4; ++m) { float* rowp = gates + (size_t)(row0 + ai * HALF + m * 16) * 16 + 8 * fq;
                        *(f32x4*)rowp = acc[ai][0][m][0] + b0; *(f32x4*)(rowp + 4) = acc[ai][0][m][1] + b1; }
            }
        }
    }
};
struct EpiMerge {
    static constexpr bool PERM = true, MID = true;
    bf16_t* O; const bf16_t* ga; const bf16_t* gb;
    __device__ __forceinline__ void mid(f32x4 (&acc)[2][2][4][2], const Unit& u, int wr, int wc, int fr, int fq) const {
        asm volatile("" : "+v"(fr), "+v"(fq));
        const unsigned base = (unsigned)((u.pm * BM + wr * 64 + fr) * 1024 + u.pn * BM + wc * 32 + 8 * fq) * 2u;
        const char* gab = (const char*)ga; const char* gbb = (const char*)gb;
#pragma unroll
        for (int ai = 0; ai < 2; ++ai)
#pragma unroll
            for (int m = 0; m < 4; ++m) { const unsigned off = base + (unsigned)((ai * HALF + m * 16) * 1024) * 2u;
#pragma unroll
                for (int bj = 0; bj < 2; ++bj) { const u32x4 a = *(const u32x4*)(gab + off + bj * HALF * 2), b = *(const u32x4*)(gbb + off + bj * HALF * 2);
                    f32x4 r0, r1;
                    r0[0] = bf_lo(a.x) * __builtin_amdgcn_rcpf(bf_lo(b.x)); r0[1] = bf_hi(a.x) * __builtin_amdgcn_rcpf(bf_hi(b.x));
                    r0[2] = bf_lo(a.y) * __builtin_amdgcn_rcpf(bf_lo(b.y)); r0[3] = bf_hi(a.y) * __builtin_amdgcn_rcpf(bf_hi(b.y));
                    r1[0] = bf_lo(a.z) * __builtin_amdgcn_rcpf(bf_lo(b.z)); r1[1] = bf_hi(a.z) * __builtin_amdgcn_rcpf(bf_hi(b.z));
                    r1[2] = bf_lo(a.w) * __builtin_amdgcn_rcpf(bf_lo(b.w)); r1[3] = bf_hi(a.w) * __builtin_amdgcn_rcpf(bf_hi(b.w));
                    acc[ai][bj][m][0] = acc[ai][bj][m][0] * r0; acc[ai][bj][m][1] = acc[ai][bj][m][1] * r1; }
                asm volatile("" ::: "memory"); }
    }
    __device__ __forceinline__ void operator()(const f32x4 (&acc)[2][2][4][2], const Unit& u, int wr, int wc, int fr, int fq) const {
        asm volatile("" : "+v"(fr), "+v"(fq));
        const unsigned base = (unsigned)((u.pm * BM + wr * 64 + fr) * 1024 + u.pn * BM + wc * 32 + 8 * fq) * 2u;
        const char* gbb = (const char*)gb; char* Ob = (char*)O;
#pragma unroll
        for (int ai = 0; ai < 2; ++ai)
#pragma unroll
            for (int m = 0; m < 4; ++m) { const unsigned off = base + (unsigned)((ai * HALF + m * 16) * 1024) * 2u;
#pragma unroll
                for (int bj = 0; bj < 2; ++bj) { const u32x4 b = *(const u32x4*)(gbb + off + bj * HALF * 2);
                    const f32x4 v0 = acc[ai][bj][m][0], v1 = acc[ai][bj][m][1];
                    u32x4 w; w.x = cvt_pk_bf16(v0[0] * bf_lo(b.x), v0[1] * bf_hi(b.x)); w.y = cvt_pk_bf16(v0[2] * bf_lo(b.y), v0[3] * bf_hi(b.y));
                    w.z = cvt_pk_bf16(v1[0] * bf_lo(b.z), v1[1] * bf_hi(b.z)); w.w = cvt_pk_bf16(v1[2] * bf_lo(b.w), v1[3] * bf_hi(b.w));
                    *(u32x4*)(Ob + off + bj * HALF * 2) = w; }
                asm volatile("" ::: "memory"); }
    }
};
struct EpiPle {
    static constexpr bool PERM = true, MID = false;
    bf16_t* O; const bf16_t* emb; const float* bias;
    __device__ __forceinline__ void operator()(const f32x4 (&acc)[2][2][4][2], const Unit& u, int wr, int wc, int fr, int fq) const {
        asm volatile("" : "+v"(fr), "+v"(fq));
        const int col0 = u.pn * BM + wc * 32 + 8 * fq;
        const unsigned base = (unsigned)((u.pm * BM + wr * 64 + fr) * 1024 + col0) * 2u;
        const char* eb = (const char*)emb; char* Ob = (char*)O;
        f32x4 bv[2][2];
#pragma unroll
        for (int bj = 0; bj < 2; ++bj)
#pragma unroll
            for (int n = 0; n < 2; ++n) bv[bj][n] = *(const f32x4*)(bias + col0 + bj * HALF + 4 * n);
#pragma unroll
        for (int ai = 0; ai < 2; ++ai)
#pragma unroll
            for (int m = 0; m < 4; ++m) { const unsigned off = base + (unsigned)((ai * HALF + m * 16) * 1024) * 2u;
#pragma unroll
                for (int bj = 0; bj < 2; ++bj) { const u32x4 b = *(const u32x4*)(eb + off + bj * HALF * 2);
                    const f32x4 v0 = acc[ai][bj][m][0] + bv[bj][0], v1 = acc[ai][bj][m][1] + bv[bj][1];
                    u32x4 w; w.x = cvt_pk_bf16(sigmoid_f(v0[0]) * bf_lo(b.x), sigmoid_f(v0[1]) * bf_hi(b.x)); w.y = cvt_pk_bf16(sigmoid_f(v0[2]) * bf_lo(b.y), sigmoid_f(v0[3]) * bf_hi(b.y));
                    w.z = cvt_pk_bf16(sigmoid_f(v1[0]) * bf_lo(b.z), sigmoid_f(v1[1]) * bf_hi(b.z)); w.w = cvt_pk_bf16(sigmoid_f(v1[2]) * bf_lo(b.w), sigmoid_f(v1[3]) * bf_hi(b.w));
                    *(u32x4*)(Ob + off + bj * HALF * 2) = w; }
                asm volatile("" ::: "memory"); }
    }
};
}
namespace fox_body {
#define FLAS __attribute__((address_space(3)))
using bf16=__hip_bfloat16;
using bf16x8=__attribute__((ext_vector_type(8)))short;
using s16x4=__attribute__((ext_vector_type(4)))short;
using f32x16=__attribute__((ext_vector_type(16)))float;
using u32x4=__attribute__((ext_vector_type(4)))unsigned;
constexpr int BATCH=8,NHEAD=8,SEQ=4096,D=64,DM=512,DMO=1024;
constexpr int NW=8,QBLK=32,QB=QBLK*NW,KVBLK=64,NQB=SEQ/QB;
__device__ __forceinline__ int crow(int r,int hi){return (r&3)+8*(r>>2)+4*hi;}
#define SBAR() __builtin_amdgcn_sched_barrier(0)
__device__ __forceinline__ void cmask(f32x16&p0,f32x16&p1,int jb,int qrel,int hi){
  const float NEG=-INFINITY; int kb=64*jb+4*hi;
  #pragma unroll
  for(int r=0;r<16;++r){int kv=kb+(r&3)+8*(r>>2); if(kv>qrel)p0[r]=NEG; if(kv+32>qrel)p1[r]=NEG;}
}

constexpr int NSLOT=3, SLOTB=8192;
constexpr int LDS_K=0, LDS_V=NSLOT*SLOTB, LDS_WS=2*NSLOT*SLOTB, LDS_OST=LDS_WS+NW*64*4, LDS_CS=LDS_OST+NW*4096, LDS_BYTES=LDS_CS+SEQ*4;
constexpr float C2=0.125f*1.4426950408889634f; typedef float f32x4 __attribute__((ext_vector_type(4)));
__device__ __forceinline__ void glds16(const void*gsrc,unsigned lds_dst){unsigned keep;
  asm volatile("s_mov_b32 %0, m0\n\ts_mov_b32 m0, %2\n\ts_nop 0\n\tglobal_load_lds_dwordx4 %1, off\n\ts_mov_b32 m0, %0":"=&s"(keep):"v"(gsrc),"s"(lds_dst):"memory");}
__device__ __forceinline__ float max3f(float a,float b,float c){float r;asm("v_max3_f32 %0, %1, %2, %3":"=v"(r):"v"(a),"v"(b),"v"(c));return r;}
__device__ __forceinline__ float max2f(float a,float b){float r;asm("v_max_f32_e32 %0, %1, %2":"=v"(r):"v"(a),"v"(b));return r;}
__device__ __forceinline__ float fadd_s(float a,float b){float r;asm("v_add_f32_e32 %0, %1, %2":"=v"(r):"v"(a),"v"(b));return r;}
__device__ __forceinline__ float fsub_s(float a,float b){float r;asm("v_sub_f32_e32 %0, %1, %2":"=v"(r):"v"(a),"v"(b));return r;}
typedef float f32x2_t __attribute__((ext_vector_type(2))); typedef __bf16 bf16x2_t __attribute__((ext_vector_type(2)));
__device__ __forceinline__ unsigned cvtpk_s(float lo,float hi){f32x2_t v={lo,hi};bf16x2_t b=__builtin_convertvector(v,bf16x2_t);return __builtin_bit_cast(unsigned,b);}
#define WAIT_BAR(N) asm volatile("s_waitcnt vmcnt(" #N ") lgkmcnt(0)\n\ts_barrier":::"memory")

__device__ __forceinline__ void qkt(f32x16&p0,f32x16&p1,const char*Kslot,const bf16x8*qr,int r32,int hi){
  const char*kb=Kslot+hi*1024+r32*16;
  #pragma unroll
  for(int d0=0;d0<4;++d0){
    const bf16x8 b0=*reinterpret_cast<const bf16x8*>(kb+d0*2048);
    const bf16x8 b1=*reinterpret_cast<const bf16x8*>(kb+d0*2048+512);
    p0=__builtin_amdgcn_mfma_f32_32x32x16_bf16(b0,qr[d0],p0,0,0,0);p1=__builtin_amdgcn_mfma_f32_32x32x16_bf16(b1,qr[d0],p1,0,0,0);}
}
typedef __attribute__((address_space(3))) const char* lds_cptr;
typedef short v4i16_t __attribute__((ext_vector_type(4)));
__device__ __forceinline__ void kload8(bf16x8*kf,lds_cptr kp){
  kf[0]=*(const __attribute__((address_space(3))) bf16x8*)(kp);      kf[1]=*(const __attribute__((address_space(3))) bf16x8*)(kp+512);
  kf[2]=*(const __attribute__((address_space(3))) bf16x8*)(kp+2048); kf[3]=*(const __attribute__((address_space(3))) bf16x8*)(kp+2560);
  kf[4]=*(const __attribute__((address_space(3))) bf16x8*)(kp+4096); kf[5]=*(const __attribute__((address_space(3))) bf16x8*)(kp+4608);
  kf[6]=*(const __attribute__((address_space(3))) bf16x8*)(kp+6144); kf[7]=*(const __attribute__((address_space(3))) bf16x8*)(kp+6656);
}
__device__ __forceinline__ void kload2(bf16x8*kf,lds_cptr kp,int j){ kf[2*j]=*(const __attribute__((address_space(3))) bf16x8*)(kp+j*2048); kf[2*j+1]=*(const __attribute__((address_space(3))) bf16x8*)(kp+j*2048+512); }
__device__ __forceinline__ s16x4 vtr(lds_cptr p){ return __builtin_bit_cast(s16x4,__builtin_amdgcn_ds_read_tr16_b64_v4i16((__attribute__((address_space(3))) v4i16_t*)p)); }
__device__ __forceinline__ float rowmax(const f32x16&p0,const f32x16&p1){
  float a=max3f(p0[0],p0[1],p1[0]),b=max3f(p0[2],p0[3],p1[1]);a=max3f(a,p1[2],p1[3]);
  #pragma unroll
  for(int r=4;r<16;r+=4){a=max3f(a,p0[r],p0[r+1]);b=max3f(b,p0[r+2],p0[r+3]);a=max3f(a,p1[r],p1[r+1]);b=max3f(b,p1[r+2],p1[r+3]);}
  const float m=max2f(a,b);
  auto rr=__builtin_amdgcn_permlane32_swap(__float_as_uint(m),__float_as_uint(m),false,false);
  return max2f(__uint_as_float(rr[0]),__uint_as_float(rr[1]));
}
__device__ __forceinline__ void pv(f32x16*o,int vb,bf16x8 pa0,bf16x8 pa1,bf16x8 pa2,bf16x8 pa3){
  #pragma unroll
  for(int d0=0;d0<2;++d0){s16x4 lo[4],hi[4];
    #pragma unroll
    for(int ks=0;ks<4;++ks){
      asm volatile("ds_read_b64_tr_b16 %0,%1 offset:%c2":"=&v"(lo[ks]):"v"(vb),"i"(d0*4096+ks*1024):"memory");
      asm volatile("ds_read_b64_tr_b16 %0,%1 offset:%c2":"=&v"(hi[ks]):"v"(vb),"i"(d0*4096+ks*1024+512):"memory");}
    asm volatile("s_waitcnt lgkmcnt(0)":::"memory");SBAR();
    #define PK(k) (bf16x8){lo[k][0],lo[k][1],lo[k][2],lo[k][3],hi[k][0],hi[k][1],hi[k][2],hi[k][3]}
    o[d0]=__builtin_amdgcn_mfma_f32_32x32x16_bf16(pa0,PK(0),o[d0],0,0,0);
    o[d0]=__builtin_amdgcn_mfma_f32_32x32x16_bf16(pa1,PK(1),o[d0],0,0,0);
    o[d0]=__builtin_amdgcn_mfma_f32_32x32x16_bf16(pa2,PK(2),o[d0],0,0,0);
    o[d0]=__builtin_amdgcn_mfma_f32_32x32x16_bf16(pa3,PK(3),o[d0],0,0,0);
    #undef PK
  }
}

#ifndef ATTN_STORE16
#define ATTN_STORE16(p,v) (*(u32x4*)(p)=(v))
#endif
template<int THRL> __device__ __forceinline__ void attn_unit(int b,int h,int qb,const bf16*Q,const bf16*__restrict__ K,const bf16*__restrict__ V,bf16*O,int ocol,const float*cs,char*shm){
  int tid_=threadIdx.x; asm volatile("":"+v"(tid_));
  const int tid=tid_,lane=tid&63,r32=lane&31,hi=lane>>5; const int wid=__builtin_amdgcn_readfirstlane(tid>>6);
  const long rowbase=(long)b*SEQ; const int q0=qb*QB;
  const bf16*Qw=Q+(rowbase+q0+wid*QBLK)*DM+h*D;
  const bf16*Kh=K+rowbase*DM+h*D,*Vh=V+rowbase*DM+h*D;
  const unsigned lds0=(unsigned)(uintptr_t)shm;
  float*wsf=(float*)(shm+LDS_WS)+wid*64;
  const bf16*ksrc=Kh+(long)lane*DM+wid*8;
  const bf16*vsrc=Vh+(long)(16*(wid&3)+(lane>>2))*DM+(wid>>2)*32+(lane&3)*8;
  const unsigned kdst=lds0+LDS_K+wid*1024, vdst=lds0+LDS_V+wid*1024;
  #define DMA_K(t,slot) glds16(ksrc+(long)(t)*KVBLK*DM,(unsigned)__builtin_amdgcn_readfirstlane(kdst+(slot)))
  #define DMA_V(t,slot) glds16(vsrc+(long)(t)*KVBLK*DM,(unsigned)__builtin_amdgcn_readfirstlane(vdst+(slot)))
  const int vb0=(int)(lds0+LDS_V)+((lane>>4)&1)*32+(lane&3)*8+(4*hi+((lane&15)>>2))*64;
  const char*Kbase=shm+LDS_K; bf16x8 kf[8];
  const lds_cptr shm3=(lds_cptr)shm; const lds_cptr kp0=shm3+LDS_K+hi*1024+r32*16; const lds_cptr vp0=shm3+LDS_V+((lane>>4)&1)*32+(lane&3)*8+(4*hi+((lane&15)>>2))*64;
  const int NT=(q0+QB)/KVBLK;
  DMA_K(0,0);DMA_V(0,0);DMA_K(1,SLOTB);
  bf16x8 qr[4];
  #pragma unroll
  for(int d0=0;d0<4;++d0)qr[d0]=*reinterpret_cast<const bf16x8*>(&Qw[(long)r32*DM+d0*16+hi*8]);
  { FLAS float*csw=(FLAS float*)((FLAS char*)shm+LDS_CS); for(int i=tid*4;i<q0+QB;i+=NW*64*4){ const f32x4 v=*(const f32x4*)(cs+i); *(FLAS f32x4*)(csw+i)=v; } }
  const FLAS float*csl=(const FLAS float*)((FLAS char*)shm+LDS_CS)+4*hi;
  float mhat=0.f,l_reg=0.f,nmh=0.f;f32x16 o[2];o[0]=f32x16{};o[1]=f32x16{};
  const int qrel=wid*QBLK+r32;
  #define CMASK(P0,P1,t) do{int jb_=(t)-(NT-4); if(jb_>=0)cmask(P0,P1,jb_,qrel,hi);}while(0)
  #define CINIT(P0,P1,t) do{ const FLAS float*cb_=csl+(t)*64; _Pragma("unroll") for(int g_=0;g_<4;++g_){ const f32x4 b0_=*(const FLAS f32x4*)(cb_+8*g_), b1_=*(const FLAS f32x4*)(cb_+32+8*g_); \
      _Pragma("unroll") for(int e_=0;e_<4;++e_){ P0[4*g_+e_]=nmh-b0_[e_]; P1[4*g_+e_]=nmh-b1_[e_]; } SBAR(); } }while(0)
  bool resc=false;
  #define START(P0,P1) do{ const float rm=rowmax(P0,P1); resc=false; \
    { const float dl=rm; mhat=fadd_s(mhat,dl); \
      _Pragma("unroll") for(int r=0;r<16;++r){P0[r]=fsub_s(P0[r],dl);P1[r]=fsub_s(P1[r],dl);} \
      nmh=-mhat; } \
    _Pragma("unroll") for(int r=0;r<16;++r)P0[r]=__builtin_amdgcn_exp2f(P0[r]); }while(0)
  #define RESC() do{ if(resc){ asm volatile("s_waitcnt lgkmcnt(0)":::"memory"); \
      _Pragma("unroll") for(int d_=0;d_<2;++d_) _Pragma("unroll") for(int r=0;r<16;++r)o[d_][r]*=wsf[crow(r,hi)]; } }while(0)
  f32x16 pA0,pA1,pB0,pB1;
  int sl_prev=0,sl_cur=0,sl_next=SLOTB;
  #define ROT() do{sl_prev=sl_cur;sl_cur=sl_next;sl_next=(sl_next==(NSLOT-1)*SLOTB)?0:sl_next+SLOTB;}while(0)
  DMA_K(2,2*SLOTB);
  WAIT_BAR(3);
  CINIT(pA0,pA1,0); qkt(pA0,pA1,Kbase,qr,r32,hi);asm volatile("s_nop 15\n\ts_nop 7":"+v"(pA0),"+v"(pA1));CMASK(pA0,pA1,0);
  START(pA0,pA1);
  _Pragma("unroll") for(int r=0;r<16;++r)pA1[r]=__builtin_amdgcn_exp2f(pA1[r]);
  WAIT_BAR(0);
  DMA_K(3,0);DMA_V(1,SLOTB);
  ROT();
  kload8(kf,kp0+sl_cur);
  WAIT_BAR(2);
  s16x4 vlo[8],vhi[8]; u32x4 pw0,pw1,pw2,pw3;
  #define PKW(P,B) cvtpk_s(P[B],P[B+1])
  #define PAF(k) __builtin_bit_cast(bf16x8,pw##k)
  #define VFR(i) (bf16x8){vlo[i][0],vlo[i][1],vlo[i][2],vlo[i][3],vhi[i][0],vhi[i][1],vhi[i][2],vhi[i][3]}
  #define PIN(x) asm volatile("":"+v"(x))
  #define MX3(a,b,c) __builtin_fmaxf(__builtin_fmaxf((a),(b)),(c))
  #define GAPA(MF,A0,A1,A2,A3,W0,W1,PW) do{ MF; sacc+=A0; sacc+=A1; sacc+=A2; sacc+=A3; PIN(sacc); W0; W1; PIN(PW); SBAR(); }while(0)
  #define EX(v) __builtin_amdgcn_exp2f(v)
  #define GAPB(MF,X,B) do{ MF; X[B]=EX(X[B]); X[B+1]=EX(X[B+1]); X[B+2]=EX(X[B+2]); X[B+3]=EX(X[B+3]); PIN(X); SBAR(); }while(0)
  #define VRD(i) do{ vlo[i]=vtr(vp_+(((i)>>2)*4096+((i)&3)*1024)); vhi[i]=vtr(vp_+(((i)>>2)*4096+((i)&3)*1024+512)); }while(0)
  #define KRD(G,j) do{ if(G){ kload2(kf,kp0+sl_next,j); SBAR(); } }while(0)
  #define STEP(C0,C1,P0,P1,t,GK,GV,GL) do{ SBAR(); CINIT(C0,C1,t); SBAR(); \
    const lds_cptr vp_=vp0+sl_prev; \
    VRD(0); SBAR(); float sacc=(P0[0]+P0[1]); \
    GAPA(C0=__builtin_amdgcn_mfma_f32_32x32x16_bf16(kf[0],qr[0],C0,0,0,0), P0[2],P0[3],P0[4],P0[5],     pw0[0]=PKW(P0,0), pw0[1]=PKW(P0,2), pw0); \
    VRD(4); SBAR(); GAPA(C1=__builtin_amdgcn_mfma_f32_32x32x16_bf16(kf[1],qr[0],C1,0,0,0), P0[6],P0[7],P0[8],P0[9],     pw0[2]=PKW(P0,4), pw0[3]=PKW(P0,6), pw0); \
    VRD(1); SBAR(); GAPA(C0=__builtin_amdgcn_mfma_f32_32x32x16_bf16(kf[2],qr[1],C0,0,0,0),   P0[10],P0[11],P0[12],P0[13], pw1[0]=PKW(P0,8), pw1[1]=PKW(P0,10), pw1); \
    VRD(5); SBAR(); GAPA(C1=__builtin_amdgcn_mfma_f32_32x32x16_bf16(kf[3],qr[1],C1,0,0,0),   P0[14],P0[15],P1[0],P1[1],   pw1[2]=PKW(P0,12),pw1[3]=PKW(P0,14), pw1); \
    VRD(2); SBAR(); GAPA(C0=__builtin_amdgcn_mfma_f32_32x32x16_bf16(kf[4],qr[2],C0,0,0,0),   P1[2],P1[3],P1[4],P1[5],     pw2[0]=PKW(P1,0), pw2[1]=PKW(P1,2), pw2); \
    VRD(6); SBAR(); GAPA(C1=__builtin_amdgcn_mfma_f32_32x32x16_bf16(kf[5],qr[2],C1,0,0,0),   P1[6],P1[7],P1[8],P1[9],     pw2[2]=PKW(P1,4), pw2[3]=PKW(P1,6), pw2); \
    VRD(3); SBAR(); GAPA(C0=__builtin_amdgcn_mfma_f32_32x32x16_bf16(kf[6],qr[3],C0,0,0,0),   P1[10],P1[11],P1[12],P1[13], pw3[0]=PKW(P1,8), pw3[1]=PKW(P1,10), pw3); \
    VRD(7); SBAR(); GAPA(C1=__builtin_amdgcn_mfma_f32_32x32x16_bf16(kf[7],qr[3],C1,0,0,0),   P1[14],P1[15],0.f,0.f,       pw3[2]=PKW(P1,12),pw3[3]=PKW(P1,14), pw3); \
    l_reg+=sacc; \
    if(GK){DMA_K((t)+3,sl_cur);} if(GV){DMA_V((t)+1,sl_next);} \
    CMASK(C0,C1,t); \
    { float a=MX3(C0[0],C0[1],C1[0]),b=MX3(C0[2],C0[3],C1[1]); a=MX3(a,C1[2],C1[3]); \
      _Pragma("unroll") for(int r=4;r<16;r+=4){a=MX3(a,C0[r],C0[r+1]);b=MX3(b,C0[r+2],C0[r+3]);a=MX3(a,C1[r],C1[r+1]);b=MX3(b,C1[r+2],C1[r+3]);} \
      float rm=__builtin_fmaxf(a,b); { auto rr=__builtin_amdgcn_permlane32_swap(__float_as_uint(rm),__float_as_uint(rm),false,false); rm=__builtin_fmaxf(__uint_as_float(rr[0]),__uint_as_float(rr[1])); } \
      resc=false; \
      if(__builtin_expect(__any(rm>(float)THRL),0)){ const float dl=__builtin_fmaxf(rm,0.f); mhat+=dl; \
        _Pragma("unroll") for(int r=0;r<16;++r){C0[r]-=dl;C1[r]-=dl;} \
        nmh=-mhat; \
        const float f=__builtin_amdgcn_exp2f(-dl); l_reg*=f; if(hi==0)wsf[r32]=f; resc=true; } } \
    SBAR(); \
    GAPB(o[0]=__builtin_amdgcn_mfma_f32_32x32x16_bf16(PAF(0),VFR(0),o[0],0,0,0), C0,0); \
    GAPB(o[1]=__builtin_amdgcn_mfma_f32_32x32x16_bf16(PAF(0),VFR(4),o[1],0,0,0), C0,4); \
    KRD(GL,0); GAPB(o[0]=__builtin_amdgcn_mfma_f32_32x32x16_bf16(PAF(1),VFR(1),o[0],0,0,0), C0,8); \
    KRD(GL,1); GAPB(o[1]=__builtin_amdgcn_mfma_f32_32x32x16_bf16(PAF(1),VFR(5),o[1],0,0,0), C0,12); \
    KRD(GL,2); GAPB(o[0]=__builtin_amdgcn_mfma_f32_32x32x16_bf16(PAF(2),VFR(2),o[0],0,0,0), C1,0); \
    KRD(GL,3); GAPB(o[1]=__builtin_amdgcn_mfma_f32_32x32x16_bf16(PAF(2),VFR(6),o[1],0,0,0), C1,4); \
    GAPB(o[0]=__builtin_amdgcn_mfma_f32_32x32x16_bf16(PAF(3),VFR(3),o[0],0,0,0), C1,8); \
    GAPB(o[1]=__builtin_amdgcn_mfma_f32_32x32x16_bf16(PAF(3),VFR(7),o[1],0,0,0), C1,12); \
    }while(0)
  int t=1;
  #undef CMASK
  #define CMASK(P0,P1,t) do{}while(0)
  for(;t+5<NT;t+=2){
    STEP(pB0,pB1,pA0,pA1,t,true,true,true);     WAIT_BAR(2); RESC(); ROT();
    STEP(pA0,pA1,pB0,pB1,t+1,true,true,true);   WAIT_BAR(2); RESC(); ROT();
  }
  #undef CMASK
  #define CMASK(P0,P1,t) do{int jb_=(t)-(NT-4); if(jb_>=0)cmask(P0,P1,jb_,qrel,hi);}while(0)
  #define ENDW(tt) do{ if((tt)+3<NT){WAIT_BAR(2);} else if((tt)+2<NT){WAIT_BAR(1);} else {WAIT_BAR(0);} }while(0)
  for(;t+1<NT;t+=2){
    STEP(pB0,pB1,pA0,pA1,t,(t+3<NT),(t+1<NT),(t+1<NT));       ENDW(t);   RESC(); ROT();
    STEP(pA0,pA1,pB0,pB1,t+1,(t+4<NT),(t+2<NT),(t+2<NT));     ENDW(t+1); RESC(); ROT();
  }
  STEP(pB0,pB1,pA0,pA1,NT-1,false,false,false); RESC();
  { float sacc=pB0[0]+pB0[1]; _Pragma("unroll") for(int r=2;r<16;++r)sacc+=pB0[r]; _Pragma("unroll") for(int r=0;r<16;++r)sacc+=pB1[r]; l_reg+=sacc;
    pw0=(u32x4){PKW(pB0,0),PKW(pB0,2),PKW(pB0,4),PKW(pB0,6)};pw1=(u32x4){PKW(pB0,8),PKW(pB0,10),PKW(pB0,12),PKW(pB0,14)};pw2=(u32x4){PKW(pB1,0),PKW(pB1,2),PKW(pB1,4),PKW(pB1,6)};pw3=(u32x4){PKW(pB1,8),PKW(pB1,10),PKW(pB1,12),PKW(pB1,14)};
    SBAR(); pv(o,vb0+sl_cur,PAF(0),PAF(1),PAF(2),PAF(3)); }
  #undef PKW
  #undef PAF
  #undef VFR
  #undef PIN
  #undef MX3
  #undef GAPA
  #undef GAPB
  #undef EX
  #undef VRD
  #undef KRD
  #undef STEP
  #undef ENDW
  {auto rr=__builtin_amdgcn_permlane32_swap(__float_as_uint(l_reg),__float_as_uint(l_reg),false,false);l_reg=__uint_as_float(rr[0])+__uint_as_float(rr[1]);}
  if(hi==0)wsf[32+r32]=l_reg;asm volatile("s_waitcnt lgkmcnt(0)":::"memory");
  float rli[16];
  #pragma unroll
  for(int r=0;r<16;++r)rli[r]=__builtin_amdgcn_rcpf(wsf[32+crow(r,hi)]);
  bf16*Ow=O+(rowbase+q0+wid*QBLK)*DMO+ocol;
  { bf16*stg=(bf16*)(shm+LDS_OST)+wid*2048;
    #pragma unroll
    for(int r=0;r<16;++r){const int orow=crow(r,hi);
      #pragma unroll
      for(int d0=0;d0<2;++d0)stg[orow*64+d0*32+r32]=__float2bfloat16(o[d0][r]*rli[r]);}
    asm volatile("s_waitcnt lgkmcnt(0)":::"memory");
    #pragma unroll
    for(int i=0;i<4;++i){const int row=i*8+(lane>>3),ch=lane&7; const u32x4 v=*(const u32x4*)(stg+row*64+ch*8); ATTN_STORE16(Ow+(long)row*DMO+ch*8,v);} }
  asm volatile("s_waitcnt lgkmcnt(0)\n\ts_barrier":::"memory");
  #undef DMA_K
  #undef DMA_V
  #undef CMASK
  #undef CINIT
  #undef START
  #undef RESC
  #undef ROT
}
constexpr int ATTN_LDS_BYTES=LDS_BYTES;
#undef SBAR
#undef WAIT_BAR
#undef FLAS
}
constexpr int NWAVES = 8;
constexpr int BATCH = 8, SEQ = 4096, DM = 1024, DFF = 2816, TOK = BATCH * SEQ;
constexpr int NWIN = 5376;
constexpr int MH = 4, MDK = 64, MDV = 128, FH = 8, FD = 64, CH = 64, NCH = SEQ / CH;
constexpr float EPS = 1e-6f;
constexpr float LOG2E = 1.4426950408889634f;
constexpr float QC2 = 0.125f * LOG2E;

constexpr size_t MiB = 1u << 20;
constexpr size_t WS_CTL = 0, CTL_ZERO_BYTES = 1 * MiB;
constexpr size_t WS_W1GU = 2 * MiB;
constexpr size_t WS_W1D = 13 * MiB;
constexpr size_t WS_W2GU = 19 * MiB;
constexpr size_t WS_W2D = 30 * MiB;
constexpr size_t WS_WIN = 36 * MiB;
constexpr size_t WS_WAB = 47 * MiB;
constexpr size_t WS_WOUT = 49 * MiB;
constexpr size_t WS_WPG = 51 * MiB;
constexpr size_t WS_WPP = 53 * MiB;
constexpr size_t WS_GATES = 54 * MiB;
constexpr size_t WS_MA = 56 * MiB;
constexpr size_t WS_MB = 56 * MiB + 512 * 1024;
constexpr size_t WS_MSC = 57 * MiB;
constexpr size_t WS_MDN = 57 * MiB + 256 * 1024;
constexpr size_t WS_FCS = 58 * MiB;
constexpr size_t WS_FCT = 59 * MiB;
constexpr size_t WS_XN = 64 * MiB;
constexpr size_t WS_Y = 128 * MiB;
constexpr size_t WS_R = 192 * MiB;
constexpr size_t WS_H = WS_R;
constexpr size_t WS_PB = WS_R + 176 * MiB;
constexpr size_t WS_EMB = WS_R + 192 * MiB;
constexpr size_t WS_SEG0 = WS_R;
constexpr size_t WS_GA = WS_R + 192 * MiB, WS_GB = WS_R + 256 * MiB;
constexpr size_t WS_QK = WS_Y;
constexpr size_t WS_CST = WS_Y + 32 * MiB;
constexpr size_t WS_END = 512 * MiB;
constexpr int CW_TMO = 0, CW_CODE = 1, CW_DBG = 64, CW_BAR = 4096;

constexpr int RING_OFF = 0, RING_BYTES = 131072;
constexpr int LDSCTL_OFF = RING_BYTES, MISC_OFF = LDSCTL_OFF + 320;
constexpr int LDS_BYTES = 147456;

#define GAS __attribute__((address_space(1)))
#define LAS __attribute__((address_space(3)))
typedef unsigned short bf16;
typedef unsigned v4u __attribute__((ext_vector_type(4)));
typedef unsigned v2u __attribute__((ext_vector_type(2)));
typedef float f32x4 __attribute__((ext_vector_type(4)));
typedef short bf16x8 __attribute__((ext_vector_type(8)));
typedef GAS unsigned gu32;
#define RLX_AGENT __ATOMIC_RELAXED, __HIP_MEMORY_SCOPE_AGENT
#define LDS_WAIT() asm volatile("s_waitcnt lgkmcnt(0)" ::: "memory")
#define VM_WAIT() asm volatile("s_waitcnt vmcnt(0)" ::: "memory")
__device__ __forceinline__ unsigned f2bf(float f) { unsigned u = __builtin_bit_cast(unsigned, f); return (u + 0x7fffu + ((u >> 16) & 1u)) >> 16; }
__device__ __forceinline__ unsigned pk2(float lo, float hi) { return f2bf(lo) | (f2bf(hi) << 16); }
__device__ __forceinline__ float bf2f(unsigned short h) { return __uint_as_float(((unsigned)h) << 16); }

#define XB_TMO      128
#define XB_XCNT(j)  (256  + 64 * (j))
#define XB_XSUB(j)  (1280 + 64 * (j))
#define XB_XGEN(j)  (2304 + 64 * (j))
#define XB_TOP      3328
#define XB_TOPGEN   3392
#define XCD_BAR_WORDS 3456
#define XB_SPIN_CAP (1u << 20)
__device__ __forceinline__ unsigned xb_ld(unsigned* p)              { return __hip_atomic_load(p, __ATOMIC_RELAXED, __HIP_MEMORY_SCOPE_AGENT); }
__device__ __forceinline__ unsigned xb_add(unsigned* p, unsigned v) { return __hip_atomic_fetch_add(p, v, __ATOMIC_RELAXED, __HIP_MEMORY_SCOPE_AGENT); }
__device__ __forceinline__ unsigned xb_xcc_id() { return (unsigned)__builtin_amdgcn_s_getreg((3 << 11) | 20) & 0xFu; }
#define XB_SPIN(cond, bar) do { unsigned _sp = 0; while (cond) { __builtin_amdgcn_s_sleep(1); \
    if ((++_sp & 255u) == 0u) { if (xb_ld(&(bar)[XB_TMO])) break; if (_sp > XB_SPIN_CAP) { atomicAdd(&(bar)[XB_TMO], 1u); break; } } } } while (0)
struct XcdBarrier { unsigned* bar; unsigned x; volatile LAS unsigned* st; };
__device__ __forceinline__ XcdBarrier xcd_barrier_post(unsigned* bar, volatile LAS unsigned* st) {
    XcdBarrier b; b.bar = bar; b.x = xb_xcc_id(); b.st = st;
    if (threadIdx.x == 0) (void)xb_add(&bar[XB_XCNT(b.x)], 1u);
    return b;
}
__device__ __forceinline__ void xcd_barrier_complete(unsigned* bar, unsigned x, unsigned& nloc, unsigned& nx) {
    const unsigned G = gridDim.x * gridDim.y * gridDim.z;
    unsigned sum, cnt, mine, sp = 0u;
    for (;;) {
        sum = 0u; cnt = 0u; mine = 0u;
#pragma unroll
        for (unsigned j = 0; j < 16; ++j) { const unsigned c = xb_ld(&bar[XB_XCNT(j)]); sum += c; cnt += (c > 0u) ? 1u : 0u; mine = (j == x) ? c : mine; }
        if (sum == G) break;
        __builtin_amdgcn_s_sleep(1);
        if ((++sp & 255u) == 0u) { if (xb_ld(&bar[XB_TMO])) break; if (sp > XB_SPIN_CAP) { atomicAdd(&bar[XB_TMO], 1u); break; } }
    }
    nloc = mine > 0u ? mine : 1u; nx = cnt > 0u ? cnt : 1u;
}
__device__ __forceinline__ void xcd_barrier(const XcdBarrier& b) {
    asm volatile("s_waitcnt vmcnt(0)" ::: "memory");
    __syncthreads();
    if (threadIdx.x == 0) {
        unsigned* bar = b.bar;
        __builtin_amdgcn_s_waitcnt(0);
        unsigned nloc = b.st[0], nx = b.st[1];
        if (nloc == 0u) { xcd_barrier_complete(bar, b.x, nloc, nx); b.st[0] = nloc; b.st[1] = nx; }
        const unsigned old = xb_add(&bar[XB_XSUB(b.x)], 1u);
        const unsigned gen = old / nloc;
        if (old + 1u == (gen + 1u) * nloc) {
            __builtin_amdgcn_fence(__ATOMIC_RELEASE, "agent");
            asm volatile("s_waitcnt vmcnt(0)" ::: "memory");
            const unsigned og = xb_add(&bar[XB_TOP], 1u);
            const unsigned tg = og / nx;
            if (og + 1u == (tg + 1u) * nx) xb_add(&bar[XB_TOPGEN], 1u);
            else XB_SPIN(xb_ld(&bar[XB_TOPGEN]) == tg, bar);
            __builtin_amdgcn_fence(__ATOMIC_ACQUIRE, "agent");
            xb_add(&bar[XB_XGEN(b.x)], 1u);
            asm volatile("s_waitcnt vmcnt(0)" ::: "memory");
        } else {
            XB_SPIN(xb_ld(&bar[XB_XGEN(b.x)]) == gen, bar);
            __builtin_amdgcn_fence(__ATOMIC_ACQUIRE, "agent");
            asm volatile("s_waitcnt vmcnt(0)" ::: "memory");
        }
    }
    __syncthreads();
}

struct Args { const float* in[30]; float* out; unsigned char* ws; int ph_lo, ph_hi; };
static_assert(sizeof(Args) == 32 * 8 + 8, "Args has no padding");
struct Frame {
    LAS unsigned char* lds;
    volatile LAS unsigned* MISC;
    gu32* ctl;
    int tid, lane, wave;
    int vcu, G;
    unsigned char* ws;
    const Args* A;
    float* out;
};
__device__ __forceinline__ float wave_sum(float v) {
#pragma unroll
    for (int o = 1; o < 64; o <<= 1) v += __shfl_xor(v, o);
    return v;
}
__device__ __forceinline__ float wave_max(float v) {
#pragma unroll
    for (int o = 1; o < 64; o <<= 1) v = fmaxf(v, __shfl_xor(v, o));
    return v;
}

__device__ __forceinline__ void xpose_item(const float* W, int Nsrc, int k0, int srccol, bf16* WT, int ldd, int drow0, int dcol0, LAS float* scr, int lane) {
#pragma unroll 8
    for (int i = 0; i < 32; ++i) { const int kk = 2 * i + (lane >> 5); scr[kk * 33 + (lane & 31)] = (srccol >= 0) ? W[(size_t)(k0 + kk) * Nsrc + srccol] : 0.f; }
    LDS_WAIT(); asm volatile("" ::: "memory");
    const int c = lane & 7;
#pragma unroll
    for (int j = 0; j < 4; ++j) { const int n = (lane >> 3) + 8 * j; const LAS float* s = scr + (8 * c) * 33 + n;
        v4u o; o.x = pk2(s[0 * 33], s[1 * 33]); o.y = pk2(s[2 * 33], s[3 * 33]); o.z = pk2(s[4 * 33], s[5 * 33]); o.w = pk2(s[6 * 33], s[7 * 33]);
        *(GAS v4u*)(WT + (size_t)(drow0 + n) * ldd + dcol0 + 8 * c) = o; }
    LDS_WAIT(); asm volatile("" ::: "memory");
}
__device__ __forceinline__ void rms_row_to_bf16(int lane, const float* xrow, const float* g, bf16* orow) {
    const GAS f32x4* xr = (const GAS f32x4*)xrow + lane; const GAS f32x4* gr = (const GAS f32x4*)g + lane;
    f32x4 v[4]; float s = 0.f;
#pragma unroll
    for (int j = 0; j < 4; ++j) { v[j] = xr[64 * j]; s += (v[j].x * v[j].x + v[j].y * v[j].y) + (v[j].z * v[j].z + v[j].w * v[j].w); }
    const float r = 1.f / sqrtf(wave_sum(s) * (1.f / DM) + EPS);
    GAS v2u* o8 = (GAS v2u*)orow + lane;
#pragma unroll
    for (int j = 0; j < 4; ++j) { const f32x4 gg = gr[64 * j]; v2u w; w.x = pk2(v[j].x * r * gg.x, v[j].y * r * gg.y); w.y = pk2(v[j].z * r * gg.z, v[j].w * r * gg.w); o8[64 * j] = w; }
}
__device__ __forceinline__ void p0_prologue(Frame& F) {
    LAS float* scr = (LAS float*)(F.lds + RING_OFF + F.wave * 16384);
    const int gw = F.vcu * NWAVES + F.wave, NGW = F.G * NWAVES; const int lane = F.lane, l31 = lane & 31;
    unsigned char* ws = F.ws;
    constexpr int I0 = 2816, I1 = 1408, I4 = 2688, I5 = 256, I6 = 512, I8 = 128;
    constexpr int NITEMS = 2 * (I0 + I1) + I4 + 2 * I5 + 2 * I6 + I8;
    for (int it = gw; it < NITEMS; it += NGW) {
        int r = it;
        if (r < 2 * (I0 + I1)) {
            const int l2 = r >= (I0 + I1); if (l2) r -= (I0 + I1);
            if (r < I0) {
                const int kb = r / 176, g = r % 176, j = g >> 3, sub = g & 7;
                const float* W = l2 ? ((sub >> 2) ? F.A->in[22] : F.A->in[21]) : ((sub >> 2) ? F.A->in[4] : F.A->in[3]);
                xpose_item(W, DFF, 64 * kb, 128 * j + 32 * (sub & 3) + l31, (bf16*)(ws + (l2 ? WS_W2GU : WS_W1GU)), DM, 32 * g, 64 * kb, scr, lane);
            } else { r -= I0;
                const int kb = r / 32, g = r % 32;
                xpose_item(l2 ? F.A->in[23] : F.A->in[5], DM, 64 * kb, 32 * g + l31, (bf16*)(ws + (l2 ? WS_W2D : WS_W1D)), DFF, 32 * g, 64 * kb, scr, lane);
            }
            continue;
        }
        r -= 2 * (I0 + I1);
        if (r < I4) {
            const int kb = r / 168, g = r % 168, r0 = 32 * g; int sc;
            if (r0 < 1536) sc = r0 + l31; else if (r0 < 3072) sc = r0 + 8 + l31; else if (r0 < 5120) sc = r0 + 16 + l31;
            else if (r0 == 5120) sc = (l31 < 8) ? 1536 + l31 : (l31 < 16) ? 3080 + (l31 - 8) : -1; else sc = -1;
            xpose_item(F.A->in[8], 5136, 64 * kb, sc, (bf16*)(ws + WS_WIN), DM, r0, 64 * kb, scr, lane);
            continue;
        }
        r -= I4;
        if (r < 2 * I5) { const int hb = r >= I5; if (hb) r -= I5; const int kb = r / 32, g = r % 32;
            xpose_item(hb ? F.A->in[17] : F.A->in[16], DM, 64 * kb, 32 * g + l31, (bf16*)(ws + WS_WAB), DM, 32 * g, 512 * hb + 64 * kb, scr, lane); continue; }
        r -= 2 * I5;
        if (r < 2 * I6) { const int hb = r >= I6; if (hb) r -= I6; const int kb = r / 32, g = r % 32;
            xpose_item(hb ? F.A->in[26] : F.A->in[18], DM, 64 * kb, 32 * g + l31, (bf16*)(ws + (hb ? WS_WPG : WS_WOUT)), DM, 32 * g, 64 * kb, scr, lane); continue; }
        r -= 2 * I6;
        { const int kb = r / 32, g = r % 32;
            xpose_item(F.A->in[28], DM, 64 * kb, 32 * g + l31, (bf16*)(ws + WS_WPP), 256, 32 * g, 64 * kb, scr, lane); }
    }
    bf16* XN = (bf16*)(ws + WS_XN);
    for (int m = gw; m < TOK; m += NGW) rms_row_to_bf16(lane, F.A->in[0] + (size_t)m * DM, F.A->in[2], XN + (size_t)m * DM);
}

template <bool HAS_XN>
__device__ __forceinline__ void ew_row(int lane, const bf16* yrow, const float* resrow, float* outrow, float coef, const float* gpost, const float* gpre, bf16* xnrow) {
    const GAS v2u* yr = (const GAS v2u*)yrow + lane; const GAS f32x4* rr = (const GAS f32x4*)resrow + lane; const GAS f32x4* gp = (const GAS f32x4*)gpost + lane;
    f32x4 y[4], h[4]; float s = 0.f;
#pragma unroll
    for (int j = 0; j < 4; ++j) { const v2u w = yr[64 * j]; y[j].x = __uint_as_float(w.x << 16); y[j].y = __uint_as_float(w.x & 0xffff0000u); y[j].z = __uint_as_float(w.y << 16); y[j].w = __uint_as_float(w.y & 0xffff0000u);
        h[j] = rr[64 * j]; s += (y[j].x * y[j].x + y[j].y * y[j].y) + (y[j].z * y[j].z + y[j].w * y[j].w); }
    const float r = coef / sqrtf(wave_sum(s) * (1.f / DM) + EPS);
    float s2 = 0.f;
    GAS f32x4* orow = (GAS f32x4*)outrow + lane;
#pragma unroll
    for (int j = 0; j < 4; ++j) { const f32x4 g = gp[64 * j]; h[j] = h[j] + y[j] * r * g; orow[64 * j] = h[j];
        s2 += (h[j].x * h[j].x + h[j].y * h[j].y) + (h[j].z * h[j].z + h[j].w * h[j].w); }
    if constexpr (HAS_XN) {
        const float r2 = 1.f / sqrtf(wave_sum(s2) * (1.f / DM) + EPS);
        const GAS f32x4* gq = (const GAS f32x4*)gpre + lane; GAS v2u* o8 = (GAS v2u*)xnrow + lane;
#pragma unroll
        for (int j = 0; j < 4; ++j) { const f32x4 g = gq[64 * j]; v2u w; w.x = pk2(h[j].x * r2 * g.x, h[j].y * r2 * g.y); w.y = pk2(h[j].z * r2 * g.z, h[j].w * r2 * g.w); o8[64 * j] = w; }
    }
}
template <bool HAS_XN>
__device__ __forceinline__ void ew_phase(Frame& F, const bf16* Y, const float* res, float* out, float coef, const float* gpost, const float* gpre, bf16* XN) {
    const int gw = F.vcu * NWAVES + F.wave, NGW = F.G * NWAVES;
    for (int m = gw; m < TOK; m += NGW) ew_row<HAS_XN>(F.lane, Y + (size_t)m * DM, res + (size_t)m * DM, out + (size_t)m * DM, coef, gpost, gpre, XN + (size_t)m * DM);
}
typedef float f32x16 __attribute__((ext_vector_type(16)));
#define MFMA32(a, b, c) __builtin_amdgcn_mfma_f32_32x32x16_bf16(a, b, c, 0, 0, 0)
__device__ __forceinline__ int crow16(int r, int hi) { return (r & 3) + 8 * (r >> 2) + 4 * hi; }
__device__ __forceinline__ float log_sigmoid_f(float x) { return fminf(x, 0.f) - log1pf(expf(-fabsf(x))); }
__device__ __forceinline__ float wave_incl_scan_add(float v, int lane) {
#pragma unroll
    for (int o = 1; o < 64; o <<= 1) { const float t = __shfl_up(v, o); if (lane >= o) v += t; }
    return v;
}
__device__ __forceinline__ float wave_incl_scan_max(float v, int lane) {
#pragma unroll
    for (int o = 1; o < 64; o <<= 1) { const float t = __shfl_up(v, o); if (lane >= o) v = fmaxf(v, t); }
    return v;
}
__device__ __forceinline__ int swap23(int s) { return (s & ~12) | ((s & 4) << 1) | ((s & 8) >> 1); }
constexpr int LP = 72;

__device__ __forceinline__ void m1_unit(Frame& F, int b, int c, int h) {
    unsigned char* ws = F.ws; LAS unsigned char* L = F.lds;
    const int tid = F.tid, lane = F.lane, wave = F.wave;
    const int tok0 = b * SEQ + c * CH, uidx = (b * MH + h) * NCH + c;
    LAS bf16* LKT = (LAS bf16*)(L);
    LAS bf16* LVT = (LAS bf16*)(L + 64 * LP * 2);
    LAS float* LW = (LAS float*)(L + 64 * LP * 2 + 128 * LP * 2);
    const float* gates = (const float*)(ws + WS_GATES);
    if (wave == 0) {
        const float* gr = gates + (size_t)(tok0 + lane) * 16;
        const float ig = gr[h], lf = log_sigmoid_f(gr[4 + h]);
        const float bs = wave_incl_scan_add(lf, lane), a = ig - bs, amax = wave_max(a);
        ((float*)(ws + WS_MA))[(size_t)(b * MH + h) * SEQ + c * CH + lane] = a;
        ((float*)(ws + WS_MB))[(size_t)(b * MH + h) * SEQ + c * CH + lane] = bs;
        LW[lane] = __expf(a - amax);
        if (lane == 63) { float* sc = (float*)(ws + WS_MSC); sc[uidx] = amax; sc[BATCH * MH * NCH + uidx] = bs; }
    } else if (wave <= 2) {
        const int fh = 2 * h + (wave - 1);
        const float lf = log_sigmoid_f(gates[(size_t)(tok0 + lane) * 16 + 8 + fh]) * LOG2E;
        const float cs = wave_incl_scan_add(lf, lane);
        ((float*)(ws + WS_FCS))[(size_t)(b * FH + fh) * SEQ + c * CH + lane] = cs;
        if (lane == 63) ((float*)(ws + WS_FCT))[(b * FH + fh) * NCH + c] = cs;
    }
    LDS_WAIT(); __syncthreads();
    const int tt = tid >> 3, cg = tid & 7;
    {
        const bf16* mqk = (const bf16*)(ws + WS_SEG0);
        const float* cw = F.A->in[9]; const float* cb = F.A->in[10];
        float q[8], k[8];
#pragma unroll
        for (int part = 0; part < 2; ++part) {
            const int ch0 = part * 256 + 64 * h + 8 * cg;
            float accv[8];
#pragma unroll
            for (int e = 0; e < 8; ++e) accv[e] = cb[ch0 + e];
#pragma unroll
            for (int j = 0; j < 4; ++j) {
                const int ts = c * CH + tt - 3 + j;
                if (ts >= 0) {
                    const v4u w = *(const v4u*)(mqk + (size_t)(b * SEQ + ts) * 512 + ch0);
                    const f32x4 w0 = *(const f32x4*)(cw + j * 512 + ch0), w1 = *(const f32x4*)(cw + j * 512 + ch0 + 4);
                    accv[0] += w0.x * pg8::bf_lo(w.x); accv[1] += w0.y * pg8::bf_hi(w.x); accv[2] += w0.z * pg8::bf_lo(w.y); accv[3] += w0.w * pg8::bf_hi(w.y);
                    accv[4] += w1.x * pg8::bf_lo(w.z); accv[5] += w1.y * pg8::bf_hi(w.z); accv[6] += w1.z * pg8::bf_lo(w.w); accv[7] += w1.w * pg8::bf_hi(w.w);
                }
            }
#pragma unroll
            for (int e = 0; e < 8; ++e) { const float sv = accv[e] * pg8::sigmoid_f(accv[e]); if (part == 0) q[e] = sv; else k[e] = sv * 0.125f; }
        }
        bf16* qk = (bf16*)(ws + WS_QK) + (size_t)(tok0 + tt) * 512;
        v4u wq, wk; wq.x = pk2(q[0], q[1]); wq.y = pk2(q[2], q[3]); wq.z = pk2(q[4], q[5]); wq.w = pk2(q[6], q[7]);
        wk.x = pk2(k[0], k[1]); wk.y = pk2(k[2], k[3]); wk.z = pk2(k[4], k[5]); wk.w = pk2(k[6], k[7]);
        *(v4u*)(qk + 64 * h + 8 * cg) = wq; *(v4u*)(qk + 256 + 64 * h + 8 * cg) = wk;
        const float wgt = LW[tt]; const int pos = swap23(tt);
        const unsigned kw[4] = {wk.x, wk.y, wk.z, wk.w};
#pragma unroll
        for (int e = 0; e < 8; ++e) { const float kv = (e & 1) ? pg8::bf_hi(kw[e >> 1]) : pg8::bf_lo(kw[e >> 1]); LKT[(8 * cg + e) * LP + pos] = (bf16)f2bf(kv * wgt); }
        const bf16* mv = (const bf16*)(ws + WS_SEG0 + 32 * MiB) + (size_t)(tok0 + tt) * 512 + 128 * h + 16 * cg;
        const v4u v0 = *(const v4u*)mv, v1 = *(const v4u*)(mv + 8);
        const unsigned vw[8] = {v0.x, v0.y, v0.z, v0.w, v1.x, v1.y, v1.z, v1.w};
#pragma unroll
        for (int e = 0; e < 16; ++e) LVT[(16 * cg + e) * LP + pos] = (bf16)((e & 1) ? (vw[e >> 1] >> 16) : (vw[e >> 1] & 0xffffu));
    }
    LDS_WAIT(); __syncthreads();
    {
        const int r = lane & 31, hi = lane >> 5, dvt = wave >> 1, dkt = wave & 1;
        f32x16 acc = {};
#pragma unroll
        for (int ks = 0; ks < 4; ++ks) {
            const bf16x8 av = *(const LAS bf16x8*)(LVT + (32 * dvt + r) * LP + 16 * ks + 8 * hi);
            const bf16x8 bk = *(const LAS bf16x8*)(LKT + (32 * dkt + r) * LP + 16 * ks + 8 * hi);
            acc = MFMA32(av, bk, acc);
        }
        bf16* dst = (bf16*)(ws + WS_CST) + (size_t)uidx * (MDV * MDK) + 32 * dkt + r;
#pragma unroll
        for (int rg = 0; rg < 16; ++rg) dst[(size_t)(32 * dvt + crow16(rg, hi)) * MDK] = (bf16)f2bf(acc[rg]);
        if (wave == 0) {
            float s = 0.f;
#pragma unroll
            for (int j = 0; j < 8; ++j) { const v4u w = *(const LAS v4u*)(LKT + lane * LP + 8 * j);
                s += (pg8::bf_lo(w.x) + pg8::bf_hi(w.x)) + (pg8::bf_lo(w.y) + pg8::bf_hi(w.y)) + (pg8::bf_lo(w.z) + pg8::bf_hi(w.z)) + (pg8::bf_lo(w.w) + pg8::bf_hi(w.w)); }
            ((float*)(ws + WS_MDN))[(size_t)uidx * 64 + lane] = s;
        }
    }
    LDS_WAIT(); __syncthreads();
}
__device__ __forceinline__ void m1_phase(Frame& F) {
    for (int u = F.vcu; u < BATCH * NCH * MH; u += F.G) { const int h = u & 3, c = (u >> 2) & 63, b = u >> 8; m1_unit(F, b, c, h); }
}

__device__ __forceinline__ void m2_phase(Frame& F) {
    unsigned char* ws = F.ws; const int tid = F.tid;
    const float* sc = (const float*)(ws + WS_MSC); float* mstv = (float*)(ws + WS_MSC) + 2 * BATCH * MH * NCH;
    for (int job = F.vcu; job < BATCH * MH * 8; job += F.G) {
        const int bh = job >> 3, part = job & 7;
        unsigned* cst = (unsigned*)(ws + WS_CST) + (size_t)bh * NCH * (MDV * MDK / 2) + part * 512 + tid;
        float* dn = (float*)(ws + WS_MDN) + (size_t)bh * NCH * 64 + tid;
        float c0 = 0.f, c1 = 0.f, nn = 0.f, mst = 0.f;
        const bool do_n = (part == 0 && tid < 64), do_m = (part == 1 && tid == 0);
#pragma unroll 4
        for (int c = 0; c < NCH; ++c) {
            const float amax = sc[bh * NCH + c], blast = sc[BATCH * MH * NCH + bh * NCH + c];
            const float mu = fmaxf(mst, amax), d1 = __expf(mst - mu), d2 = __expf(amax - mu);
            if (do_m) mstv[bh * NCH + c] = mst;
            const unsigned w = cst[(size_t)c * (MDV * MDK / 2)];
            c0 = d1 * c0 + d2 * pg8::bf_lo(w); c1 = d1 * c1 + d2 * pg8::bf_hi(w);
            cst[(size_t)c * (MDV * MDK / 2)] = pk2(c0, c1);
            if (do_n) { nn = d1 * nn + d2 * dn[c * 64]; dn[c * 64] = nn; }
            mst = blast + mu;
        }
    }
    const int gw = F.vcu * NWAVES + F.wave;
    if (gw < BATCH * FH) {
        const float tot = ((const float*)(ws + WS_FCT))[gw * NCH + F.lane];
        const float incl = wave_incl_scan_add(tot, F.lane), excl = incl - tot;
        float* cs = (float*)(ws + WS_FCS) + (size_t)gw * SEQ;
        for (int c = 0; c < NCH; ++c) { const float off = __shfl(excl, c); cs[c * CH + F.lane] += off; }
    }
}

__device__ __forceinline__ void m3_unit(Frame& F, int b, int c, int h) {
    unsigned char* ws = F.ws; LAS unsigned char* L = F.lds;
    const int tid = F.tid, lane = F.lane, wave = F.wave;
    const int tok0 = b * SEQ + c * CH, uidx = (b * MH + h) * NCH + c;
    LAS bf16* LQ = (LAS bf16*)(L);
    LAS bf16* LK = (LAS bf16*)(L + 9216);
    LAS bf16* LVT = (LAS bf16*)(L + 18432);
    LAS bf16* LCT = (LAS bf16*)(L + 36864);
    LAS float* LH = (LAS float*)(L + 55296);
    LAS float* LSC = (LAS float*)(L + 89088);
    LAS float* LWS = (LAS float*)(L + 89088 + 2048) + wave * 64;
    const int tt = tid >> 3, cg = tid & 7;
    {
        const bf16* qk = (const bf16*)(ws + WS_QK) + (size_t)(tok0 + tt) * 512;
        *(LAS v4u*)(LQ + tt * LP + 8 * cg) = *(const v4u*)(qk + 64 * h + 8 * cg);
        *(LAS v4u*)(LK + tt * LP + 8 * cg) = *(const v4u*)(qk + 256 + 64 * h + 8 * cg);
        const bf16* mv = (const bf16*)(ws + WS_SEG0 + 32 * MiB) + (size_t)(tok0 + tt) * 512 + 128 * h + 16 * cg;
        const v4u v0 = *(const v4u*)mv, v1 = *(const v4u*)(mv + 8);
        const unsigned vw[8] = {v0.x, v0.y, v0.z, v0.w, v1.x, v1.y, v1.z, v1.w}; const int pos = swap23(tt);
#pragma unroll
        for (int e = 0; e < 16; ++e) LVT[(16 * cg + e) * LP + pos] = (bf16)((e & 1) ? (vw[e >> 1] >> 16) : (vw[e >> 1] & 0xffffu));
        const int dv = tid >> 2, c16 = (tid & 3) * 16;
        v4u s0 = {0u, 0u, 0u, 0u}, s1 = {0u, 0u, 0u, 0u};
        if (c > 0) { const bf16* cp = (const bf16*)(ws + WS_CST) + (size_t)(uidx - 1) * (MDV * MDK) + dv * MDK + c16; s0 = *(const v4u*)cp; s1 = *(const v4u*)(cp + 8); }
        *(LAS v4u*)(LCT + dv * LP + c16) = s0; *(LAS v4u*)(LCT + dv * LP + c16 + 8) = s1;
        if (wave == 0) {
            const float a = ((const float*)(ws + WS_MA))[(size_t)(b * MH + h) * SEQ + c * CH + lane];
            const float bs = ((const float*)(ws + WS_MB))[(size_t)(b * MH + h) * SEQ + c * CH + lane];
            const float mst = ((const float*)(ws + WS_MSC))[2 * BATCH * MH * NCH + uidx];
            const float np = (c > 0) ? ((const float*)(ws + WS_MDN))[(size_t)(uidx - 1) * 64 + lane] : 0.f;
            const float mu = fmaxf(mst, wave_incl_scan_max(a, lane));
            LSC[lane] = a; LSC[64 + lane] = mu; LSC[128 + lane] = __expf(mst - mu); LSC[192 + lane] = __expf(-(bs + mu)); LSC[256 + lane] = np;
        }
    }
    LDS_WAIT(); __syncthreads();
    {
        const int r = lane & 31, hi = lane >> 5, ti = wave >> 2, dvj = wave & 3;
        const int t = 32 * ti + r;
        const float mu_t = LSC[64 + t], inter_t = LSC[128 + t], emt_t = LSC[192 + t];
        float qn = 0.f;
#pragma unroll
        for (int j = 0; j < 4; ++j) { const v4u w = *(const LAS v4u*)(LQ + t * LP + 32 * hi + 8 * j); const f32x4 n0 = *(const LAS f32x4*)(LSC + 256 + 32 * hi + 8 * j), n1 = *(const LAS f32x4*)(LSC + 256 + 32 * hi + 8 * j + 4);
            qn += pg8::bf_lo(w.x) * n0.x + pg8::bf_hi(w.x) * n0.y + pg8::bf_lo(w.y) * n0.z + pg8::bf_hi(w.y) * n0.w + pg8::bf_lo(w.z) * n1.x + pg8::bf_hi(w.z) * n1.y + pg8::bf_lo(w.w) * n1.z + pg8::bf_hi(w.w) * n1.w; }
        qn += __shfl_xor(qn, 32);
        bf16x8 qf[4];
#pragma unroll
        for (int ks = 0; ks < 4; ++ks) qf[ks] = *(const LAS bf16x8*)(LQ + t * LP + 16 * ks + 8 * hi);
        f32x16 z1 = {}, z2 = {}; float den = 0.f;
#pragma unroll
        for (int si = 0; si < 2; ++si) {
            if (si <= ti) {
                f32x16 x = {};
#pragma unroll
                for (int ks = 0; ks < 4; ++ks) { const bf16x8 kf = *(const LAS bf16x8*)(LK + (32 * si + r) * LP + 16 * ks + 8 * hi); x = MFMA32(kf, qf[ks], x); }
#pragma unroll
                for (int g = 0; g < 4; ++g) { const f32x4 av = *(const LAS f32x4*)(LSC + 32 * si + 8 * g + 4 * hi);
#pragma unroll
                    for (int e = 0; e < 4; ++e) { const int s = 32 * si + 8 * g + 4 * hi + e; const float w = (s <= t) ? __expf(fminf(av[e] - mu_t, 0.f)) : 0.f; const float p = x[4 * g + e] * w; x[4 * g + e] = p; den += p; } }
#pragma unroll
                for (int k2 = 0; k2 < 2; ++k2) {
                    v4u pw; pw.x = pk2(x[8 * k2 + 0], x[8 * k2 + 1]); pw.y = pk2(x[8 * k2 + 2], x[8 * k2 + 3]); pw.z = pk2(x[8 * k2 + 4], x[8 * k2 + 5]); pw.w = pk2(x[8 * k2 + 6], x[8 * k2 + 7]);
                    const bf16x8 vf = *(const LAS bf16x8*)(LVT + (32 * dvj + r) * LP + 32 * si + 16 * k2 + 8 * hi);
                    z1 = MFMA32(__builtin_bit_cast(bf16x8, pw), vf, z1);
                }
            }
        }
#pragma unroll
        for (int ks = 0; ks < 4; ++ks) { const bf16x8 cf = *(const LAS bf16x8*)(LCT + (32 * dvj + r) * LP + 16 * ks + 8 * hi); z2 = MFMA32(qf[ks], cf, z2); }
        den += __shfl_xor(den, 32);
        den += inter_t * qn;
        const float rden = 1.0f / fmaxf(fabsf(den), emt_t);
        if (hi == 0) { LWS[r] = inter_t; LWS[32 + r] = rden; }
        LDS_WAIT();
#pragma unroll
        for (int g = 0; g < 4; ++g) { const f32x4 iv = *(const LAS f32x4*)(LWS + 8 * g + 4 * hi), rv = *(const LAS f32x4*)(LWS + 32 + 8 * g + 4 * hi);
#pragma unroll
            for (int e = 0; e < 4; ++e) LH[(32 * ti + 8 * g + 4 * hi + e) * 132 + 32 * dvj + r] = (z1[4 * g + e] + iv[e] * z2[4 * g + e]) * rv[e]; }
    }
    LDS_WAIT(); __syncthreads();
    {
        float v[16]; float s = 0.f;
#pragma unroll
        for (int j = 0; j < 4; ++j) { const f32x4 x = *(const LAS f32x4*)(LH + tt * 132 + 16 * cg + 4 * j); v[4 * j] = x.x; v[4 * j + 1] = x.y; v[4 * j + 2] = x.z; v[4 * j + 3] = x.w; s += (x.x + x.y) + (x.z + x.w); }
        s += __shfl_xor(s, 1); s += __shfl_xor(s, 2); s += __shfl_xor(s, 4);
        const float mean = s * (1.f / MDV); float q = 0.f;
#pragma unroll
        for (int e = 0; e < 16; ++e) { v[e] -= mean; q += v[e] * v[e]; }
        q += __shfl_xor(q, 1); q += __shfl_xor(q, 2); q += __shfl_xor(q, 4);
        const float rstd = 1.0f / sqrtf(q * (1.f / MDV) + EPS);
        const float* gn = F.A->in[13] + 128 * h + 16 * cg;
        const bf16* mo = (const bf16*)(ws + WS_SEG0 + 64 * MiB) + (size_t)(tok0 + tt) * 512 + 128 * h + 16 * cg;
        const v4u o0 = *(const v4u*)mo, o1 = *(const v4u*)(mo + 8);
        const unsigned ow[8] = {o0.x, o0.y, o0.z, o0.w, o1.x, o1.y, o1.z, o1.w};
        unsigned res[8];
#pragma unroll
        for (int e = 0; e < 8; ++e) { const float y0 = v[2 * e] * rstd * gn[2 * e] * pg8::bf_lo(ow[e]), y1 = v[2 * e + 1] * rstd * gn[2 * e + 1] * pg8::bf_hi(ow[e]); res[e] = pk2(y0, y1); }
        bf16* ya = (bf16*)(ws + WS_XN) + (size_t)(tok0 + tt) * 1024 + 128 * h + 16 * cg;
        *(v4u*)ya = (v4u){res[0], res[1], res[2], res[3]}; *(v4u*)(ya + 8) = (v4u){res[4], res[5], res[6], res[7]};
    }
    LDS_WAIT(); __syncthreads();
}
#ifndef MK_N_LAUNCHES
#define MK_N_LAUNCHES 16
#endif
constexpr int NPHASE = 16;

__device__ __forceinline__ void p7_mixer(Frame& F) {
    unsigned char* ws = F.ws;
    const fox_body::bf16* FQ = (const fox_body::bf16*)(ws + WS_SEG0 + 96 * MiB);
    const fox_body::bf16* FK = (const fox_body::bf16*)(ws + WS_SEG0 + 128 * MiB);
    const fox_body::bf16* FV = (const fox_body::bf16*)(ws + WS_SEG0 + 160 * MiB);
    fox_body::bf16* YB = (fox_body::bf16*)(ws + WS_XN);
#ifndef NO_FOX
    for (int job = F.vcu; job < BATCH * FH * 4; job += F.G) {
        const int bh = job >> 2, s = job & 3, b = bh >> 3, fh = bh & 7;
        const float* cs = (const float*)(ws + WS_FCS) + (size_t)bh * SEQ;
#pragma unroll 1
        for (int i = 0; i < 4; ++i) { const int qb = (i == 0) ? s : (i == 1) ? 7 - s : (i == 2) ? 8 + s : 15 - s;
            fox_body::attn_unit<8>(b, fh, qb, FQ, FK, FV, YB, 512 + 64 * fh, cs, (char*)F.lds); }
    }
#endif
    __syncthreads();
#ifndef NO_M3
    for (int u = F.vcu; u < BATCH * NCH * MH; u += F.G) { const int h = u & 3, c = (u >> 2) & 63, b = u >> 8; m3_unit(F, b, c, h); }
#endif
}

__global__ void __launch_bounds__(NWAVES * 64, 2) mega_fwd(Args args) {
    extern __shared__ __attribute__((aligned(16))) unsigned char lds[];
    Frame F;
    F.lds = (LAS unsigned char*)lds;
    F.MISC = (volatile LAS unsigned*)(F.lds + MISC_OFF);
    F.tid = threadIdx.x; F.lane = F.tid & 63; F.wave = __builtin_amdgcn_readfirstlane(F.tid >> 6);
    F.G = gridDim.x; { const int bx = blockIdx.x; F.vcu = (F.G % 8 == 0) ? (bx % 8) * (F.G / 8) + bx / 8 : bx; }
    F.ws = args.ws; F.out = args.out;
    F.A = &args;
    F.ctl = (gu32*)(F.ws + WS_CTL);
    for (int u = F.tid; u < (LDS_BYTES - LDSCTL_OFF) / 4; u += NWAVES * 64) ((LAS unsigned*)(F.lds + LDSCTL_OFF))[u] = 0u;
    __syncthreads();
    const int lo = args.ph_lo, hi = args.ph_hi;
    const bool use_bar = (hi - lo) > 1;
    XcdBarrier bar; bar.bar = (unsigned*)(F.ctl + CW_BAR); bar.x = 0; bar.st = nullptr;
    if (use_bar) bar = xcd_barrier_post((unsigned*)(F.ctl + CW_BAR), F.MISC + 8);
#ifndef PHMASK
#define PHMASK 0xffff
#endif
#define IN(k) (((PHMASK >> (k)) & 1) && lo <= (k) && (k) < hi)
#define SEAM(k) do { if (IN(k) && IN((k) + 1)) xcd_barrier(bar); } while (0)
    unsigned char* ws = F.ws;
    bf16* XN = (bf16*)(ws + WS_XN); bf16* Y = (bf16*)(ws + WS_Y); bf16* H = (bf16*)(ws + WS_H);
    const int cid = (int)blockIdx.x;

    if (IN(0)) { p0_prologue(F); SEAM(0); }
    if (IN(1)) {
        pg8::Gemm g{XN, (const bf16*)(ws + WS_W1GU), DM, DM, DM}; pg8::StaticOrder S; S.init(TOK, 2 * DFF, F.G, cid);
        pg8::EpiSwiGLU E{H, DFF};
        pg8::gemm_phase<pg8::EpiSwiGLU, pg8::StaticOrder, true>(F.lds + RING_OFF, g, S, E); SEAM(1); }
    if (IN(2)) {
        pg8::Gemm g{H, (const bf16*)(ws + WS_W1D), DFF, DFF, DFF}; pg8::StaticOrder S; S.init(TOK, DM, F.G, cid);
        pg8::EpiBf16 E{Y, DM};
        pg8::gemm_phase<pg8::EpiBf16, pg8::StaticOrder, true>(F.lds + RING_OFF, g, S, E); SEAM(2); }
    if (IN(3)) { ew_phase<true>(F, Y, args.in[0], F.out, 0.5f, args.in[6], args.in[7], XN); SEAM(3); }
    if (IN(4)) {
        pg8::Gemm g{XN, (const bf16*)(ws + WS_WIN), DM, DM, DM}; pg8::StaticOrder S; S.init(TOK, NWIN, F.G, cid);
        pg8::EpiWin E{(bf16*)(ws + WS_SEG0), (bf16*)(ws + WS_GA), (bf16*)(ws + WS_GB), (float*)(ws + WS_GATES), args.in[15], args.in[11], args.in[12], args.in[14], QC2};
        pg8::gemm_phase<pg8::EpiWin, pg8::StaticOrder, true>(F.lds + RING_OFF, g, S, E); SEAM(4); }
    if (IN(5)) { m1_phase(F); SEAM(5); }
    if (IN(6)) { m2_phase(F); SEAM(6); }
    if (IN(7)) { p7_mixer(F); SEAM(7); }
    if (IN(8)) {
        pg8::Gemm g{XN, (const bf16*)(ws + WS_WAB), DM, DM, DM}; pg8::StaticOrder S; S.init(TOK, DM, F.G, cid);
        pg8::EpiMerge E{Y, (const bf16*)(ws + WS_GA), (const bf16*)(ws + WS_GB)};
        pg8::gemm_phase<pg8::EpiMerge, pg8::StaticOrder, true>(F.lds + RING_OFF, g, S, E); SEAM(8); }
    if (IN(9)) {
        pg8::Gemm g{Y, (const bf16*)(ws + WS_WOUT), DM, DM, DM}; pg8::StaticOrder S; S.init(TOK, DM, F.G, cid);
        pg8::EpiBf16 E{XN, DM};
        pg8::gemm_phase<pg8::EpiBf16, pg8::StaticOrder, true>(F.lds + RING_OFF, g, S, E); SEAM(9); }
    if (IN(10)) { ew_phase<true>(F, XN, F.out, F.out, 1.0f, args.in[19], args.in[20], Y); SEAM(10); }
    if (IN(11)) {
        pg8::Gemm g{Y, (const bf16*)(ws + WS_W2GU), DM, DM, DM}; pg8::StaticOrder S; S.init(TOK, 2 * DFF, F.G, cid);
        pg8::EpiSwiGLU E{H, DFF};
        pg8::gemm_phase<pg8::EpiSwiGLU, pg8::StaticOrder, true>(F.lds + RING_OFF, g, S, E); SEAM(11); }
    if (IN(12)) {
        pg8::Gemm g{H, (const bf16*)(ws + WS_W2D), DFF, DFF, DFF}; pg8::StaticOrder S; S.init(TOK, DM, F.G, cid);
        pg8::EpiBf16 E{XN, DM};
        pg8::gemm_phase<pg8::EpiBf16, pg8::StaticOrder, true>(F.lds + RING_OFF, g, S, E); SEAM(12); }
    if (IN(13)) {
        ew_phase<true>(F, XN, F.out, F.out, 0.5f, args.in[24], args.in[25], Y);
        const int gw = F.vcu * NWAVES + F.wave, NGW = F.G * NWAVES; bf16* PB = (bf16*)(ws + WS_PB);
        for (int m = gw; m < TOK; m += NGW) { const f32x4 v = *((const GAS f32x4*)(args.in[1] + (size_t)m * 256) + F.lane); v2u w; w.x = pk2(v.x, v.y); w.y = pk2(v.z, v.w); *((GAS v2u*)(PB + (size_t)m * 256) + F.lane) = w; }
        SEAM(13); }
    if (IN(14)) {
        { pg8::Gemm g{(const bf16*)(ws + WS_PB), (const bf16*)(ws + WS_WPP), 256, 256, 256}; pg8::StaticOrder S; S.init(TOK, DM, F.G, cid);
          pg8::EpiBf16 E{(bf16*)(ws + WS_EMB), DM};
          pg8::gemm_phase<pg8::EpiBf16, pg8::StaticOrder, true>(F.lds + RING_OFF, g, S, E); }
        VM_WAIT(); __syncthreads();
        { pg8::Gemm g{Y, (const bf16*)(ws + WS_WPG), DM, DM, DM}; pg8::StaticOrder S; S.init(TOK, DM, F.G, cid);
          pg8::EpiPle E{XN, (const bf16*)(ws + WS_EMB), args.in[27]};
          pg8::gemm_phase<pg8::EpiPle, pg8::StaticOrder, true>(F.lds + RING_OFF, g, S, E); }
        SEAM(14); }
    if (IN(15)) { ew_phase<false>(F, XN, F.out, F.out, 1.0f, args.in[29], nullptr, nullptr); }
#undef IN
#undef SEAM
}

extern "C" void kernel_launch(void* const* d_in, const int* in_sizes, int n_in, void* d_out, int out_size, void* d_ws, size_t ws_size, hipStream_t stream) {
    static int grid = 0;
    if (grid == 0) {
        if (n_in != 30 || in_sizes[0] != TOK * DM || out_size != TOK * DM || ws_size < WS_END) { fprintf(stderr, "kernel_launch: unexpected shapes (n_in %d, in0 %d, out %d, ws %zu); nothing launched\n", n_in, n_in > 0 ? in_sizes[0] : -1, out_size, ws_size); grid = -1; return; }
        int dev = 0, cus = 0, per_cu = 0;
        if (hipGetDevice(&dev) != hipSuccess || hipDeviceGetAttribute(&cus, hipDeviceAttributeMultiprocessorCount, dev) != hipSuccess) { grid = -1; return; }
        if (hipFuncSetAttribute((const void*)mega_fwd, hipFuncAttributeMaxDynamicSharedMemorySize, LDS_BYTES) != hipSuccess) { fprintf(stderr, "kernel_launch: hipFuncSetAttribute failed\n"); grid = -1; return; }
        if (hipOccupancyMaxActiveBlocksPerMultiprocessor(&per_cu, (const void*)mega_fwd, NWAVES * 64, LDS_BYTES) != hipSuccess || per_cu < 1) { fprintf(stderr, "kernel_launch: occupancy query reports %d\n", per_cu); }
        (void)hipGetLastError();
        grid = cus;
        if (grid != 256) fprintf(stderr, "kernel_launch: %d CUs (built for 256)\n", grid);
    }
    if (grid < 0) return;
    hipMemsetAsync((char*)d_ws + WS_CTL, 0, CTL_ZERO_BYTES, stream);
    Args a{};
    for (int i = 0; i < 30; ++i) a.in[i] = (const float*)d_in[i];
    a.out = (float*)d_out; a.ws = (unsigned char*)d_ws;
#if MK_N_LAUNCHES == 1
    a.ph_lo = 0; a.ph_hi = NPHASE;
    hipLaunchKernelGGL(mega_fwd, dim3(grid), dim3(NWAVES * 64), LDS_BYTES, stream, a);
#else
    for (int p = 0; p < NPHASE; ++p) { a.ph_lo = p; a.ph_hi = p + 1; hipLaunchKernelGGL(mega_fwd, dim3(grid), dim3(NWAVES * 64), LDS_BYTES, stream, a); }
#endif
}
```

```cpp
#include <hip/hip_runtime.h>
#include <hip/hip_bf16.h>
#include <cstdio>
#include <cstdint>
#include <cmath>
namespace pg8 {
#define PG8_LAS __attribute__((address_space(3)))
typedef unsigned short bf16_t;
typedef short bf16x8 __attribute__((ext_vector_type(8)));
typedef float f32x4 __attribute__((ext_vector_type(4)));
typedef unsigned u32x4 __attribute__((ext_vector_type(4)));
constexpr int BM = 256, BK = 64, HALF = 128, HTB = HALF * BK * 2  , STAGE_BYTES = 8 * HTB, NXCD = 8, WGM = 8;

__host__ __device__ __forceinline__ int lds_byte(int r, int c) { const int st = (r >> 4) * 2 + (c >> 5), rr = r & 15, cc = c & 31, ob = rr * 64 + cc * 2; return st * 1024 + (ob ^ (((ob >> 9) & 1) << 5)); }
__host__ __device__ __forceinline__ void stage_rc(int b, int& R, int& C) { const int st = b / 1024, sb = b % 1024, swz = sb ^ (((sb >> 9) & 1) << 5); R = (st >> 1) * 16 + swz / 64; C = (st & 1) * 32 + (swz % 64) / 2; }
__host__ __device__ __forceinline__ int perm32(int rho) { const int n = rho >> 4, i = rho & 15; return 8 * (i >> 2) + 4 * n + (i & 3); }

struct Unit { int pm, pn; };
struct Gemm { const bf16_t* A; const bf16_t* Bt; int lda, ldb, K; };

struct StaticOrder {
    int nM, nN, nwg, G, c;
    __host__ __device__ void init(int M, int N, int G_, int c_) { nM = M / BM; nN = N / BM; nwg = nM * nN; G = G_; c = c_; }
    __host__ __device__ bool next(int i, Unit& u) const {
        const long L = (long)i * G + c; if (L >= nwg) return false;
        int wgid = (int)L; { const int q = nwg / NXCD, r = nwg % NXCD, xcd = wgid % NXCD, off = wgid / NXCD; wgid = (xcd < r ? xcd * (q + 1) : r * (q + 1) + (xcd - r) * q) + off; }
        const int nig = WGM * nN, gid = wgid / nig, fm = gid * WGM, gsz = (nM - fm) < WGM ? (nM - fm) : WGM;
        u.pm = fm + ((wgid % nig) % gsz); u.pn = (wgid % nig) / gsz; return true;
    }
};

__device__ __forceinline__ unsigned cvt_pk_bf16(float lo, float hi) { unsigned r; asm volatile("v_cvt_pk_bf16_f32 %0, %1, %2" : "=v"(r) : "v"(lo), "v"(hi)); return r; }
__device__ __forceinline__ float bf_lo(unsigned w) { return __uint_as_float(w << 16); }
__device__ __forceinline__ float bf_hi(unsigned w) { return __uint_as_float(w & 0xffff0000u); }
__device__ __forceinline__ float sigmoid_f(float x) { return __builtin_amdgcn_rcpf(1.0f + __builtin_amdgcn_exp2f(-1.4426950408889634f * x)); }

template <class Epi, class Sched, bool ALIGN_EPI = false>
__device__ __forceinline__ void gemm_phase(PG8_LAS unsigned char* lds, const Gemm g, const Sched& S, const Epi& E) {
    const int tid = threadIdx.x, wid = __builtin_amdgcn_readfirstlane(tid >> 6), lane = tid & 63, wr = wid >> 2, wc = wid & 3, fr = lane & 15, fq = lane >> 4;
    const int K = g.K, nt = K / BK;
    unsigned voffA[2], voffB[2];
#pragma unroll
    for (int i = 0; i < 2; ++i) { int R, C; stage_rc(tid * 16 + i * 8192, R, C); const int Rb = Epi::PERM ? ((R & ~31) + perm32(R & 31)) : R;
        voffA[i] = (unsigned)(R * g.lda + C) * 2u; voffB[i] = (unsigned)(Rb * g.ldb + C) * 2u; }
    const size_t kstep = (size_t)(BK * 2);
    const size_t hstepA = (size_t)HALF * g.lda * 2, hstepB = (size_t)HALF * g.ldb * 2;
    const size_t tstepA = 2 * hstepA, tstepB = 2 * hstepB;
    const unsigned ldsw = (unsigned)wid * 1024u;
    const int aoff = lds_byte(wr * 64 + fr, fq * 8), boff = lds_byte(wc * 32 + fr, fq * 8);
#define PG8_SA(b, h) (((b) * 2 + (h)) * HTB)
#define PG8_SB(b, h) ((4 + (b) * 2 + (h)) * HTB)
#define PG8_STAGE(bufoff, gbase, voff) do { _Pragma("unroll") for (int _i = 0; _i < 2; ++_i) \
        __builtin_amdgcn_global_load_lds((const unsigned*)((const char*)(gbase) + (voff)[_i]), (PG8_LAS unsigned*)(lds + (bufoff) + ldsw + _i * 8192), 16, 0, 0); } while (0)
#define PG8_LDA(dst, b, h) do { _Pragma("unroll") for (int m = 0; m < 4; ++m) _Pragma("unroll") for (int k = 0; k < 2; ++k) dst[m][k] = *(const PG8_LAS bf16x8*)(lds + PG8_SA(b, h) + aoff + m * 2048 + k * 1024); } while (0)
#define PG8_LDB(dst, b, h) do { _Pragma("unroll") for (int n = 0; n < 2; ++n) _Pragma("unroll") for (int k = 0; k < 2; ++k) dst[n][k] = *(const PG8_LAS bf16x8*)(lds + PG8_SB(b, h) + boff + n * 2048 + k * 1024); } while (0)
#define PG8_MMA(ai, bj, At, Bt) do { __builtin_amdgcn_s_setprio(1); _Pragma("unroll") for (int m = 0; m < 4; ++m) _Pragma("unroll") for (int n = 0; n < 2; ++n) _Pragma("unroll") for (int k = 0; k < 2; ++k) \
        acc[ai][bj][m][n] = __builtin_amdgcn_mfma_f32_16x16x32_bf16(Bt[n][k], At[m][k], acc[ai][bj][m][n], 0, 0, 0); __builtin_amdgcn_s_setprio(0); } while (0)
#define PG8_WAIT_V(n) asm volatile("s_waitcnt vmcnt(" #n ")" ::: "memory")
#define PG8_WAIT_L(n) asm volatile("s_waitcnt lgkmcnt(" #n ")" ::: "memory")
#define PG8_BAR __builtin_amdgcn_s_barrier()
#define PG8_SCHED __builtin_amdgcn_sched_barrier(0)
    Unit cur, nxt; int ui = 0;
    if (!S.next(0, cur)) return;
    f32x4 acc[2][2][4][2];
#pragma unroll
    for (int a = 0; a < 2; ++a)
#pragma unroll
        for (int b = 0; b < 2; ++b)
#pragma unroll
            for (int m = 0; m < 4; ++m)
#pragma unroll
                for (int n = 0; n < 2; ++n) acc[a][b][m][n] = (f32x4){0.f, 0.f, 0.f, 0.f};
    bf16x8 At[4][2], B0[2][2], B1[2][2];
    const char* cA = (const char*)g.A + (size_t)cur.pm * tstepA; const char* cB = (const char*)g.Bt + (size_t)cur.pn * tstepB;
    PG8_STAGE(PG8_SB(0, 0), cB, voffB); PG8_STAGE(PG8_SB(0, 1), cB + hstepB, voffB); PG8_STAGE(PG8_SA(0, 0), cA, voffA); PG8_STAGE(PG8_SA(0, 1), cA + hstepA, voffA);
    if (wr == 1) PG8_BAR;
    PG8_WAIT_V(2); PG8_BAR;
    PG8_STAGE(PG8_SB(1, 0), cB + kstep, voffB); PG8_STAGE(PG8_SA(1, 0), cA + kstep, voffA); PG8_STAGE(PG8_SB(1, 1), cB + hstepB + kstep, voffB);
    PG8_WAIT_V(6); PG8_BAR;
    for (;;) {
        const bool has_next = S.next(ui + 1, nxt);
        const char* nA = has_next ? (const char*)g.A + (size_t)nxt.pm * tstepA : cA; const char* nB = has_next ? (const char*)g.Bt + (size_t)nxt.pn * tstepB : cB;
        for (int t = 0; t < nt; t += 2) {
            const bool last = (t == nt - 2);
            if constexpr (Epi::MID) { if (t == (nt >> 1)) E.mid(acc, cur, wr, wc, fr, fq); }
            const char* a1 = cA + (size_t)(t + 1) * kstep;
            const char* a2 = last ? nA : cA + (size_t)(t + 2) * kstep; const char* b2 = last ? nB : cB + (size_t)(t + 2) * kstep;
            const char* a3 = a2 + kstep; const char* b3 = b2 + kstep;
            PG8_LDB(B0, 0, 0); PG8_LDB(B1, 0, 1); PG8_SCHED; PG8_LDA(At, 0, 0); PG8_STAGE(PG8_SA(1, 1), a1 + hstepA, voffA);
            PG8_WAIT_V(8); PG8_WAIT_L(0); PG8_BAR; PG8_MMA(0, 0, At, B0); PG8_MMA(0, 1, At, B1); PG8_BAR; PG8_SCHED;
            PG8_LDA(At, 0, 1); PG8_STAGE(PG8_SB(0, 0), b2, voffB); PG8_STAGE(PG8_SB(0, 1), b2 + hstepB, voffB); PG8_STAGE(PG8_SA(0, 0), a2, voffA);
            PG8_WAIT_V(8); PG8_WAIT_L(0); PG8_BAR; PG8_MMA(1, 0, At, B0); PG8_MMA(1, 1, At, B1); PG8_BAR; PG8_SCHED;
            PG8_LDB(B0, 1, 0); PG8_LDB(B1, 1, 1); PG8_SCHED; PG8_LDA(At, 1, 0); PG8_STAGE(PG8_SA(0, 1), a2 + hstepA, voffA);
            PG8_WAIT_V(8); PG8_WAIT_L(0); PG8_BAR; PG8_MMA(0, 0, At, B0); PG8_MMA(0, 1, At, B1); PG8_BAR; PG8_SCHED;
            PG8_LDA(At, 1, 1); PG8_STAGE(PG8_SB(1, 0), b3, voffB); PG8_STAGE(PG8_SB(1, 1), b3 + hstepB, voffB); PG8_STAGE(PG8_SA(1, 0), a3, voffA);
            PG8_WAIT_V(8); PG8_WAIT_L(0); PG8_BAR; PG8_MMA(1, 0, At, B0); PG8_MMA(1, 1, At, B1); PG8_BAR; PG8_SCHED;
        }
        if constexpr (ALIGN_EPI) { if (wr == 0) PG8_BAR; }
        E(acc, cur, wr, wc, fr, fq);
        if (!has_next) break;
#pragma unroll
        for (int a = 0; a < 2; ++a)
#pragma unroll
            for (int b = 0; b < 2; ++b)
#pragma unroll
                for (int m = 0; m < 4; ++m)
#pragma unroll
                    for (int n = 0; n < 2; ++n) acc[a][b][m][n] = (f32x4){0.f, 0.f, 0.f, 0.f};
        cur = nxt; cA = nA; cB = nB; ++ui;
        if constexpr (ALIGN_EPI) { if (wr == 1) PG8_BAR; }
    }
    PG8_WAIT_V(0);
    if constexpr (!ALIGN_EPI) { if (wr == 0) PG8_BAR; }
    PG8_BAR;
#undef PG8_SA
#undef PG8_SB
#undef PG8_STAGE
#undef PG8_LDA
#undef PG8_LDB
#undef PG8_MMA
#undef PG8_WAIT_V
#undef PG8_WAIT_L
#undef PG8_BAR
#undef PG8_SCHED
}
}
namespace pg8 {
struct EpiBf16 {
    static constexpr bool PERM = true, MID = false;
    bf16_t* O; int ldc;
    __device__ __forceinline__ void operator()(const f32x4 (&acc)[2][2][4][2], const Unit& u, int wr, int wc, int fr, int fq) const {
        const int row0 = u.pm * BM + wr * 64 + fr, col0 = u.pn * BM + wc * 32 + 8 * fq;
#pragma unroll
        for (int ai = 0; ai < 2; ++ai)
#pragma unroll
            for (int m = 0; m < 4; ++m) { bf16_t* rowp = O + (size_t)(row0 + ai * HALF + m * 16) * ldc + col0;
#pragma unroll
                for (int bj = 0; bj < 2; ++bj) { const f32x4 v0 = acc[ai][bj][m][0], v1 = acc[ai][bj][m][1];
                    u32x4 w; w.x = cvt_pk_bf16(v0[0], v0[1]); w.y = cvt_pk_bf16(v0[2], v0[3]); w.z = cvt_pk_bf16(v1[0], v1[1]); w.w = cvt_pk_bf16(v1[2], v1[3]);
                    *(u32x4*)(rowp + bj * HALF) = w; } }
    }
};
struct EpiSwiGLU {
    static constexpr bool PERM = true, MID = false;
    bf16_t* O; int ldc;
    __device__ __forceinline__ void operator()(const f32x4 (&acc)[2][2][4][2], const Unit& u, int wr, int wc, int fr, int fq) const {
        const int row0 = u.pm * BM + wr * 64 + fr, col0 = u.pn * HALF + wc * 32 + 8 * fq;
#pragma unroll
        for (int ai = 0; ai < 2; ++ai)
#pragma unroll
            for (int m = 0; m < 4; ++m) { bf16_t* rowp = O + (size_t)(row0 + ai * HALF + m * 16) * ldc + col0;
                float h[8];
#pragma unroll
                for (int n = 0; n < 2; ++n)
#pragma unroll
                    for (int e = 0; e < 4; ++e) { const float gt = acc[ai][0][m][n][e], up = acc[ai][1][m][n][e]; h[n * 4 + e] = gt * sigmoid_f(gt) * up; }
                u32x4 w; w.x = cvt_pk_bf16(h[0], h[1]); w.y = cvt_pk_bf16(h[2], h[3]); w.z = cvt_pk_bf16(h[4], h[5]); w.w = cvt_pk_bf16(h[6], h[7]);
                *(u32x4*)rowp = w; }
    }
};
struct EpiWin {
    static constexpr bool PERM = true, MID = false;
    bf16_t* seg0; bf16_t* ga; bf16_t* gb; float* gates; const float* bgate; const float* ib; const float* fb; const float* xb; float qscale;
    __device__ __forceinline__ void operator()(const f32x4 (&acc)[2][2][4][2], const Unit& u, int wr, int wc, int fr, int fq) const {
        const int pn = u.pn; const int row0 = u.pm * BM + wr * 64 + fr;
        if (pn < 20) {
            bf16_t* dst; int ldc, ccol, op; const float* bias = nullptr;
            if (pn < 12) { const int sg = pn >> 1; dst = seg0 + (size_t)sg * (size_t)(16u << 20); ldc = 512; ccol = (pn & 1) * 256; op = (sg == 2) ? 2 : (sg == 3) ? 1 : 0; }
            else { const int sg = (pn - 12) >> 2; dst = sg ? gb : ga; ldc = 1024; ccol = ((pn - 12) & 3) * 256; op = 2; bias = bgate + sg * 1024 + ccol; }
            const int col0 = ccol + wc * 32 + 8 * fq;
            f32x4 bv[2][2];
#pragma unroll
            for (int bj = 0; bj < 2; ++bj)
#pragma unroll
                for (int n = 0; n < 2; ++n) bv[bj][n] = bias ? *(const f32x4*)(bias + wc * 32 + 8 * fq + bj * HALF + 4 * n) : (f32x4){0.f, 0.f, 0.f, 0.f};
#pragma unroll
            for (int ai = 0; ai < 2; ++ai)
#pragma unroll
                for (int m = 0; m < 4; ++m) { bf16_t* rowp = dst + (size_t)(row0 + ai * HALF + m * 16) * ldc + col0;
#pragma unroll
                    for (int bj = 0; bj < 2; ++bj) { f32x4 v0 = acc[ai][bj][m][0], v1 = acc[ai][bj][m][1];
                        if (op == 1) { v0 = v0 * qscale; v1 = v1 * qscale; }
                        else if (op == 2) { v0 = v0 + bv[bj][0]; v1 = v1 + bv[bj][1];
#pragma unroll
                            for (int e = 0; e < 4; ++e) { v0[e] = sigmoid_f(v0[e]); v1[e] = sigmoid_f(v1[e]); } }
                        u32x4 w; w.x = cvt_pk_bf16(v0[0], v0[1]); w.y = cvt_pk_bf16(v0[2], v0[3]); w.z = cvt_pk_bf16(v1[0], v1[1]); w.w = cvt_pk_bf16(v1[2], v1[3]);
                        *(u32x4*)(rowp + bj * HALF) = w; } }
        } else {
            if (wc == 0 && fq < 2) {
                const float* p0 = fq ? xb : ib; const float* p1 = fq ? xb + 4 : fb; const f32x4 b0 = (f32x4){p0[0], p0[1], p0[2], p0[3]}, b1 = (f32x4){p1[0], p1[1], p1[2], p1[3]};
#pragma unroll
                for (int ai = 0; ai < 2; ++ai)
#pragma unroll
                    for (int m = 0; m < 4; ++m) { float* rowp = gates + (size_t)(row0 + ai * HALF + m * 16) * 16 + 8 * fq;
                        *(f32x4*)rowp = acc[ai][0][m][0] + b0; *(f32x4*)(rowp + 4) = acc[ai][0][m][1] + b1; }
            }
        }
    }
};
struct EpiMerge {
    static constexpr bool PERM = true, MID = true;
    bf16_t* O; const bf16_t* ga; const bf16_t* gb;
    __device__ __forceinline__ void mid(f32x4 (&acc)[2][2][4][2], const Unit& u, int wr, int wc, int fr, int fq) const {
        asm volatile("" : "+v"(fr), "+v"(fq));
        const unsigned base = (unsigned)((u.pm * BM + wr * 64 + fr) * 1024 + u.pn * BM + wc * 32 + 8 * fq) * 2u;
        const char* gab = (const char*)ga; const char* gbb = (const char*)gb;
#pragma unroll
        for (int ai = 0; ai < 2; ++ai)
#pragma unroll
            for (int m = 0; m < 4; ++m) { const unsigned off = base + (unsigned)((ai * HALF + m * 16) * 1024) * 2u;
#pragma unroll
                for (int bj = 0; bj < 2; ++bj) { const u32x4 a = *(const u32x4*)(gab + off + bj * HALF * 2), b = *(const u32x4*)(gbb + off + bj * HALF * 2);
                    f32x4 r0, r1;
                    r0[0] = bf_lo(a.x) * __builtin_amdgcn_rcpf(bf_lo(b.x)); r0[1] = bf_hi(a.x) * __builtin_amdgcn_rcpf(bf_hi(b.x));
                    r0[2] = bf_lo(a.y) * __builtin_amdgcn_rcpf(bf_lo(b.y)); r0[3] = bf_hi(a.y) * __builtin_amdgcn_rcpf(bf_hi(b.y));
                    r1[0] = bf_lo(a.z) * __builtin_amdgcn_rcpf(bf_lo(b.z)); r1[1] = bf_hi(a.z) * __builtin_amdgcn_rcpf(bf_hi(b.z));
                    r1[2] = bf_lo(a.w) * __builtin_amdgcn_rcpf(bf_lo(b.w)); r1[3] = bf_hi(a.w) * __builtin_amdgcn_rcpf(bf_hi(b.w));
                    acc[ai][bj][m][0] = acc[ai][bj][m][0] * r0; acc[ai][bj][m][1] = acc[ai][bj][m][1] * r1; }
                asm volatile("" ::: "memory"); }
    }
    __device__ __forceinline__ void operator()(const f32x4 (&acc)[2][2][4][2], const Unit& u, int wr, int wc, int fr, int fq) const {
        asm volatile("" : "+v"(fr), "+v"(fq));
        const unsigned base = (unsigned)((u.pm * BM + wr * 64 + fr) * 1024 + u.pn * BM + wc * 32 + 8 * fq) * 2u;
        const char* gbb = (const char*)gb; char* Ob = (char*)O;
#pragma unroll
        for (int ai = 0; ai < 2; ++ai)
#pragma unroll
            for (int m = 0; m < 4; ++m) { const unsigned off = base + (unsigned)((ai * HALF + m * 16) * 1024) * 2u;
#pragma unroll
                for (int bj = 0; bj < 2; ++bj) { const u32x4 b = *(const u32x4*)(gbb + off + bj * HALF * 2);
                    const f32x4 v0 = acc[ai][bj][m][0], v1 = acc[ai][bj][m][1];
                    u32x4 w; w.x = cvt_pk_bf16(v0[0] * bf_lo(b.x), v0[1] * bf_hi(b.x)); w.y = cvt_pk_bf16(v0[2] * bf_lo(b.y), v0[3] * bf_hi(b.y));
                    w.z = cvt_pk_bf16(v1[0] * bf_lo(b.z), v1[1] * bf_hi(b.z)); w.w = cvt_pk_bf16(v1[2] * bf_lo(b.w), v1[3] * bf_hi(b.w));
                    *(u32x4*)(Ob + off + bj * HALF * 2) = w; }
                asm volatile("" ::: "memory"); }
    }
};
struct EpiPle {
    static constexpr bool PERM = true, MID = false;
    bf16_t* O; const bf16_t* emb; const float* bias;
    __device__ __forceinline__ void operator()(const f32x4 (&acc)[2][2][4][2], const Unit& u, int wr, int wc, int fr, int fq) const {
        asm volatile("" : "+v"(fr), "+v"(fq));
        const int col0 = u.pn * BM + wc * 32 + 8 * fq;
        const unsigned base = (unsigned)((u.pm * BM + wr * 64 + fr) * 1024 + col0) * 2u;
        const char* eb = (const char*)emb; char* Ob = (char*)O;
        f32x4 bv[2][2];
#pragma unroll
        for (int bj = 0; bj < 2; ++bj)
#pragma unroll
            for (int n = 0; n < 2; ++n) bv[bj][n] = *(const f32x4*)(bias + col0 + bj * HALF + 4 * n);
#pragma unroll
        for (int ai = 0; ai < 2; ++ai)
#pragma unroll
            for (int m = 0; m < 4; ++m) { const unsigned off = base + (unsigned)((ai * HALF + m * 16) * 1024) * 2u;
#pragma unroll
                for (int bj = 0; bj < 2; ++bj) { const u32x4 b = *(const u32x4*)(eb + off + bj * HALF * 2);
                    const f32x4 v0 = acc[ai][bj][m][0] + bv[bj][0], v1 = acc[ai][bj][m][1] + bv[bj][1];
                    u32x4 w; w.x = cvt_pk_bf16(sigmoid_f(v0[0]) * bf_lo(b.x), sigmoid_f(v0[1]) * bf_hi(b.x)); w.y = cvt_pk_bf16(sigmoid_f(v0[2]) * bf_lo(b.y), sigmoid_f(v0[3]) * bf_hi(b.y));
                    w.z = cvt_pk_bf16(sigmoid_f(v1[0]) * bf_lo(b.z), sigmoid_f(v1[1]) * bf_hi(b.z)); w.w = cvt_pk_bf16(sigmoid_f(v1[2]) * bf_lo(b.w), sigmoid_f(v1[3]) * bf_hi(b.w));
                    *(u32x4*)(Ob + off + bj * HALF * 2) = w; }
                asm volatile("" ::: "memory"); }
    }
};
}
namespace fox_body {
#define FLAS __attribute__((address_space(3)))
using bf16=__hip_bfloat16;
using bf16x8=__attribute__((ext_vector_type(8)))short;
using s16x4=__attribute__((ext_vector_type(4)))short;
using f32x16=__attribute__((ext_vector_type(16)))float;
using u32x4=__attribute__((ext_vector_type(4)))unsigned;
constexpr int BATCH=8,NHEAD=8,SEQ=4096,D=64,DM=512,DMO=1024;
constexpr int NW=8,QBLK=32,QB=QBLK*NW,KVBLK=64,NQB=SEQ/QB;
__device__ __forceinline__ int crow(int r,int hi){return (r&3)+8*(r>>2)+4*hi;}
#define SBAR() __builtin_amdgcn_sched_barrier(0)
__device__ __forceinline__ void cmask(f32x16&p0,f32x16&p1,int jb,int qrel,int hi){
  const float NEG=-INFINITY; int kb=64*jb+4*hi;
  #pragma unroll
  for(int r=0;r<16;++r){int kv=kb+(r&3)+8*(r>>2); if(kv>qrel)p0[r]=NEG; if(kv+32>qrel)p1[r]=NEG;}
}

constexpr int NSLOT=3, SLOTB=8192;
constexpr int LDS_K=0, LDS_V=NSLOT*SLOTB, LDS_WS=2*NSLOT*SLOTB, LDS_OST=LDS_WS+NW*64*4, LDS_CS=LDS_OST+NW*4096, LDS_BYTES=LDS_CS+SEQ*4;
constexpr float C2=0.125f*1.4426950408889634f; typedef float f32x4 __attribute__((ext_vector_type(4)));
__device__ __forceinline__ void glds16(const void*gsrc,unsigned lds_dst){unsigned keep;
  asm volatile("s_mov_b32 %0, m0\n\ts_mov_b32 m0, %2\n\ts_nop 0\n\tglobal_load_lds_dwordx4 %1, off\n\ts_mov_b32 m0, %0":"=&s"(keep):"v"(gsrc),"s"(lds_dst):"memory");}
__device__ __forceinline__ float max3f(float a,float b,float c){float r;asm("v_max3_f32 %0, %1, %2, %3":"=v"(r):"v"(a),"v"(b),"v"(c));return r;}
__device__ __forceinline__ float max2f(float a,float b){float r;asm("v_max_f32_e32 %0, %1, %2":"=v"(r):"v"(a),"v"(b));return r;}
__device__ __forceinline__ float fadd_s(float a,float b){float r;asm("v_add_f32_e32 %0, %1, %2":"=v"(r):"v"(a),"v"(b));return r;}
__device__ __forceinline__ float fsub_s(float a,float b){float r;asm("v_sub_f32_e32 %0, %1, %2":"=v"(r):"v"(a),"v"(b));return r;}
typedef float f32x2_t __attribute__((ext_vector_type(2))); typedef __bf16 bf16x2_t __attribute__((ext_vector_type(2)));
__device__ __forceinline__ unsigned cvtpk_s(float lo,float hi){f32x2_t v={lo,hi};bf16x2_t b=__builtin_convertvector(v,bf16x2_t);return __builtin_bit_cast(unsigned,b);}
#define WAIT_BAR(N) asm volatile("s_waitcnt vmcnt(" #N ") lgkmcnt(0)\n\ts_barrier":::"memory")

__device__ __forceinline__ void qkt(f32x16&p0,f32x16&p1,const char*Kslot,const bf16x8*qr,int r32,int hi){
  const char*kb=Kslot+hi*1024+r32*16;
  #pragma unroll
  for(int d0=0;d0<4;++d0){
    const bf16x8 b0=*reinterpret_cast<const bf16x8*>(kb+d0*2048);
    const bf16x8 b1=*reinterpret_cast<const bf16x8*>(kb+d0*2048+512);
    p0=__builtin_amdgcn_mfma_f32_32x32x16_bf16(b0,qr[d0],p0,0,0,0);p1=__builtin_amdgcn_mfma_f32_32x32x16_bf16(b1,qr[d0],p1,0,0,0);}
}
typedef __attribute__((address_space(3))) const char* lds_cptr;
typedef short v4i16_t __attribute__((ext_vector_type(4)));
__device__ __forceinline__ void kload8(bf16x8*kf,lds_cptr kp){
  kf[0]=*(const __attribute__((address_space(3))) bf16x8*)(kp);      kf[1]=*(const __attribute__((address_space(3))) bf16x8*)(kp+512);
  kf[2]=*(const __attribute__((address_space(3))) bf16x8*)(kp+2048); kf[3]=*(const __attribute__((address_space(3))) bf16x8*)(kp+2560);
  kf[4]=*(const __attribute__((address_space(3))) bf16x8*)(kp+4096); kf[5]=*(const __attribute__((address_space(3))) bf16x8*)(kp+4608);
  kf[6]=*(const __attribute__((address_space(3))) bf16x8*)(kp+6144); kf[7]=*(const __attribute__((address_space(3))) bf16x8*)(kp+6656);
}
__device__ __forceinline__ void kload2(bf16x8*kf,lds_cptr kp,int j){ kf[2*j]=*(const __attribute__((address_space(3))) bf16x8*)(kp+j*2048); kf[2*j+1]=*(const __attribute__((address_space(3))) bf16x8*)(kp+j*2048+512); }
__device__ __forceinline__ s16x4 vtr(lds_cptr p){ return __builtin_bit_cast(s16x4,__builtin_amdgcn_ds_read_tr16_b64_v4i16((__attribute__((address_space(3))) v4i16_t*)p)); }
__device__ __forceinline__ float rowmax(const f32x16&p0,const f32x16&p1){
  float a=max3f(p0[0],p0[1],p1[0]),b=max3f(p0[2],p0[3],p1[1]);a=max3f(a,p1[2],p1[3]);
  #pragma unroll
  for(int r=4;r<16;r+=4){a=max3f(a,p0[r],p0[r+1]);b=max3f(b,p0[r+2],p0[r+3]);a=max3f(a,p1[r],p1[r+1]);b=max3f(b,p1[r+2],p1[r+3]);}
  const float m=max2f(a,b);
  auto rr=__builtin_amdgcn_permlane32_swap(__float_as_uint(m),__float_as_uint(m),false,false);
  return max2f(__uint_as_float(rr[0]),__uint_as_float(rr[1]));
}
__device__ __forceinline__ void pv(f32x16*o,int vb,bf16x8 pa0,bf16x8 pa1,bf16x8 pa2,bf16x8 pa3){
  #pragma unroll
  for(int d0=0;d0<2;++d0){s16x4 lo[4],hi[4];
    #pragma unroll
    for(int ks=0;ks<4;++ks){
      asm volatile("ds_read_b64_tr_b16 %0,%1 offset:%c2":"=&v"(lo[ks]):"v"(vb),"i"(d0*4096+ks*1024):"memory");
      asm volatile("ds_read_b64_tr_b16 %0,%1 offset:%c2":"=&v"(hi[ks]):"v"(vb),"i"(d0*4096+ks*1024+512):"memory");}
    asm volatile("s_waitcnt lgkmcnt(0)":::"memory");SBAR();
    #define PK(k) (bf16x8){lo[k][0],lo[k][1],lo[k][2],lo[k][3],hi[k][0],hi[k][1],hi[k][2],hi[k][3]}
    o[d0]=__builtin_amdgcn_mfma_f32_32x32x16_bf16(pa0,PK(0),o[d0],0,0,0);
    o[d0]=__builtin_amdgcn_mfma_f32_32x32x16_bf16(pa1,PK(1),o[d0],0,0,0);
    o[d0]=__builtin_amdgcn_mfma_f32_32x32x16_bf16(pa2,PK(2),o[d0],0,0,0);
    o[d0]=__builtin_amdgcn_mfma_f32_32x32x16_bf16(pa3,PK(3),o[d0],0,0,0);
    #undef PK
  }
}

#ifndef ATTN_STORE16
#define ATTN_STORE16(p,v) (*(u32x4*)(p)=(v))
#endif
template<int THRL> __device__ __forceinline__ void attn_unit(int b,int h,int qb,const bf16*Q,const bf16*__restrict__ K,const bf16*__restrict__ V,bf16*O,int ocol,const float*cs,char*shm){
  int tid_=threadIdx.x; asm volatile("":"+v"(tid_));
  const int tid=tid_,lane=tid&63,r32=lane&31,hi=lane>>5; const int wid=__builtin_amdgcn_readfirstlane(tid>>6);
  const long rowbase=(long)b*SEQ; const int q0=qb*QB;
  const bf16*Qw=Q+(rowbase+q0+wid*QBLK)*DM+h*D;
  const bf16*Kh=K+rowbase*DM+h*D,*Vh=V+rowbase*DM+h*D;
  const unsigned lds0=(unsigned)(uintptr_t)shm;
  float*wsf=(float*)(shm+LDS_WS)+wid*64;
  const bf16*ksrc=Kh+(long)lane*DM+wid*8;
  const bf16*vsrc=Vh+(long)(16*(wid&3)+(lane>>2))*DM+(wid>>2)*32+(lane&3)*8;
  const unsigned kdst=lds0+LDS_K+wid*1024, vdst=lds0+LDS_V+wid*1024;
  #define DMA_K(t,slot) glds16(ksrc+(long)(t)*KVBLK*DM,(unsigned)__builtin_amdgcn_readfirstlane(kdst+(slot)))
  #define DMA_V(t,slot) glds16(vsrc+(long)(t)*KVBLK*DM,(unsigned)__builtin_amdgcn_readfirstlane(vdst+(slot)))
  const int vb0=(int)(lds0+LDS_V)+((lane>>4)&1)*32+(lane&3)*8+(4*hi+((lane&15)>>2))*64;
  const char*Kbase=shm+LDS_K; bf16x8 kf[8];
  const lds_cptr shm3=(lds_cptr)shm; const lds_cptr kp0=shm3+LDS_K+hi*1024+r32*16; const lds_cptr vp0=shm3+LDS_V+((lane>>4)&1)*32+(lane&3)*8+(4*hi+((lane&15)>>2))*64;
  const int NT=(q0+QB)/KVBLK;
  DMA_K(0,0);DMA_V(0,0);DMA_K(1,SLOTB);
  bf16x8 qr[4];
  #pragma unroll
  for(int d0=0;d0<4;++d0)qr[d0]=*reinterpret_cast<const bf16x8*>(&Qw[(long)r32*DM+d0*16+hi*8]);
  { FLAS float*csw=(FLAS float*)((FLAS char*)shm+LDS_CS); for(int i=tid*4;i<q0+QB;i+=NW*64*4){ const f32x4 v=*(const f32x4*)(cs+i); *(FLAS f32x4*)(csw+i)=v; } }
  const FLAS float*csl=(const FLAS float*)((FLAS char*)shm+LDS_CS)+4*hi;
  float mhat=0.f,l_reg=0.f,nmh=0.f;f32x16 o[2];o[0]=f32x16{};o[1]=f32x16{};
  const int qrel=wid*QBLK+r32;
  #define CMASK(P0,P1,t) do{int jb_=(t)-(NT-4); if(jb_>=0)cmask(P0,P1,jb_,qrel,hi);}while(0)
  #define CINIT(P0,P1,t) do{ const FLAS float*cb_=csl+(t)*64; _Pragma("unroll") for(int g_=0;g_<4;++g_){ const f32x4 b0_=*(const FLAS f32x4*)(cb_+8*g_), b1_=*(const FLAS f32x4*)(cb_+32+8*g_); \
      _Pragma("unroll") for(int e_=0;e_<4;++e_){ P0[4*g_+e_]=nmh-b0_[e_]; P1[4*g_+e_]=nmh-b1_[e_]; } SBAR(); } }while(0)
  bool resc=false;
  #define START(P0,P1) do{ const float rm=rowmax(P0,P1); resc=false; \
    { const float dl=rm; mhat=fadd_s(mhat,dl); \
      _Pragma("unroll") for(int r=0;r<16;++r){P0[r]=fsub_s(P0[r],dl);P1[r]=fsub_s(P1[r],dl);} \
      nmh=-mhat; } \
    _Pragma("unroll") for(int r=0;r<16;++r)P0[r]=__builtin_amdgcn_exp2f(P0[r]); }while(0)
  #define RESC() do{ if(resc){ asm volatile("s_waitcnt lgkmcnt(0)":::"memory"); \
      _Pragma("unroll") for(int d_=0;d_<2;++d_) _Pragma("unroll") for(int r=0;r<16;++r)o[d_][r]*=wsf[crow(r,hi)]; } }while(0)
  f32x16 pA0,pA1,pB0,pB1;
  int sl_prev=0,sl_cur=0,sl_next=SLOTB;
  #define ROT() do{sl_prev=sl_cur;sl_cur=sl_next;sl_next=(sl_next==(NSLOT-1)*SLOTB)?0:sl_next+SLOTB;}while(0)
  DMA_K(2,2*SLOTB);
  WAIT_BAR(3);
  CINIT(pA0,pA1,0); qkt(pA0,pA1,Kbase,qr,r32,hi);asm volatile("s_nop 15\n\ts_nop 7":"+v"(pA0),"+v"(pA1));CMASK(pA0,pA1,0);
  START(pA0,pA1);
  _Pragma("unroll") for(int r=0;r<16;++r)pA1[r]=__builtin_amdgcn_exp2f(pA1[r]);
  WAIT_BAR(0);
  DMA_K(3,0);DMA_V(1,SLOTB);
  ROT();
  kload8(kf,kp0+sl_cur);
  WAIT_BAR(2);
  s16x4 vlo[8],vhi[8]; u32x4 pw0,pw1,pw2,pw3;
  #define PKW(P,B) cvtpk_s(P[B],P[B+1])
  #define PAF(k) __builtin_bit_cast(bf16x8,pw##k)
  #define VFR(i) (bf16x8){vlo[i][0],vlo[i][1],vlo[i][2],vlo[i][3],vhi[i][0],vhi[i][1],vhi[i][2],vhi[i][3]}
  #define PIN(x) asm volatile("":"+v"(x))
  #define MX3(a,b,c) __builtin_fmaxf(__builtin_fmaxf((a),(b)),(c))
  #define GAPA(MF,A0,A1,A2,A3,W0,W1,PW) do{ MF; sacc+=A0; sacc+=A1; sacc+=A2; sacc+=A3; PIN(sacc); W0; W1; PIN(PW); SBAR(); }while(0)
  #define EX(v) __builtin_amdgcn_exp2f(v)
  #define GAPB(MF,X,B) do{ MF; X[B]=EX(X[B]); X[B+1]=EX(X[B+1]); X[B+2]=EX(X[B+2]); X[B+3]=EX(X[B+3]); PIN(X); SBAR(); }while(0)
  #define VRD(i) do{ vlo[i]=vtr(vp_+(((i)>>2)*4096+((i)&3)*1024)); vhi[i]=vtr(vp_+(((i)>>2)*4096+((i)&3)*1024+512)); }while(0)
  #define KRD(G,j) do{ if(G){ kload2(kf,kp0+sl_next,j); SBAR(); } }while(0)
  #define STEP(C0,C1,P0,P1,t,GK,GV,GL) do{ SBAR(); CINIT(C0,C1,t); SBAR(); \
    const lds_cptr vp_=vp0+sl_prev; \
    VRD(0); SBAR(); float sacc=(P0[0]+P0[1]); \
    GAPA(C0=__builtin_amdgcn_mfma_f32_32x32x16_bf16(kf[0],qr[0],C0,0,0,0), P0[2],P0[3],P0[4],P0[5],     pw0[0]=PKW(P0,0), pw0[1]=PKW(P0,2), pw0); \
    VRD(4); SBAR(); GAPA(C1=__builtin_amdgcn_mfma_f32_32x32x16_bf16(kf[1],qr[0],C1,0,0,0), P0[6],P0[7],P0[8],P0[9],     pw0[2]=PKW(P0,4), pw0[3]=PKW(P0,6), pw0); \
    VRD(1); SBAR(); GAPA(C0=__builtin_amdgcn_mfma_f32_32x32x16_bf16(kf[2],qr[1],C0,0,0,0),   P0[10],P0[11],P0[12],P0[13], pw1[0]=PKW(P0,8), pw1[1]=PKW(P0,10), pw1); \
    VRD(5); SBAR(); GAPA(C1=__builtin_amdgcn_mfma_f32_32x32x16_bf16(kf[3],qr[1],C1,0,0,0),   P0[14],P0[15],P1[0],P1[1],   pw1[2]=PKW(P0,12),pw1[3]=PKW(P0,14), pw1); \
    VRD(2); SBAR(); GAPA(C0=__builtin_amdgcn_mfma_f32_32x32x16_bf16(kf[4],qr[2],C0,0,0,0),   P1[2],P1[3],P1[4],P1[5],     pw2[0]=PKW(P1,0), pw2[1]=PKW(P1,2), pw2); \
    VRD(6); SBAR(); GAPA(C1=__builtin_amdgcn_mfma_f32_32x32x16_bf16(kf[5],qr[2],C1,0,0,0),   P1[6],P1[7],P1[8],P1[9],     pw2[2]=PKW(P1,4), pw2[3]=PKW(P1,6), pw2); \
    VRD(3); SBAR(); GAPA(C0=__builtin_amdgcn_mfma_f32_32x32x16_bf16(kf[6],qr[3],C0,0,0,0),   P1[10],P1[11],P1[12],P1[13], pw3[0]=PKW(P1,8), pw3[1]=PKW(P1,10), pw3); \
    VRD(7); SBAR(); GAPA(C1=__builtin_amdgcn_mfma_f32_32x32x16_bf16(kf[7],qr[3],C1,0,0,0),   P1[14],P1[15],0.f,0.f,       pw3[2]=PKW(P1,12),pw3[3]=PKW(P1,14), pw3); \
    l_reg+=sacc; \
    if(GK){DMA_K((t)+3,sl_cur);} if(GV){DMA_V((t)+1,sl_next);} \
    CMASK(C0,C1,t); \
    { float a=MX3(C0[0],C0[1],C1[0]),b=MX3(C0[2],C0[3],C1[1]); a=MX3(a,C1[2],C1[3]); \
      _Pragma("unroll") for(int r=4;r<16;r+=4){a=MX3(a,C0[r],C0[r+1]);b=MX3(b,C0[r+2],C0[r+3]);a=MX3(a,C1[r],C1[r+1]);b=MX3(b,C1[r+2],C1[r+3]);} \
      float rm=__builtin_fmaxf(a,b); { auto rr=__builtin_amdgcn_permlane32_swap(__float_as_uint(rm),__float_as_uint(rm),false,false); rm=__builtin_fmaxf(__uint_as_float(rr[0]),__uint_as_float(rr[1])); } \
      resc=false; \
      if(__builtin_expect(__any(rm>(float)THRL),0)){ const float dl=__builtin_fmaxf(rm,0.f); mhat+=dl; \
        _Pragma("unroll") for(int r=0;r<16;++r){C0[r]-=dl;C1[r]-=dl;} \
        nmh=-mhat; \
        const float f=__builtin_amdgcn_exp2f(-dl); l_reg*=f; if(hi==0)wsf[r32]=f; resc=true; } } \
    SBAR(); \
    GAPB(o[0]=__builtin_amdgcn_mfma_f32_32x32x16_bf16(PAF(0),VFR(0),o[0],0,0,0), C0,0); \
    GAPB(o[1]=__builtin_amdgcn_mfma_f32_32x32x16_bf16(PAF(0),VFR(4),o[1],0,0,0), C0,4); \
    KRD(GL,0); GAPB(o[0]=__builtin_amdgcn_mfma_f32_32x32x16_bf16(PAF(1),VFR(1),o[0],0,0,0), C0,8); \
    KRD(GL,1); GAPB(o[1]=__builtin_amdgcn_mfma_f32_32x32x16_bf16(PAF(1),VFR(5),o[1],0,0,0), C0,12); \
    KRD(GL,2); GAPB(o[0]=__builtin_amdgcn_mfma_f32_32x32x16_bf16(PAF(2),VFR(2),o[0],0,0,0), C1,0); \
    KRD(GL,3); GAPB(o[1]=__builtin_amdgcn_mfma_f32_32x32x16_bf16(PAF(2),VFR(6),o[1],0,0,0), C1,4); \
    GAPB(o[0]=__builtin_amdgcn_mfma_f32_32x32x16_bf16(PAF(3),VFR(3),o[0],0,0,0), C1,8); \
    GAPB(o[1]=__builtin_amdgcn_mfma_f32_32x32x16_bf16(PAF(3),VFR(7),o[1],0,0,0), C1,12); \
    }while(0)
  int t=1;
  #undef CMASK
  #define CMASK(P0,P1,t) do{}while(0)
  for(;t+5<NT;t+=2){
    STEP(pB0,pB1,pA0,pA1,t,true,true,true);     WAIT_BAR(2); RESC(); ROT();
    STEP(pA0,pA1,pB0,pB1,t+1,true,true,true);   WAIT_BAR(2); RESC(); ROT();
  }
  #undef CMASK
  #define CMASK(P0,P1,t) do{int jb_=(t)-(NT-4); if(jb_>=0)cmask(P0,P1,jb_,qrel,hi);}while(0)
  #define ENDW(tt) do{ if((tt)+3<NT){WAIT_BAR(2);} else if((tt)+2<NT){WAIT_BAR(1);} else {WAIT_BAR(0);} }while(0)
  for(;t+1<NT;t+=2){
    STEP(pB0,pB1,pA0,pA1,t,(t+3<NT),(t+1<NT),(t+1<NT));       ENDW(t);   RESC(); ROT();
    STEP(pA0,pA1,pB0,pB1,t+1,(t+4<NT),(t+2<NT),(t+2<NT));     ENDW(t+1); RESC(); ROT();
  }
  STEP(pB0,pB1,pA0,pA1,NT-1,false,false,false); RESC();
  { float sacc=pB0[0]+pB0[1]; _Pragma("unroll") for(int r=2;r<16;++r)sacc+=pB0[r]; _Pragma("unroll") for(int r=0;r<16;++r)sacc+=pB1[r]; l_reg+=sacc;
    pw0=(u32x4){PKW(pB0,0),PKW(pB0,2),PKW(pB0,4),PKW(pB0,6)};pw1=(u32x4){PKW(pB0,8),PKW(pB0,10),PKW(pB0,12),PKW(pB0,14)};pw2=(u32x4){PKW(pB1,0),PKW(pB1,2),PKW(pB1,4),PKW(pB1,6)};pw3=(u32x4){PKW(pB1,8),PKW(pB1,10),PKW(pB1,12),PKW(pB1,14)};
    SBAR(); pv(o,vb0+sl_cur,PAF(0),PAF(1),PAF(2),PAF(3)); }
  #undef PKW
  #undef PAF
  #undef VFR
  #undef PIN
  #undef MX3
  #undef GAPA
  #undef GAPB
  #undef EX
  #undef VRD
  #undef KRD
  #undef STEP
  #undef ENDW
  {auto rr=__builtin_amdgcn_permlane32_swap(__float_as_uint(l_reg),__float_as_uint(l_reg),false,false);l_reg=__uint_as_float(rr[0])+__uint_as_float(rr[1]);}
  if(hi==0)wsf[32+r32]=l_reg;asm volatile("s_waitcnt lgkmcnt(0)":::"memory");
  float rli[16];
  #pragma unroll
  for(int r=0;r<16;++r)rli[r]=__builtin_amdgcn_rcpf(wsf[32+crow(r,hi)]);
  bf16*Ow=O+(rowbase+q0+wid*QBLK)*DMO+ocol;
  { bf16*stg=(bf16*)(shm+LDS_OST)+wid*2048;
    #pragma unroll
    for(int r=0;r<16;++r){const int orow=crow(r,hi);
      #pragma unroll
      for(int d0=0;d0<2;++d0)stg[orow*64+d0*32+r32]=__float2bfloat16(o[d0][r]*rli[r]);}
    asm volatile("s_waitcnt lgkmcnt(0)":::"memory");
    #pragma unroll
    for(int i=0;i<4;++i){const int row=i*8+(lane>>3),ch=lane&7; const u32x4 v=*(const u32x4*)(stg+row*64+ch*8); ATTN_STORE16(Ow+(long)row*DMO+ch*8,v);} }
  asm volatile("s_waitcnt lgkmcnt(0)\n\ts_barrier":::"memory");
  #undef DMA_K
  #undef DMA_V
  #undef CMASK
  #undef CINIT
  #undef START
  #undef RESC
  #undef ROT
}
constexpr int ATTN_LDS_BYTES=LDS_BYTES;
#undef SBAR
#undef WAIT_BAR
#undef FLAS
}
constexpr int NWAVES = 8;
constexpr int BATCH = 8, SEQ = 4096, DM = 1024, DFF = 2816, TOK = BATCH * SEQ;
constexpr int NWIN = 5376;
constexpr int MH = 4, MDK = 64, MDV = 128, FH = 8, FD = 64, CH = 64, NCH = SEQ / CH;
constexpr float EPS = 1e-6f;
constexpr float LOG2E = 1.4426950408889634f;
constexpr float QC2 = 0.125f * LOG2E;

constexpr size_t MiB = 1u << 20;
constexpr size_t WS_CTL = 0, CTL_ZERO_BYTES = 1 * MiB;
constexpr size_t WS_W1GU = 2 * MiB;
constexpr size_t WS_W1D = 13 * MiB;
constexpr size_t WS_W2GU = 19 * MiB;
constexpr size_t WS_W2D = 30 * MiB;
constexpr size_t WS_WIN = 36 * MiB;
constexpr size_t WS_WAB = 47 * MiB;
constexpr size_t WS_WOUT = 49 * MiB;
constexpr size_t WS_WPG = 51 * MiB;
constexpr size_t WS_WPP = 53 * MiB;
constexpr size_t WS_GATES = 54 * MiB;
constexpr size_t WS_MA = 56 * MiB;
constexpr size_t WS_MB = 56 * MiB + 512 * 1024;
constexpr size_t WS_MSC = 57 * MiB;
constexpr size_t WS_MDN = 57 * MiB + 256 * 1024;
constexpr size_t WS_FCS = 58 * MiB;
constexpr size_t WS_FCT = 59 * MiB;
constexpr size_t WS_XN = 64 * MiB;
constexpr size_t WS_Y = 128 * MiB;
constexpr size_t WS_R = 192 * MiB;
constexpr size_t WS_H = WS_R;
constexpr size_t WS_PB = WS_R + 176 * MiB;
constexpr size_t WS_EMB = WS_R + 192 * MiB;
constexpr size_t WS_SEG0 = WS_R;
constexpr size_t WS_GA = WS_R + 192 * MiB, WS_GB = WS_R + 256 * MiB;
constexpr size_t WS_QK = WS_Y;
constexpr size_t WS_CST = WS_Y + 32 * MiB;
constexpr size_t WS_END = 512 * MiB;
constexpr int CW_TMO = 0, CW_CODE = 1, CW_DBG = 64, CW_BAR = 4096;

constexpr int RING_OFF = 0, RING_BYTES = 131072;
constexpr int LDSCTL_OFF = RING_BYTES, MISC_OFF = LDSCTL_OFF + 320;
constexpr int LDS_BYTES = 147456;

#define GAS __attribute__((address_space(1)))
#define LAS __attribute__((address_space(3)))
typedef unsigned short bf16;
typedef unsigned v4u __attribute__((ext_vector_type(4)));
typedef unsigned v2u __attribute__((ext_vector_type(2)));
typedef float f32x4 __attribute__((ext_vector_type(4)));
typedef short bf16x8 __attribute__((ext_vector_type(8)));
typedef GAS unsigned gu32;
#define RLX_AGENT __ATOMIC_RELAXED, __HIP_MEMORY_SCOPE_AGENT
#define LDS_WAIT() asm volatile("s_waitcnt lgkmcnt(0)" ::: "memory")
#define VM_WAIT() asm volatile("s_waitcnt vmcnt(0)" ::: "memory")
__device__ __forceinline__ unsigned f2bf(float f) { unsigned u = __builtin_bit_cast(unsigned, f); return (u + 0x7fffu + ((u >> 16) & 1u)) >> 16; }
__device__ __forceinline__ unsigned pk2(float lo, float hi) { return f2bf(lo) | (f2bf(hi) << 16); }
__device__ __forceinline__ float bf2f(unsigned short h) { return __uint_as_float(((unsigned)h) << 16); }

#define XB_TMO      128
#define XB_XCNT(j)  (256  + 64 * (j))
#define XB_XSUB(j)  (1280 + 64 * (j))
#define XB_XGEN(j)  (2304 + 64 * (j))
#define XB_TOP      3328
#define XB_TOPGEN   3392
#define XCD_BAR_WORDS 3456
#define XB_SPIN_CAP (1u << 20)
__device__ __forceinline__ unsigned xb_ld(unsigned* p)              { return __hip_atomic_load(p, __ATOMIC_RELAXED, __HIP_MEMORY_SCOPE_AGENT); }
__device__ __forceinline__ unsigned xb_add(unsigned* p, unsigned v) { return __hip_atomic_fetch_add(p, v, __ATOMIC_RELAXED, __HIP_MEMORY_SCOPE_AGENT); }
__device__ __forceinline__ unsigned xb_xcc_id() { return (unsigned)__builtin_amdgcn_s_getreg((3 << 11) | 20) & 0xFu; }
#define XB_SPIN(cond, bar) do { unsigned _sp = 0; while (cond) { __builtin_amdgcn_s_sleep(1); \
    if ((++_sp & 255u) == 0u) { if (xb_ld(&(bar)[XB_TMO])) break; if (_sp > XB_SPIN_CAP) { atomicAdd(&(bar)[XB_TMO], 1u); break; } } } } while (0)
struct XcdBarrier { unsigned* bar; unsigned x; volatile LAS unsigned* st; };
__device__ __forceinline__ XcdBarrier xcd_barrier_post(unsigned* bar, volatile LAS unsigned* st) {
    XcdBarrier b; b.bar = bar; b.x = xb_xcc_id(); b.st = st;
    if (threadIdx.x == 0) (void)xb_add(&bar[XB_XCNT(b.x)], 1u);
    return b;
}
__device__ __forceinline__ void xcd_barrier_complete(unsigned* bar, unsigned x, unsigned& nloc, unsigned& nx) {
    const unsigned G = gridDim.x * gridDim.y * gridDim.z;
    unsigned sum, cnt, mine, sp = 0u;
    for (;;) {
        sum = 0u; cnt = 0u; mine = 0u;
#pragma unroll
        for (unsigned j = 0; j < 16; ++j) { const unsigned c = xb_ld(&bar[XB_XCNT(j)]); sum += c; cnt += (c > 0u) ? 1u : 0u; mine = (j == x) ? c : mine; }
        if (sum == G) break;
        __builtin_amdgcn_s_sleep(1);
        if ((++sp & 255u) == 0u) { if (xb_ld(&bar[XB_TMO])) break; if (sp > XB_SPIN_CAP) { atomicAdd(&bar[XB_TMO], 1u); break; } }
    }
    nloc = mine > 0u ? mine : 1u; nx = cnt > 0u ? cnt : 1u;
}
__device__ __forceinline__ void xcd_barrier(const XcdBarrier& b) {
    asm volatile("s_waitcnt vmcnt(0)" ::: "memory");
    __syncthreads();
    if (threadIdx.x == 0) {
        unsigned* bar = b.bar;
        __builtin_amdgcn_s_waitcnt(0);
        unsigned nloc = b.st[0], nx = b.st[1];
        if (nloc == 0u) { xcd_barrier_complete(bar, b.x, nloc, nx); b.st[0] = nloc; b.st[1] = nx; }
        const unsigned old = xb_add(&bar[XB_XSUB(b.x)], 1u);
        const unsigned gen = old / nloc;
        if (old + 1u == (gen + 1u) * nloc) {
            __builtin_amdgcn_fence(__ATOMIC_RELEASE, "agent");
            asm volatile("s_waitcnt vmcnt(0)" ::: "memory");
            const unsigned og = xb_add(&bar[XB_TOP], 1u);
            const unsigned tg = og / nx;
            if (og + 1u == (tg + 1u) * nx) xb_add(&bar[XB_TOPGEN], 1u);
            else XB_SPIN(xb_ld(&bar[XB_TOPGEN]) == tg, bar);
            __builtin_amdgcn_fence(__ATOMIC_ACQUIRE, "agent");
            xb_add(&bar[XB_XGEN(b.x)], 1u);
            asm volatile("s_waitcnt vmcnt(0)" ::: "memory");
        } else {
            XB_SPIN(xb_ld(&bar[XB_XGEN(b.x)]) == gen, bar);
            __builtin_amdgcn_fence(__ATOMIC_ACQUIRE, "agent");
            asm volatile("s_waitcnt vmcnt(0)" ::: "memory");
        }
    }
    __syncthreads();
}

struct Args { const float* in[30]; float* out; unsigned char* ws; int ph_lo, ph_hi; };
static_assert(sizeof(Args) == 32 * 8 + 8, "Args has no padding");
struct Frame {
    LAS unsigned char* lds;
    volatile LAS unsigned* MISC;
    gu32* ctl;
    int tid, lane, wave;
    int vcu, G;
    unsigned char* ws;
    const Args* A;
    float* out;
};
__device__ __forceinline__ float wave_sum(float v) {
#pragma unroll
    for (int o = 1; o < 64; o <<= 1) v += __shfl_xor(v, o);
    return v;
}
__device__ __forceinline__ float wave_max(float v) {
#pragma unroll
    for (int o = 1; o < 64; o <<= 1) v = fmaxf(v, __shfl_xor(v, o));
    return v;
}

__device__ __forceinline__ void xpose_item(const float* W, int Nsrc, int k0, int srccol, bf16* WT, int ldd, int drow0, int dcol0, LAS float* scr, int lane) {
#pragma unroll 8
    for (int i = 0; i < 32; ++i) { const int kk = 2 * i + (lane >> 5); scr[kk * 33 + (lane & 31)] = (srccol >= 0) ? W[(size_t)(k0 + kk) * Nsrc + srccol] : 0.f; }
    LDS_WAIT(); asm volatile("" ::: "memory");
    const int c = lane & 7;
#pragma unroll
    for (int j = 0; j < 4; ++j) { const int n = (lane >> 3) + 8 * j; const LAS float* s = scr + (8 * c) * 33 + n;
        v4u o; o.x = pk2(s[0 * 33], s[1 * 33]); o.y = pk2(s[2 * 33], s[3 * 33]); o.z = pk2(s[4 * 33], s[5 * 33]); o.w = pk2(s[6 * 33], s[7 * 33]);
        *(GAS v4u*)(WT + (size_t)(drow0 + n) * ldd + dcol0 + 8 * c) = o; }
    LDS_WAIT(); asm volatile("" ::: "memory");
}
__device__ __forceinline__ void rms_row_to_bf16(int lane, const float* xrow, const float* g, bf16* orow) {
    const GAS f32x4* xr = (const GAS f32x4*)xrow + lane; const GAS f32x4* gr = (const GAS f32x4*)g + lane;
    f32x4 v[4]; float s = 0.f;
#pragma unroll
    for (int j = 0; j < 4; ++j) { v[j] = xr[64 * j]; s += (v[j].x * v[j].x + v[j].y * v[j].y) + (v[j].z * v[j].z + v[j].w * v[j].w); }
    const float r = 1.f / sqrtf(wave_sum(s) * (1.f / DM) + EPS);
    GAS v2u* o8 = (GAS v2u*)orow + lane;
#pragma unroll
    for (int j = 0; j < 4; ++j) { const f32x4 gg = gr[64 * j]; v2u w; w.x = pk2(v[j].x * r * gg.x, v[j].y * r * gg.y); w.y = pk2(v[j].z * r * gg.z, v[j].w * r * gg.w); o8[64 * j] = w; }
}
__device__ __forceinline__ void p0_prologue(Frame& F) {
    LAS float* scr = (LAS float*)(F.lds + RING_OFF + F.wave * 16384);
    const int gw = F.vcu * NWAVES + F.wave, NGW = F.G * NWAVES; const int lane = F.lane, l31 = lane & 31;
    unsigned char* ws = F.ws;
    constexpr int I0 = 2816, I1 = 1408, I4 = 2688, I5 = 256, I6 = 512, I8 = 128;
    constexpr int NITEMS = 2 * (I0 + I1) + I4 + 2 * I5 + 2 * I6 + I8;
    for (int it = gw; it < NITEMS; it += NGW) {
        int r = it;
        if (r < 2 * (I0 + I1)) {
            const int l2 = r >= (I0 + I1); if (l2) r -= (I0 + I1);
            if (r < I0) {
                const int kb = r / 176, g = r % 176, j = g >> 3, sub = g & 7;
                const float* W = l2 ? ((sub >> 2) ? F.A->in[22] : F.A->in[21]) : ((sub >> 2) ? F.A->in[4] : F.A->in[3]);
                xpose_item(W, DFF, 64 * kb, 128 * j + 32 * (sub & 3) + l31, (bf16*)(ws + (l2 ? WS_W2GU : WS_W1GU)), DM, 32 * g, 64 * kb, scr, lane);
            } else { r -= I0;
                const int kb = r / 32, g = r % 32;
                xpose_item(l2 ? F.A->in[23] : F.A->in[5], DM, 64 * kb, 32 * g + l31, (bf16*)(ws + (l2 ? WS_W2D : WS_W1D)), DFF, 32 * g, 64 * kb, scr, lane);
            }
            continue;
        }
        r -= 2 * (I0 + I1);
        if (r < I4) {
            const int kb = r / 168, g = r % 168, r0 = 32 * g; int sc;
            if (r0 < 1536) sc = r0 + l31; else if (r0 < 3072) sc = r0 + 8 + l31; else if (r0 < 5120) sc = r0 + 16 + l31;
            else if (r0 == 5120) sc = (l31 < 8) ? 1536 + l31 : (l31 < 16) ? 3080 + (l31 - 8) : -1; else sc = -1;
            xpose_item(F.A->in[8], 5136, 64 * kb, sc, (bf16*)(ws + WS_WIN), DM, r0, 64 * kb, scr, lane);
            continue;
        }
        r -= I4;
        if (r < 2 * I5) { const int hb = r >= I5; if (hb) r -= I5; const int kb = r / 32, g = r % 32;
            xpose_item(hb ? F.A->in[17] : F.A->in[16], DM, 64 * kb, 32 * g + l31, (bf16*)(ws + WS_WAB), DM, 32 * g, 512 * hb + 64 * kb, scr, lane); continue; }
        r -= 2 * I5;
        if (r < 2 * I6) { const int hb = r >= I6; if (hb) r -= I6; const int kb = r / 32, g = r % 32;
            xpose_item(hb ? F.A->in[26] : F.A->in[18], DM, 64 * kb, 32 * g + l31, (bf16*)(ws + (hb ? WS_WPG : WS_WOUT)), DM, 32 * g, 64 * kb, scr, lane); continue; }
        r -= 2 * I6;
        { const int kb = r / 32, g = r % 32;
            xpose_item(F.A->in[28], DM, 64 * kb, 32 * g + l31, (bf16*)(ws + WS_WPP), 256, 32 * g, 64 * kb, scr, lane); }
    }
    bf16* XN = (bf16*)(ws + WS_XN);
    for (int m = gw; m < TOK; m += NGW) rms_row_to_bf16(lane, F.A->in[0] + (size_t)m * DM, F.A->in[2], XN + (size_t)m * DM);
}

template <bool HAS_XN>
__device__ __forceinline__ void ew_row(int lane, const bf16* yrow, const float* resrow, float* outrow, float coef, const float* gpost, const float* gpre, bf16* xnrow) {
    const GAS v2u* yr = (const GAS v2u*)yrow + lane; const GAS f32x4* rr = (const GAS f32x4*)resrow + lane; const GAS f32x4* gp = (const GAS f32x4*)gpost + lane;
    f32x4 y[4], h[4]; float s = 0.f;
#pragma unroll
    for (int j = 0; j < 4; ++j) { const v2u w = yr[64 * j]; y[j].x = __uint_as_float(w.x << 16); y[j].y = __uint_as_float(w.x & 0xffff0000u); y[j].z = __uint_as_float(w.y << 16); y[j].w = __uint_as_float(w.y & 0xffff0000u);
        h[j] = rr[64 * j]; s += (y[j].x * y[j].x + y[j].y * y[j].y) + (y[j].z * y[j].z + y[j].w * y[j].w); }
    const float r = coef / sqrtf(wave_sum(s) * (1.f / DM) + EPS);
    float s2 = 0.f;
    GAS f32x4* orow = (GAS f32x4*)outrow + lane;
#pragma unroll
    for (int j = 0; j < 4; ++j) { const f32x4 g = gp[64 * j]; h[j] = h[j] + y[j] * r * g; orow[64 * j] = h[j];
        s2 += (h[j].x * h[j].x + h[j].y * h[j].y) + (h[j].z * h[j].z + h[j].w * h[j].w); }
    if constexpr (HAS_XN) {
        const float r2 = 1.f / sqrtf(wave_sum(s2) * (1.f / DM) + EPS);
        const GAS f32x4* gq = (const GAS f32x4*)gpre + lane; GAS v2u* o8 = (GAS v2u*)xnrow + lane;
#pragma unroll
        for (int j = 0; j < 4; ++j) { const f32x4 g = gq[64 * j]; v2u w; w.x = pk2(h[j].x * r2 * g.x, h[j].y * r2 * g.y); w.y = pk2(h[j].z * r2 * g.z, h[j].w * r2 * g.w); o8[64 * j] = w; }
    }
}
template <bool HAS_XN>
__device__ __forceinline__ void ew_phase(Frame& F, const bf16* Y, const float* res, float* out, float coef, const float* gpost, const float* gpre, bf16* XN) {
    const int gw = F.vcu * NWAVES + F.wave, NGW = F.G * NWAVES;
    for (int m = gw; m < TOK; m += NGW) ew_row<HAS_XN>(F.lane, Y + (size_t)m * DM, res + (size_t)m * DM, out + (size_t)m * DM, coef, gpost, gpre, XN + (size_t)m * DM);
}
typedef float f32x16 __attribute__((ext_vector_type(16)));
#define MFMA32(a, b, c) __builtin_amdgcn_mfma_f32_32x32x16_bf16(a, b, c, 0, 0, 0)
__device__ __forceinline__ int crow16(int r, int hi) { return (r & 3) + 8 * (r >> 2) + 4 * hi; }
__device__ __forceinline__ float log_sigmoid_f(float x) { return fminf(x, 0.f) - log1pf(expf(-fabsf(x))); }
__device__ __forceinline__ float wave_incl_scan_add(float v, int lane) {
#pragma unroll
    for (int o = 1; o < 64; o <<= 1) { const float t = __shfl_up(v, o); if (lane >= o) v += t; }
    return v;
}
__device__ __forceinline__ float wave_incl_scan_max(float v, int lane) {
#pragma unroll
    for (int o = 1; o < 64; o <<= 1) { const float t = __shfl_up(v, o); if (lane >= o) v = fmaxf(v, t); }
    return v;
}
__device__ __forceinline__ int swap23(int s) { return (s & ~12) | ((s & 4) << 1) | ((s & 8) >> 1); }
constexpr int LP = 72;

__device__ __forceinline__ void m1_unit(Frame& F, int b, int c, int h) {
    unsigned char* ws = F.ws; LAS unsigned char* L = F.lds;
    const int tid = F.tid, lane = F.lane, wave = F.wave;
    const int tok0 = b * SEQ + c * CH, uidx = (b * MH + h) * NCH + c;
    LAS bf16* LKT = (LAS bf16*)(L);
    LAS bf16* LVT = (LAS bf16*)(L + 64 * LP * 2);
    LAS float* LW = (LAS float*)(L + 64 * LP * 2 + 128 * LP * 2);
    const float* gates = (const float*)(ws + WS_GATES);
    if (wave == 0) {
        const float* gr = gates + (size_t)(tok0 + lane) * 16;
        const float ig = gr[h], lf = log_sigmoid_f(gr[4 + h]);
        const float bs = wave_incl_scan_add(lf, lane), a = ig - bs, amax = wave_max(a);
        ((float*)(ws + WS_MA))[(size_t)(b * MH + h) * SEQ + c * CH + lane] = a;
        ((float*)(ws + WS_MB))[(size_t)(b * MH + h) * SEQ + c * CH + lane] = bs;
        LW[lane] = __expf(a - amax);
        if (lane == 63) { float* sc = (float*)(ws + WS_MSC); sc[uidx] = amax; sc[BATCH * MH * NCH + uidx] = bs; }
    } else if (wave <= 2) {
        const int fh = 2 * h + (wave - 1);
        const float lf = log_sigmoid_f(gates[(size_t)(tok0 + lane) * 16 + 8 + fh]) * LOG2E;
        const float cs = wave_incl_scan_add(lf, lane);
        ((float*)(ws + WS_FCS))[(size_t)(b * FH + fh) * SEQ + c * CH + lane] = cs;
        if (lane == 63) ((float*)(ws + WS_FCT))[(b * FH + fh) * NCH + c] = cs;
    }
    LDS_WAIT(); __syncthreads();
    const int tt = tid >> 3, cg = tid & 7;
    {
        const bf16* mqk = (const bf16*)(ws + WS_SEG0);
        const float* cw = F.A->in[9]; const float* cb = F.A->in[10];
        float q[8], k[8];
#pragma unroll
        for (int part = 0; part < 2; ++part) {
            const int ch0 = part * 256 + 64 * h + 8 * cg;
            float accv[8];
#pragma unroll
            for (int e = 0; e < 8; ++e) accv[e] = cb[ch0 + e];
#pragma unroll
            for (int j = 0; j < 4; ++j) {
                const int ts = c * CH + tt - 3 + j;
                if (ts >= 0) {
                    const v4u w = *(const v4u*)(mqk + (size_t)(b * SEQ + ts) * 512 + ch0);
                    const f32x4 w0 = *(const f32x4*)(cw + j * 512 + ch0), w1 = *(const f32x4*)(cw + j * 512 + ch0 + 4);
                    accv[0] += w0.x * pg8::bf_lo(w.x); accv[1] += w0.y * pg8::bf_hi(w.x); accv[2] += w0.z * pg8::bf_lo(w.y); accv[3] += w0.w * pg8::bf_hi(w.y);
                    accv[4] += w1.x * pg8::bf_lo(w.z); accv[5] += w1.y * pg8::bf_hi(w.z); accv[6] += w1.z * pg8::bf_lo(w.w); accv[7] += w1.w * pg8::bf_hi(w.w);
                }
            }
#pragma unroll
            for (int e = 0; e < 8; ++e) { const float sv = accv[e] * pg8::sigmoid_f(accv[e]); if (part == 0) q[e] = sv; else k[e] = sv * 0.125f; }
        }
        bf16* qk = (bf16*)(ws + WS_QK) + (size_t)(tok0 + tt) * 512;
        v4u wq, wk; wq.x = pk2(q[0], q[1]); wq.y = pk2(q[2], q[3]); wq.z = pk2(q[4], q[5]); wq.w = pk2(q[6], q[7]);
        wk.x = pk2(k[0], k[1]); wk.y = pk2(k[2], k[3]); wk.z = pk2(k[4], k[5]); wk.w = pk2(k[6], k[7]);
        *(v4u*)(qk + 64 * h + 8 * cg) = wq; *(v4u*)(qk + 256 + 64 * h + 8 * cg) = wk;
        const float wgt = LW[tt]; const int pos = swap23(tt);
        const unsigned kw[4] = {wk.x, wk.y, wk.z, wk.w};
#pragma unroll
        for (int e = 0; e < 8; ++e) { const float kv = (e & 1) ? pg8::bf_hi(kw[e >> 1]) : pg8::bf_lo(kw[e >> 1]); LKT[(8 * cg + e) * LP + pos] = (bf16)f2bf(kv * wgt); }
        const bf16* mv = (const bf16*)(ws + WS_SEG0 + 32 * MiB) + (size_t)(tok0 + tt) * 512 + 128 * h + 16 * cg;
        const v4u v0 = *(const v4u*)mv, v1 = *(const v4u*)(mv + 8);
        const unsigned vw[8] = {v0.x, v0.y, v0.z, v0.w, v1.x, v1.y, v1.z, v1.w};
#pragma unroll
        for (int e = 0; e < 16; ++e) LVT[(16 * cg + e) * LP + pos] = (bf16)((e & 1) ? (vw[e >> 1] >> 16) : (vw[e >> 1] & 0xffffu));
    }
    LDS_WAIT(); __syncthreads();
    {
        const int r = lane & 31, hi = lane >> 5, dvt = wave >> 1, dkt = wave & 1;
        f32x16 acc = {};
#pragma unroll
        for (int ks = 0; ks < 4; ++ks) {
            const bf16x8 av = *(const LAS bf16x8*)(LVT + (32 * dvt + r) * LP + 16 * ks + 8 * hi);
            const bf16x8 bk = *(const LAS bf16x8*)(LKT + (32 * dkt + r) * LP + 16 * ks + 8 * hi);
            acc = MFMA32(av, bk, acc);
        }
        bf16* dst = (bf16*)(ws + WS_CST) + (size_t)uidx * (MDV * MDK) + 32 * dkt + r;
#pragma unroll
        for (int rg = 0; rg < 16; ++rg) dst[(size_t)(32 * dvt + crow16(rg, hi)) * MDK] = (bf16)f2bf(acc[rg]);
        if (wave == 0) {
            float s = 0.f;
#pragma unroll
            for (int j = 0; j < 8; ++j) { const v4u w = *(const LAS v4u*)(LKT + lane * LP + 8 * j);
                s += (pg8::bf_lo(w.x) + pg8::bf_hi(w.x)) + (pg8::bf_lo(w.y) + pg8::bf_hi(w.y)) + (pg8::bf_lo(w.z) + pg8::bf_hi(w.z)) + (pg8::bf_lo(w.w) + pg8::bf_hi(w.w)); }
            ((float*)(ws + WS_MDN))[(size_t)uidx * 64 + lane] = s;
        }
    }
    LDS_WAIT(); __syncthreads();
}
__device__ __forceinline__ void m1_phase(Frame& F) {
    for (int u = F.vcu; u < BATCH * NCH * MH; u += F.G) { const int h = u & 3, c = (u >> 2) & 63, b = u >> 8; m1_unit(F, b, c, h); }
}

__device__ __forceinline__ void m2_phase(Frame& F) {
    unsigned char* ws = F.ws; const int tid = F.tid;
    const float* sc = (const float*)(ws + WS_MSC); float* mstv = (float*)(ws + WS_MSC) + 2 * BATCH * MH * NCH;
    for (int job = F.vcu; job < BATCH * MH * 8; job += F.G) {
        const int bh = job >> 3, part = job & 7;
        unsigned* cst = (unsigned*)(ws + WS_CST) + (size_t)bh * NCH * (MDV * MDK / 2) + part * 512 + tid;
        float* dn = (float*)(ws + WS_MDN) + (size_t)bh * NCH * 64 + tid;
        float c0 = 0.f, c1 = 0.f, nn = 0.f, mst = 0.f;
        const bool do_n = (part == 0 && tid < 64), do_m = (part == 1 && tid == 0);
#pragma unroll 4
        for (int c = 0; c < NCH; ++c) {
            const float amax = sc[bh * NCH + c], blast = sc[BATCH * MH * NCH + bh * NCH + c];
            const float mu = fmaxf(mst, amax), d1 = __expf(mst - mu), d2 = __expf(amax - mu);
            if (do_m) mstv[bh * NCH + c] = mst;
            const unsigned w = cst[(size_t)c * (MDV * MDK / 2)];
            c0 = d1 * c0 + d2 * pg8::bf_lo(w); c1 = d1 * c1 + d2 * pg8::bf_hi(w);
            cst[(size_t)c * (MDV * MDK / 2)] = pk2(c0, c1);
            if (do_n) { nn = d1 * nn + d2 * dn[c * 64]; dn[c * 64] = nn; }
            mst = blast + mu;
        }
    }
    const int gw = F.vcu * NWAVES + F.wave;
    if (gw < BATCH * FH) {
        const float tot = ((const float*)(ws + WS_FCT))[gw * NCH + F.lane];
        const float incl = wave_incl_scan_add(tot, F.lane), excl = incl - tot;
        float* cs = (float*)(ws + WS_FCS) + (size_t)gw * SEQ;
        for (int c = 0; c < NCH; ++c) { const float off = __shfl(excl, c); cs[c * CH + F.lane] += off; }
    }
}

__device__ __forceinline__ void m3_unit(Frame& F, int b, int c, int h) {
    unsigned char* ws = F.ws; LAS unsigned char* L = F.lds;
    const int tid = F.tid, lane = F.lane, wave = F.wave;
    const int tok0 = b * SEQ + c * CH, uidx = (b * MH + h) * NCH + c;
    LAS bf16* LQ = (LAS bf16*)(L);
    LAS bf16* LK = (LAS bf16*)(L + 9216);
    LAS bf16* LVT = (LAS bf16*)(L + 18432);
    LAS bf16* LCT = (LAS bf16*)(L + 36864);
    LAS float* LH = (LAS float*)(L + 55296);
    LAS float* LSC = (LAS float*)(L + 89088);
    LAS float* LWS = (LAS float*)(L + 89088 + 2048) + wave * 64;
    const int tt = tid >> 3, cg = tid & 7;
    {
        const bf16* qk = (const bf16*)(ws + WS_QK) + (size_t)(tok0 + tt) * 512;
        *(LAS v4u*)(LQ + tt * LP + 8 * cg) = *(const v4u*)(qk + 64 * h + 8 * cg);
        *(LAS v4u*)(LK + tt * LP + 8 * cg) = *(const v4u*)(qk + 256 + 64 * h + 8 * cg);
        const bf16* mv = (const bf16*)(ws + WS_SEG0 + 32 * MiB) + (size_t)(tok0 + tt) * 512 + 128 * h + 16 * cg;
        const v4u v0 = *(const v4u*)mv, v1 = *(const v4u*)(mv + 8);
        const unsigned vw[8] = {v0.x, v0.y, v0.z, v0.w, v1.x, v1.y, v1.z, v1.w}; const int pos = swap23(tt);
#pragma unroll
        for (int e = 0; e < 16; ++e) LVT[(16 * cg + e) * LP + pos] = (bf16)((e & 1) ? (vw[e >> 1] >> 16) : (vw[e >> 1] & 0xffffu));
        const int dv = tid >> 2, c16 = (tid & 3) * 16;
        v4u s0 = {0u, 0u, 0u, 0u}, s1 = {0u, 0u, 0u, 0u};
        if (c > 0) { const bf16* cp = (const bf16*)(ws + WS_CST) + (size_t)(uidx - 1) * (MDV * MDK) + dv * MDK + c16; s0 = *(const v4u*)cp; s1 = *(const v4u*)(cp + 8); }
        *(LAS v4u*)(LCT + dv * LP + c16) = s0; *(LAS v4u*)(LCT + dv * LP + c16 + 8) = s1;
        if (wave == 0) {
            const float a = ((const float*)(ws + WS_MA))[(size_t)(b * MH + h) * SEQ + c * CH + lane];
            const float bs = ((const float*)(ws + WS_MB))[(size_t)(b * MH + h) * SEQ + c * CH + lane];
            const float mst = ((const float*)(ws + WS_MSC))[2 * BATCH * MH * NCH + uidx];
            const float np = (c > 0) ? ((const float*)(ws + WS_MDN))[(size_t)(uidx - 1) * 64 + lane] : 0.f;
            const float mu = fmaxf(mst, wave_incl_scan_max(a, lane));
            LSC[lane] = a; LSC[64 + lane] = mu; LSC[128 + lane] = __expf(mst - mu); LSC[192 + lane] = __expf(-(bs + mu)); LSC[256 + lane] = np;
        }
    }
    LDS_WAIT(); __syncthreads();
    {
        const int r = lane & 31, hi = lane >> 5, ti = wave >> 2, dvj = wave & 3;
        const int t = 32 * ti + r;
        const float mu_t = LSC[64 + t], inter_t = LSC[128 + t], emt_t = LSC[192 + t];
        float qn = 0.f;
#pragma unroll
        for (int j = 0; j < 4; ++j) { const v4u w = *(const LAS v4u*)(LQ + t * LP + 32 * hi + 8 * j); const f32x4 n0 = *(const LAS f32x4*)(LSC + 256 + 32 * hi + 8 * j), n1 = *(const LAS f32x4*)(LSC + 256 + 32 * hi + 8 * j + 4);
            qn += pg8::bf_lo(w.x) * n0.x + pg8::bf_hi(w.x) * n0.y + pg8::bf_lo(w.y) * n0.z + pg8::bf_hi(w.y) * n0.w + pg8::bf_lo(w.z) * n1.x + pg8::bf_hi(w.z) * n1.y + pg8::bf_lo(w.w) * n1.z + pg8::bf_hi(w.w) * n1.w; }
        qn += __shfl_xor(qn, 32);
        bf16x8 qf[4];
#pragma unroll
        for (int ks = 0; ks < 4; ++ks) qf[ks] = *(const LAS bf16x8*)(LQ + t * LP + 16 * ks + 8 * hi);
        f32x16 z1 = {}, z2 = {}; float den = 0.f;
#pragma unroll
        for (int si = 0; si < 2; ++si) {
            if (si <= ti) {
                f32x16 x = {};
#pragma unroll
                for (int ks = 0; ks < 4; ++ks) { const bf16x8 kf = *(const LAS bf16x8*)(LK + (32 * si + r) * LP + 16 * ks + 8 * hi); x = MFMA32(kf, qf[ks], x); }
#pragma unroll
                for (int g = 0; g < 4; ++g) { const f32x4 av = *(const LAS f32x4*)(LSC + 32 * si + 8 * g + 4 * hi);
#pragma unroll
                    for (int e = 0; e < 4; ++e) { const int s = 32 * si + 8 * g + 4 * hi + e; const float w = (s <= t) ? __expf(fminf(av[e] - mu_t, 0.f)) : 0.f; const float p = x[4 * g + e] * w; x[4 * g + e] = p; den += p; } }
#pragma unroll
                for (int k2 = 0; k2 < 2; ++k2) {
                    v4u pw; pw.x = pk2(x[8 * k2 + 0], x[8 * k2 + 1]); pw.y = pk2(x[8 * k2 + 2], x[8 * k2 + 3]); pw.z = pk2(x[8 * k2 + 4], x[8 * k2 + 5]); pw.w = pk2(x[8 * k2 + 6], x[8 * k2 + 7]);
                    const bf16x8 vf = *(const LAS bf16x8*)(LVT + (32 * dvj + r) * LP + 32 * si + 16 * k2 + 8 * hi);
                    z1 = MFMA32(__builtin_bit_cast(bf16x8, pw), vf, z1);
                }
            }
        }
#pragma unroll
        for (int ks = 0; ks < 4; ++ks) { const bf16x8 cf = *(const LAS bf16x8*)(LCT + (32 * dvj + r) * LP + 16 * ks + 8 * hi); z2 = MFMA32(qf[ks], cf, z2); }
        den += __shfl_xor(den, 32);
        den += inter_t * qn;
        const float rden = 1.0f / fmaxf(fabsf(den), emt_t);
        if (hi == 0) { LWS[r] = inter_t; LWS[32 + r] = rden; }
        LDS_WAIT();
#pragma unroll
        for (int g = 0; g < 4; ++g) { const f32x4 iv = *(const LAS f32x4*)(LWS + 8 * g + 4 * hi), rv = *(const LAS f32x4*)(LWS + 32 + 8 * g + 4 * hi);
#pragma unroll
            for (int e = 0; e < 4; ++e) LH[(32 * ti + 8 * g + 4 * hi + e) * 132 + 32 * dvj + r] = (z1[4 * g + e] + iv[e] * z2[4 * g + e]) * rv[e]; }
    }
    LDS_WAIT(); __syncthreads();
    {
        float v[16]; float s = 0.f;
#pragma unroll
        for (int j = 0; j < 4; ++j) { const f32x4 x = *(const LAS f32x4*)(LH + tt * 132 + 16 * cg + 4 * j); v[4 * j] = x.x; v[4 * j + 1] = x.y; v[4 * j + 2] = x.z; v[4 * j + 3] = x.w; s += (x.x + x.y) + (x.z + x.w); }
        s += __shfl_xor(s, 1); s += __shfl_xor(s, 2); s += __shfl_xor(s, 4);
        const float mean = s * (1.f / MDV); float q = 0.f;
#pragma unroll
        for (int e = 0; e < 16; ++e) { v[e] -= mean; q += v[e] * v[e]; }
        q += __shfl_xor(q, 1); q += __shfl_xor(q, 2); q += __shfl_xor(q, 4);
        const float rstd = 1.0f / sqrtf(q * (1.f / MDV) + EPS);
        const float* gn = F.A->in[13] + 128 * h + 16 * cg;
        const bf16* mo = (const bf16*)(ws + WS_SEG0 + 64 * MiB) + (size_t)(tok0 + tt) * 512 + 128 * h + 16 * cg;
        const v4u o0 = *(const v4u*)mo, o1 = *(const v4u*)(mo + 8);
        const unsigned ow[8] = {o0.x, o0.y, o0.z, o0.w, o1.x, o1.y, o1.z, o1.w};
        unsigned res[8];
#pragma unroll
        for (int e = 0; e < 8; ++e) { const float y0 = v[2 * e] * rstd * gn[2 * e] * pg8::bf_lo(ow[e]), y1 = v[2 * e + 1] * rstd * gn[2 * e + 1] * pg8::bf_hi(ow[e]); res[e] = pk2(y0, y1); }
        bf16* ya = (bf16*)(ws + WS_XN) + (size_t)(tok0 + tt) * 1024 + 128 * h + 16 * cg;
        *(v4u*)ya = (v4u){res[0], res[1], res[2], res[3]}; *(v4u*)(ya + 8) = (v4u){res[4], res[5], res[6], res[7]};
    }
    LDS_WAIT(); __syncthreads();
}
#ifndef MK_N_LAUNCHES
#define MK_N_LAUNCHES 1
#endif
constexpr int NPHASE = 16;

__device__ __forceinline__ void p7_mixer(Frame& F) {
    unsigned char* ws = F.ws;
    const fox_body::bf16* FQ = (const fox_body::bf16*)(ws + WS_SEG0 + 96 * MiB);
    const fox_body::bf16* FK = (const fox_body::bf16*)(ws + WS_SEG0 + 128 * MiB);
    const fox_body::bf16* FV = (const fox_body::bf16*)(ws + WS_SEG0 + 160 * MiB);
    fox_body::bf16* YB = (fox_body::bf16*)(ws + WS_XN);
#ifndef NO_FOX
    for (int job = F.vcu; job < BATCH * FH * 4; job += F.G) {
        const int bh = job >> 2, s = job & 3, b = bh >> 3, fh = bh & 7;
        const float* cs = (const float*)(ws + WS_FCS) + (size_t)bh * SEQ;
#pragma unroll 1
        for (int i = 0; i < 4; ++i) { const int qb = (i == 0) ? s : (i == 1) ? 7 - s : (i == 2) ? 8 + s : 15 - s;
            fox_body::attn_unit<8>(b, fh, qb, FQ, FK, FV, YB, 512 + 64 * fh, cs, (char*)F.lds); }
    }
#endif
    __syncthreads();
#ifndef NO_M3
    for (int u = F.vcu; u < BATCH * NCH * MH; u += F.G) { const int h = u & 3, c = (u >> 2) & 63, b = u >> 8; m3_unit(F, b, c, h); }
#endif
}

__global__ void __launch_bounds__(NWAVES * 64, 2) mega_fwd(Args args) {
    extern __shared__ __attribute__((aligned(16))) unsigned char lds[];
    Frame F;
    F.lds = (LAS unsigned char*)lds;
    F.MISC = (volatile LAS unsigned*)(F.lds + MISC_OFF);
    F.tid = threadIdx.x; F.lane = F.tid & 63; F.wave = __builtin_amdgcn_readfirstlane(F.tid >> 6);
    F.G = gridDim.x; { const int bx = blockIdx.x; F.vcu = (F.G % 8 == 0) ? (bx % 8) * (F.G / 8) + bx / 8 : bx; }
    F.ws = args.ws; F.out = args.out;
    F.A = &args;
    F.ctl = (gu32*)(F.ws + WS_CTL);
    for (int u = F.tid; u < (LDS_BYTES - LDSCTL_OFF) / 4; u += NWAVES * 64) ((LAS unsigned*)(F.lds + LDSCTL_OFF))[u] = 0u;
    __syncthreads();
    const int lo = args.ph_lo, hi = args.ph_hi;
    const bool use_bar = (hi - lo) > 1;
    XcdBarrier bar; bar.bar = (unsigned*)(F.ctl + CW_BAR); bar.x = 0; bar.st = nullptr;
    if (use_bar) bar = xcd_barrier_post((unsigned*)(F.ctl + CW_BAR), F.MISC + 8);
#ifndef PHMASK
#define PHMASK 0xffff
#endif
#define IN(k) (((PHMASK >> (k)) & 1) && lo <= (k) && (k) < hi)
#define SEAM(k) do { if (IN(k) && IN((k) + 1)) xcd_barrier(bar); } while (0)
    unsigned char* ws = F.ws;
    bf16* XN = (bf16*)(ws + WS_XN); bf16* Y = (bf16*)(ws + WS_Y); bf16* H = (bf16*)(ws + WS_H);
    const int cid = (int)blockIdx.x;

    if (IN(0)) { p0_prologue(F); SEAM(0); }
    if (IN(1)) {
        pg8::Gemm g{XN, (const bf16*)(ws + WS_W1GU), DM, DM, DM}; pg8::StaticOrder S; S.init(TOK, 2 * DFF, F.G, cid);
        pg8::EpiSwiGLU E{H, DFF};
        pg8::gemm_phase<pg8::EpiSwiGLU, pg8::StaticOrder, true>(F.lds + RING_OFF, g, S, E); SEAM(1); }
    if (IN(2)) {
        pg8::Gemm g{H, (const bf16*)(ws + WS_W1D), DFF, DFF, DFF}; pg8::StaticOrder S; S.init(TOK, DM, F.G, cid);
        pg8::EpiBf16 E{Y, DM};
        pg8::gemm_phase<pg8::EpiBf16, pg8::StaticOrder, true>(F.lds + RING_OFF, g, S, E); SEAM(2); }
    if (IN(3)) { ew_phase<true>(F, Y, args.in[0], F.out, 0.5f, args.in[6], args.in[7], XN); SEAM(3); }
    if (IN(4)) {
        pg8::Gemm g{XN, (const bf16*)(ws + WS_WIN), DM, DM, DM}; pg8::StaticOrder S; S.init(TOK, NWIN, F.G, cid);
        pg8::EpiWin E{(bf16*)(ws + WS_SEG0), (bf16*)(ws + WS_GA), (bf16*)(ws + WS_GB), (float*)(ws + WS_GATES), args.in[15], args.in[11], args.in[12], args.in[14], QC2};
        pg8::gemm_phase<pg8::EpiWin, pg8::StaticOrder, true>(F.lds + RING_OFF, g, S, E); SEAM(4); }
    if (IN(5)) { m1_phase(F); SEAM(5); }
    if (IN(6)) { m2_phase(F); SEAM(6); }
    if (IN(7)) { p7_mixer(F); SEAM(7); }
    if (IN(8)) {
        pg8::Gemm g{XN, (const bf16*)(ws + WS_WAB), DM, DM, DM}; pg8::StaticOrder S; S.init(TOK, DM, F.G, cid);
        pg8::EpiMerge E{Y, (const bf16*)(ws + WS_GA), (const bf16*)(ws + WS_GB)};
        pg8::gemm_phase<pg8::EpiMerge, pg8::StaticOrder, true>(F.lds + RING_OFF, g, S, E); SEAM(8); }
    if (IN(9)) {
        pg8::Gemm g{Y, (const bf16*)(ws + WS_WOUT), DM, DM, DM}; pg8::StaticOrder S; S.init(TOK, DM, F.G, cid);
        pg8::EpiBf16 E{XN, DM};
        pg8::gemm_phase<pg8::EpiBf16, pg8::StaticOrder, true>(F.lds + RING_OFF, g, S, E); SEAM(9); }
    if (IN(10)) { ew_phase<true>(F, XN, F.out, F.out, 1.0f, args.in[19], args.in[20], Y); SEAM(10); }
    if (IN(11)) {
        pg8::Gemm g{Y, (const bf16*)(ws + WS_W2GU), DM, DM, DM}; pg8::StaticOrder S; S.init(TOK, 2 * DFF, F.G, cid);
        pg8::EpiSwiGLU E{H, DFF};
        pg8::gemm_phase<pg8::EpiSwiGLU, pg8::StaticOrder, true>(F.lds + RING_OFF, g, S, E); SEAM(11); }
    if (IN(12)) {
        pg8::Gemm g{H, (const bf16*)(ws + WS_W2D), DFF, DFF, DFF}; pg8::StaticOrder S; S.init(TOK, DM, F.G, cid);
        pg8::EpiBf16 E{XN, DM};
        pg8::gemm_phase<pg8::EpiBf16, pg8::StaticOrder, true>(F.lds + RING_OFF, g, S, E); SEAM(12); }
    if (IN(13)) {
        ew_phase<true>(F, XN, F.out, F.out, 0.5f, args.in[24], args.in[25], Y);
        const int gw = F.vcu * NWAVES + F.wave, NGW = F.G * NWAVES; bf16* PB = (bf16*)(ws + WS_PB);
        for (int m = gw; m < TOK; m += NGW) { const f32x4 v = *((const GAS f32x4*)(args.in[1] + (size_t)m * 256) + F.lane); v2u w; w.x = pk2(v.x, v.y); w.y = pk2(v.z, v.w); *((GAS v2u*)(PB + (size_t)m * 256) + F.lane) = w; }
        SEAM(13); }
    if (IN(14)) {
        { pg8::Gemm g{(const bf16*)(ws + WS_PB), (const bf16*)(ws + WS_WPP), 256, 256, 256}; pg8::StaticOrder S; S.init(TOK, DM, F.G, cid);
          pg8::EpiBf16 E{(bf16*)(ws + WS_EMB), DM};
          pg8::gemm_phase<pg8::EpiBf16, pg8::StaticOrder, true>(F.lds + RING_OFF, g, S, E); }
        VM_WAIT(); __syncthreads();
        { pg8::Gemm g{Y, (const bf16*)(ws + WS_WPG), DM, DM, DM}; pg8::StaticOrder S; S.init(TOK, DM, F.G, cid);
          pg8::EpiPle E{XN, (const bf16*)(ws + WS_EMB), args.in[27]};
          pg8::gemm_phase<pg8::EpiPle, pg8::StaticOrder, true>(F.lds + RING_OFF, g, S, E); }
        SEAM(14); }
    if (IN(15)) { ew_phase<false>(F, XN, F.out, F.out, 1.0f, args.in[29], nullptr, nullptr); }
#undef IN
#undef SEAM
}

extern "C" void kernel_launch(void* const* d_in, const int* in_sizes, int n_in, void* d_out, int out_size, void* d_ws, size_t ws_size, hipStream_t stream) {
    static int grid = 0;
    if (grid == 0) {
        if (n_in != 30 || in_sizes[0] != TOK * DM || out_size != TOK * DM || ws_size < WS_END) { fprintf(stderr, "kernel_launch: unexpected shapes (n_in %d, in0 %d, out %d, ws %zu); nothing launched\n", n_in, n_in > 0 ? in_sizes[0] : -1, out_size, ws_size); grid = -1; return; }
        int dev = 0, cus = 0, per_cu = 0;
        if (hipGetDevice(&dev) != hipSuccess || hipDeviceGetAttribute(&cus, hipDeviceAttributeMultiprocessorCount, dev) != hipSuccess) { grid = -1; return; }
        if (hipFuncSetAttribute((const void*)mega_fwd, hipFuncAttributeMaxDynamicSharedMemorySize, LDS_BYTES) != hipSuccess) { fprintf(stderr, "kernel_launch: hipFuncSetAttribute failed\n"); grid = -1; return; }
        if (hipOccupancyMaxActiveBlocksPerMultiprocessor(&per_cu, (const void*)mega_fwd, NWAVES * 64, LDS_BYTES) != hipSuccess || per_cu < 1) { fprintf(stderr, "kernel_launch: occupancy query reports %d\n", per_cu); }
        (void)hipGetLastError();
        grid = cus;
        if (grid != 256) fprintf(stderr, "kernel_launch: %d CUs (built for 256)\n", grid);
    }
    if (grid < 0) return;
    hipMemsetAsync((char*)d_ws + WS_CTL, 0, CTL_ZERO_BYTES, stream);
    Args a{};
    for (int i = 0; i < 30; ++i) a.in[i] = (const float*)d_in[i];
    a.out = (float*)d_out; a.ws = (unsigned char*)d_ws;
#if MK_N_LAUNCHES == 1
    a.ph_lo = 0; a.ph_hi = NPHASE;
    hipLaunchKernelGGL(mega_fwd, dim3(grid), dim3(NWAVES * 64), LDS_BYTES, stream, a);
#else
    for (int p = 0; p < NPHASE; ++p) { a.ph_lo = p; a.ph_hi = p + 1; hipLaunchKernelGGL(mega_fwd, dim3(grid), dim3(NWAVES * 64), LDS_BYTES, stream, a); }
#endif
}
```

```cpp
#include <hip/hip_runtime.h>
#include <hip/hip_bf16.h>
#include <cstdio>
#include <cstdint>
#include <cmath>
namespace pg8 {
#define PG8_LAS __attribute__((address_space(3)))
typedef unsigned short bf16_t;
typedef short bf16x8 __attribute__((ext_vector_type(8)));
typedef float f32x4 __attribute__((ext_vector_type(4)));
typedef unsigned u32x4 __attribute__((ext_vector_type(4)));
constexpr int BM = 256, BK = 64, HALF = 128, HTB = HALF * BK * 2  , STAGE_BYTES = 8 * HTB, NXCD = 8, WGM = 8;

__host__ __device__ __forceinline__ int lds_byte(int r, int c) { const int st = (r >> 4) * 2 + (c >> 5), rr = r & 15, cc = c & 31, ob = rr * 64 + cc * 2; return st * 1024 + (ob ^ (((ob >> 9) & 1) << 5)); }
__host__ __device__ __forceinline__ void stage_rc(int b, int& R, int& C) { const int st = b / 1024, sb = b % 1024, swz = sb ^ (((sb >> 9) & 1) << 5); R = (st >> 1) * 16 + swz / 64; C = (st & 1) * 32 + (swz % 64) / 2; }
__host__ __device__ __forceinline__ int perm32(int rho) { const int n = rho >> 4, i = rho & 15; return 8 * (i >> 2) + 4 * n + (i & 3); }

struct Unit { int pm, pn; };
struct Gemm { const bf16_t* A; const bf16_t* Bt; int lda, ldb, K; size_t bstepA, bstepB; };

struct StaticOrder {
    int nM, nN, nwg, G, c, rev;
    __host__ __device__ void init(int M, int N, int G_, int c_, int rev_ = 0) { nM = M / BM; nN = N / BM; nwg = nM * nN; G = G_; c = c_; rev = rev_; }
    __host__ __device__ bool next(int i, Unit& u) const {
        if (rev) { if (i >= rev) return false; i = rev - 1 - i; }
        const long L = (long)i * G + c; if (L >= nwg) return false;
        int wgid = (int)L; { const int q = nwg / NXCD, r = nwg % NXCD, xcd = wgid % NXCD, off = wgid / NXCD; wgid = (xcd < r ? xcd * (q + 1) : r * (q + 1) + (xcd - r) * q) + off; }
        const int nig = WGM * nN, gid = wgid / nig, fm = gid * WGM, gsz = (nM - fm) < WGM ? (nM - fm) : WGM;
        u.pm = fm + ((wgid % nig) % gsz); u.pn = (wgid % nig) / gsz; return true;
    }
};

typedef float f32x2_t __attribute__((ext_vector_type(2))); typedef __bf16 bf16x2_t __attribute__((ext_vector_type(2)));
__device__ __forceinline__ unsigned cvt_pk_bf16(float lo, float hi) { f32x2_t v = {lo, hi}; bf16x2_t b = __builtin_convertvector(v, bf16x2_t); return __builtin_bit_cast(unsigned, b); }
__device__ __forceinline__ float bf_lo(unsigned w) { return __uint_as_float(w << 16); }
__device__ __forceinline__ float bf_hi(unsigned w) { return __uint_as_float(w & 0xffff0000u); }
__device__ __forceinline__ float sigmoid_f(float x) { return __builtin_amdgcn_rcpf(1.0f + __builtin_amdgcn_exp2f(-1.4426950408889634f * x)); }

template <class Epi, class Sched, bool ALIGN_EPI = false>
__device__ __forceinline__ void gemm_phase(PG8_LAS unsigned char* lds, const Gemm g, const Sched& S, const Epi& E) {
    int tid_ = threadIdx.x; asm volatile("" : "+v"(tid_));
    const int tid = tid_, wid = __builtin_amdgcn_readfirstlane(tid >> 6), lane = tid & 63, wr = wid >> 2, wc = wid & 3, fr = lane & 15, fq = lane >> 4;
    const int K = g.K, nt = K / BK;
    unsigned voffA[2], voffB[2];
#pragma unroll
    for (int i = 0; i < 2; ++i) { int R, C; stage_rc(tid * 16 + i * 8192, R, C); const int Rb = Epi::PERM ? ((R & ~31) + perm32(R & 31)) : R;
        voffA[i] = (unsigned)(R * g.lda + C) * 2u; voffB[i] = (unsigned)(Rb * g.ldb + C) * 2u; }
    const size_t kstep = (size_t)(BK * 2);
    const size_t bstepA = g.bstepA, bstepB = g.bstepB;
    const size_t hstepA = (size_t)HALF * g.lda * 2, hstepB = (size_t)HALF * g.ldb * 2;
    const size_t tstepA = 2 * hstepA, tstepB = 2 * hstepB;
    const unsigned ldsw = (unsigned)wid * 1024u;
    const int aoff = lds_byte(wr * 64 + fr, fq * 8), boff = lds_byte(wc * 32 + fr, fq * 8);
#define PG8_SA(b, h) (((b) * 2 + (h)) * HTB)
#define PG8_SB(b, h) ((4 + (b) * 2 + (h)) * HTB)
#define PG8_STAGE(bufoff, gbase, voff) do { _Pragma("unroll") for (int _i = 0; _i < 2; ++_i) \
        __builtin_amdgcn_global_load_lds((const unsigned*)((const char*)(gbase) + (voff)[_i]), (PG8_LAS unsigned*)(lds + (bufoff) + ldsw + _i * 8192), 16, 0, 0); } while (0)
#define PG8_LDA(dst, b, h) do { _Pragma("unroll") for (int m = 0; m < 4; ++m) _Pragma("unroll") for (int k = 0; k < 2; ++k) dst[m][k] = *(const PG8_LAS bf16x8*)(lds + PG8_SA(b, h) + aoff + m * 2048 + k * 1024); } while (0)
#define PG8_LDB(dst, b, h) do { _Pragma("unroll") for (int n = 0; n < 2; ++n) _Pragma("unroll") for (int k = 0; k < 2; ++k) dst[n][k] = *(const PG8_LAS bf16x8*)(lds + PG8_SB(b, h) + boff + n * 2048 + k * 1024); } while (0)
#define PG8_MMA(ai, bj, At, Bt) do { __builtin_amdgcn_s_setprio(1); _Pragma("unroll") for (int m = 0; m < 4; ++m) _Pragma("unroll") for (int n = 0; n < 2; ++n) _Pragma("unroll") for (int k = 0; k < 2; ++k) \
        acc[ai][bj][m][n] = __builtin_amdgcn_mfma_f32_16x16x32_bf16(Bt[n][k], At[m][k], acc[ai][bj][m][n], 0, 0, 0); __builtin_amdgcn_s_setprio(0); } while (0)
#define PG8_WAIT_V(n) asm volatile("s_waitcnt vmcnt(" #n ")" ::: "memory")
#define PG8_WAIT_L(n) asm volatile("s_waitcnt lgkmcnt(" #n ")" ::: "memory")
#define PG8_BAR __builtin_amdgcn_s_barrier()
#define PG8_SCHED __builtin_amdgcn_sched_barrier(0)
    Unit cur, nxt; int ui = 0;
    if (!S.next(0, cur)) return;
    f32x4 acc[2][2][4][2];
#pragma unroll
    for (int a = 0; a < 2; ++a)
#pragma unroll
        for (int b = 0; b < 2; ++b)
#pragma unroll
            for (int m = 0; m < 4; ++m)
#pragma unroll
                for (int n = 0; n < 2; ++n) acc[a][b][m][n] = (f32x4){0.f, 0.f, 0.f, 0.f};
    bf16x8 At[4][2], B0[2][2], B1[2][2];
    PG8_LAS float* const lrs = (PG8_LAS float*)(lds + STAGE_BYTES + 1024);
    const char* cA = (const char*)g.A + (size_t)cur.pm * tstepA; const char* cB = (const char*)g.Bt + (size_t)cur.pn * tstepB;
    PG8_STAGE(PG8_SB(0, 0), cB, voffB); PG8_STAGE(PG8_SB(0, 1), cB + hstepB, voffB); PG8_STAGE(PG8_SA(0, 0), cA, voffA); PG8_STAGE(PG8_SA(0, 1), cA + hstepA, voffA);
    if (wr == 1) PG8_BAR;
    PG8_WAIT_V(2); PG8_BAR;
    PG8_STAGE(PG8_SB(1, 0), cB + kstep, voffB); PG8_STAGE(PG8_SA(1, 0), cA + kstep, voffA); PG8_STAGE(PG8_SB(1, 1), cB + hstepB + kstep, voffB);
    PG8_WAIT_V(6); PG8_BAR;
    for (;;) {
        const bool has_next = S.next(ui + 1, nxt);
        const char* nA = has_next ? (const char*)g.A + (size_t)nxt.pm * tstepA : cA; const char* nB = has_next ? (const char*)g.Bt + (size_t)nxt.pn * tstepB : cB;
        const char* pA = cA; const char* pB = cB;
        if constexpr (Epi::RS) { E.unit_dma(cur, wid, lane, lrs + 512 + (ui & 1) * 256);
            if (wid == 0)
            __builtin_amdgcn_global_load_lds((const unsigned*)(E.rs + (size_t)cur.pm * BM + lane * 4), (PG8_LAS unsigned*)(lrs + (ui & 1) * 256), 16, 0, 0); }
        for (int t = 0; t < nt; t += 2) {
            const bool last = (t == nt - 2);
            if constexpr (Epi::MID) { if (t == (nt >> 1)) E.mid(acc, cur, wr, wc, fr, fq); }
            const char* a1 = pA + kstep;
            const char* a2 = last ? nA : pA + bstepA; const char* b2 = last ? nB : pB + bstepB;
            const char* a3 = a2 + kstep; const char* b3 = b2 + kstep;
            pA = a2; pB = b2;
            PG8_LDB(B0, 0, 0); PG8_LDB(B1, 0, 1); PG8_SCHED; PG8_LDA(At, 0, 0); PG8_STAGE(PG8_SA(1, 1), a1 + hstepA, voffA);
            PG8_WAIT_V(8); PG8_WAIT_L(0); PG8_BAR; PG8_MMA(0, 0, At, B0); PG8_MMA(0, 1, At, B1); PG8_BAR; PG8_SCHED;
            PG8_LDA(At, 0, 1); PG8_STAGE(PG8_SB(0, 0), b2, voffB); PG8_STAGE(PG8_SB(0, 1), b2 + hstepB, voffB); PG8_STAGE(PG8_SA(0, 0), a2, voffA);
            PG8_WAIT_V(8); PG8_WAIT_L(0); PG8_BAR; PG8_MMA(1, 0, At, B0); PG8_MMA(1, 1, At, B1); PG8_BAR; PG8_SCHED;
            PG8_LDB(B0, 1, 0); PG8_LDB(B1, 1, 1); PG8_SCHED; PG8_LDA(At, 1, 0); PG8_STAGE(PG8_SA(0, 1), a2 + hstepA, voffA);
            PG8_WAIT_V(8); PG8_WAIT_L(0); PG8_BAR; PG8_MMA(0, 0, At, B0); PG8_MMA(0, 1, At, B1); PG8_BAR; PG8_SCHED;
            PG8_LDA(At, 1, 1); PG8_STAGE(PG8_SB(1, 0), b3, voffB); PG8_STAGE(PG8_SB(1, 1), b3 + hstepB, voffB); PG8_STAGE(PG8_SA(1, 0), a3, voffA);
            PG8_WAIT_V(8); PG8_WAIT_L(0); PG8_BAR; PG8_MMA(1, 0, At, B0); PG8_MMA(1, 1, At, B1); PG8_BAR; PG8_SCHED;
        }
        if constexpr (ALIGN_EPI) { if (wr == 0) PG8_BAR; }
        if constexpr (Epi::RS) E(acc, lrs + (ui & 1) * 256, cur, wr, wc, fr, fq); else E(acc, cur, wr, wc, fr, fq);
#ifdef DUP_EPI
        if (DUP_EPI == Epi::ID) { asm volatile("" ::: "memory"); if constexpr (Epi::RS) E(acc, lrs + (ui & 1) * 256, cur, wr, wc, fr, fq); else E(acc, cur, wr, wc, fr, fq); }
#endif
        if (!has_next) break;
#pragma unroll
        for (int a = 0; a < 2; ++a)
#pragma unroll
            for (int b = 0; b < 2; ++b)
#pragma unroll
                for (int m = 0; m < 4; ++m)
#pragma unroll
                    for (int n = 0; n < 2; ++n) acc[a][b][m][n] = (f32x4){0.f, 0.f, 0.f, 0.f};
        cur = nxt; cA = nA; cB = nB; ++ui;
        if constexpr (ALIGN_EPI) { if (wr == 1) PG8_BAR; }
    }
    PG8_WAIT_V(0);
    if constexpr (!ALIGN_EPI) { if (wr == 0) PG8_BAR; }
    PG8_BAR;
#undef PG8_SA
#undef PG8_SB
#undef PG8_STAGE
#undef PG8_LDA
#undef PG8_LDB
#undef PG8_MMA
#undef PG8_WAIT_V
#undef PG8_WAIT_L
#undef PG8_BAR
#undef PG8_SCHED
}
}
namespace pg8 {
struct EpiBf16 {
    static constexpr bool RS = false; static constexpr int ID = 0; static constexpr bool PERM = true, MID = false;
    bf16_t* O; int ldc;
    __device__ __forceinline__ void operator()(const f32x4 (&acc)[2][2][4][2], const Unit& u, int wr, int wc, int fr, int fq) const {
        const int row0 = u.pm * BM + wr * 64 + fr, col0 = u.pn * BM + wc * 32 + 8 * fq;
#pragma unroll
        for (int ai = 0; ai < 2; ++ai)
#pragma unroll
            for (int m = 0; m < 4; ++m) { bf16_t* rowp = O + (size_t)(row0 + ai * HALF + m * 16) * ldc + col0;
#pragma unroll
                for (int bj = 0; bj < 2; ++bj) { const f32x4 v0 = acc[ai][bj][m][0], v1 = acc[ai][bj][m][1];
                    u32x4 w; w.x = cvt_pk_bf16(v0[0], v0[1]); w.y = cvt_pk_bf16(v0[2], v0[3]); w.z = cvt_pk_bf16(v1[0], v1[1]); w.w = cvt_pk_bf16(v1[2], v1[3]);
                    *(u32x4*)(rowp + bj * HALF) = w; } }
    }
};
struct EpiSwiGLU {
    static constexpr bool RS = true; static constexpr int ID = 1; static constexpr bool PERM = true, MID = false;
    const float* rs;
    bf16_t* O;
    __device__ __forceinline__ void unit_dma(const Unit&, int, int, PG8_LAS float*) const {}
    __device__ __forceinline__ void operator()(const f32x4 (&acc)[2][2][4][2], const PG8_LAS float* lrs, const Unit& u, int wr, int wc, int fr, int fq) const {
        const int row0 = u.pm * BM + wr * 64 + fr, col0 = wc * 32 + 8 * fq;
        bf16_t* Ob = O + (size_t)u.pn * ((size_t)32768 * HALF);
#pragma unroll
        for (int ai = 0; ai < 2; ++ai)
#pragma unroll
            for (int m = 0; m < 4; ++m) { bf16_t* rowp = Ob + (size_t)(row0 + ai * HALF + m * 16) * HALF + col0; const float r = lrs[ai * HALF + wr * 64 + m * 16 + fr];
                typedef float f32x2 __attribute__((ext_vector_type(2)));
                f32x2 h2[4];
#pragma unroll
                for (int n = 0; n < 2; ++n)
#pragma unroll
                    for (int e2 = 0; e2 < 2; ++e2) { const f32x2 a = (f32x2){acc[ai][0][m][n][2 * e2], acc[ai][0][m][n][2 * e2 + 1]} * r, b = (f32x2){acc[ai][1][m][n][2 * e2], acc[ai][1][m][n][2 * e2 + 1]} * r;
                        f32x2 ex; ex.x = __builtin_amdgcn_exp2f(a.x); ex.y = __builtin_amdgcn_exp2f(a.y);
                        const f32x2 d = ex + 1.0f; f32x2 r; r.x = __builtin_amdgcn_rcpf(d.x); r.y = __builtin_amdgcn_rcpf(d.y);
                        h2[n * 2 + e2] = (a * b) * r; }
                u32x4 w; w.x = cvt_pk_bf16(h2[0].x, h2[0].y); w.y = cvt_pk_bf16(h2[1].x, h2[1].y); w.z = cvt_pk_bf16(h2[2].x, h2[2].y); w.w = cvt_pk_bf16(h2[3].x, h2[3].y);
                *(u32x4*)rowp = w; }
    }
};
struct EpiWin {
    static constexpr bool RS = true; static constexpr int ID = 2; static constexpr bool PERM = true, MID = false;
    const float* rs;
    bf16_t* seg0; bf16_t* rho; bf16_t* gb; const float* bgate; float qscale; unsigned* nrm;
    __device__ __forceinline__ void unit_dma(const Unit& u, int wid, int lane, PG8_LAS float* dst) const {
        if (wid == 1 && u.pn >= 12) __builtin_amdgcn_global_load_lds((const unsigned*)(bgate + ((lane >> 5) ? 1024 : 0) + (u.pn - 12) * HALF + 4 * (lane & 31)), (PG8_LAS unsigned*)dst, 16, 0, 0); }
    __device__ __forceinline__ void operator()(const f32x4 (&acc_)[2][2][4][2], const PG8_LAS float* lrs, const Unit& u, int wr, int wc, int fr, int fq) const {
        const int pn = u.pn; const int row0 = u.pm * BM + wr * 64 + fr;
        f32x4 acc[2][2][4][2];
#pragma unroll
        for (int ai = 0; ai < 2; ++ai)
#pragma unroll
            for (int m = 0; m < 4; ++m) { const float r = lrs[ai * HALF + wr * 64 + m * 16 + fr];
#pragma unroll
                for (int bj = 0; bj < 2; ++bj) { acc[ai][bj][m][0] = acc_[ai][bj][m][0] * r; acc[ai][bj][m][1] = acc_[ai][bj][m][1] * r; } }
        if (pn >= 6 && pn < 10) {
            const float sc = (pn < 8) ? qscale : 1.0f;
#pragma unroll
            for (int bj = 0; bj < 2; ++bj) { float mx = 0.f;
#pragma unroll
                for (int ai = 0; ai < 2; ++ai)
#pragma unroll
                    for (int m = 0; m < 4; ++m) { const f32x4 a = acc[ai][bj][m][0] * sc, b = acc[ai][bj][m][1] * sc;
                        float q = (a[0] * a[0] + a[1] * a[1]) + (a[2] * a[2] + a[3] * a[3]) + (b[0] * b[0] + b[1] * b[1]) + (b[2] * b[2] + b[3] * b[3]);
                        q += __shfl_xor(q, 16); q += __shfl_xor(q, 32); mx = fmaxf(mx, q); }
                mx = fmaxf(mx, __shfl_xor(mx, 1)); mx = fmaxf(mx, __shfl_xor(mx, 2)); mx = fmaxf(mx, __shfl_xor(mx, 4)); mx = fmaxf(mx, __shfl_xor(mx, 8));
                if (fr == 0 && fq == 0) { const int fh = 4 * (pn & 1) + 2 * bj + (wc >> 1), b = u.pm >> 4;
                    atomicMax(nrm + ((b * 8 + fh) * 4 + ((pn >= 8) ? 2 : 0) + (wc & 1)), __float_as_uint(mx)); } }
        }
        typedef float f32x2 __attribute__((ext_vector_type(2)));
        if (pn < 12) {
            const int sg = pn >> 1; bf16_t* dst = seg0 + (size_t)sg * (size_t)(16u << 20);
            const int col0 = (pn & 1) * 256 + wc * 32 + 8 * fq;
            if (sg == 2) {
#pragma unroll
                for (int ai = 0; ai < 2; ++ai)
#pragma unroll
                    for (int m = 0; m < 4; ++m) { bf16_t* rowp = dst + (size_t)(row0 + ai * HALF + m * 16) * 512 + col0;
#pragma unroll
                        for (int bj = 0; bj < 2; ++bj) { unsigned w[4];
#pragma unroll
                            for (int n = 0; n < 2; ++n)
#pragma unroll
                                for (int e2 = 0; e2 < 2; ++e2) { f32x2 ex; ex.x = __builtin_amdgcn_exp2f(acc[ai][bj][m][n][2 * e2]); ex.y = __builtin_amdgcn_exp2f(acc[ai][bj][m][n][2 * e2 + 1]);
                                    const f32x2 d = ex + 1.0f; w[2 * n + e2] = cvt_pk_bf16(__builtin_amdgcn_rcpf(d.x), __builtin_amdgcn_rcpf(d.y)); }
                            *(u32x4*)(rowp + bj * HALF) = (u32x4){w[0], w[1], w[2], w[3]}; } }
            } else {
                const float sc = (sg == 3) ? qscale : 1.0f;
#pragma unroll
                for (int ai = 0; ai < 2; ++ai)
#pragma unroll
                    for (int m = 0; m < 4; ++m) { bf16_t* rowp = dst + (size_t)(row0 + ai * HALF + m * 16) * 512 + col0;
#pragma unroll
                        for (int bj = 0; bj < 2; ++bj) { const f32x4 v0 = acc[ai][bj][m][0] * sc, v1 = acc[ai][bj][m][1] * sc;
                            u32x4 w; w.x = cvt_pk_bf16(v0[0], v0[1]); w.y = cvt_pk_bf16(v0[2], v0[3]); w.z = cvt_pk_bf16(v1[0], v1[1]); w.w = cvt_pk_bf16(v1[2], v1[3]);
                            *(u32x4*)(rowp + bj * HALF) = w; } }
            }
        } else {
            const int col0 = (pn - 12) * HALF + wc * 32 + 8 * fq;
            f32x2 ba[4], bb[4]; const PG8_LAS float* lb = lrs + 512 + wc * 32 + 8 * fq;
#pragma unroll
            for (int q = 0; q < 4; ++q) { const f32x2 x = *(const PG8_LAS f32x2*)(lb + 2 * q), y = *(const PG8_LAS f32x2*)(lb + 128 + 2 * q); ba[q] = x * -1.4426950408889634f; bb[q] = y * -1.4426950408889634f; }
#pragma unroll
            for (int ai = 0; ai < 2; ++ai)
#pragma unroll
                for (int m = 0; m < 4; ++m) { const size_t off = (size_t)(row0 + ai * HALF + m * 16) * 1024 + col0;
                    unsigned wr_[4], wg_[4];
#pragma unroll
                    for (int q = 0; q < 4; ++q) { const int n = q >> 1, e = 2 * (q & 1);
                        const f32x2 a = __builtin_elementwise_min((f32x2){acc[ai][0][m][n][e], acc[ai][0][m][n][e + 1]} + ba[q], (f32x2){80.f, 80.f}), b = __builtin_elementwise_min((f32x2){acc[ai][1][m][n][e], acc[ai][1][m][n][e + 1]} + bb[q], (f32x2){80.f, 80.f});
                        f32x2 ea, eb; ea.x = __builtin_amdgcn_exp2f(a.x); ea.y = __builtin_amdgcn_exp2f(a.y); eb.x = __builtin_amdgcn_exp2f(b.x); eb.y = __builtin_amdgcn_exp2f(b.y);
                        const f32x2 da = ea + 1.0f, db = eb + 1.0f; f32x2 ra, rb; ra.x = __builtin_amdgcn_rcpf(da.x); ra.y = __builtin_amdgcn_rcpf(da.y); rb.x = __builtin_amdgcn_rcpf(db.x); rb.y = __builtin_amdgcn_rcpf(db.y);
                        const f32x2 rr = db * ra; wr_[q] = cvt_pk_bf16(rr.x, rr.y); wg_[q] = cvt_pk_bf16(rb.x, rb.y); }
                    *(u32x4*)(rho + off) = (u32x4){wr_[0], wr_[1], wr_[2], wr_[3]};
                    *(u32x4*)(gb + off) = (u32x4){wg_[0], wg_[1], wg_[2], wg_[3]}; }
        }
    }
};
struct EpiMerge {
    static constexpr bool RS = false; static constexpr int ID = 3; static constexpr bool PERM = true, MID = true;
    bf16_t* O; const bf16_t* rho; const bf16_t* gb;
    __device__ __forceinline__ void mid(f32x4 (&acc)[2][2][4][2], const Unit& u, int wr, int wc, int fr, int fq) const {
        asm volatile("" : "+v"(fr), "+v"(fq));
        const unsigned base = (unsigned)((u.pm * BM + wr * 64 + fr) * 1024 + u.pn * BM + wc * 32 + 8 * fq) * 2u;
        const char* rb = (const char*)rho;
#pragma unroll
        for (int ai = 0; ai < 2; ++ai) { u32x4 a[4][2];
#pragma unroll
            for (int m = 0; m < 4; ++m)
#pragma unroll
                for (int bj = 0; bj < 2; ++bj) a[m][bj] = *(const u32x4*)(rb + base + (unsigned)((ai * HALF + m * 16) * 1024) * 2u + bj * HALF * 2);
#pragma unroll
            for (int m = 0; m < 4; ++m)
#pragma unroll
                for (int bj = 0; bj < 2; ++bj) { const u32x4 w = a[m][bj];
                    acc[ai][bj][m][0] = acc[ai][bj][m][0] * (f32x4){bf_lo(w.x), bf_hi(w.x), bf_lo(w.y), bf_hi(w.y)};
                    acc[ai][bj][m][1] = acc[ai][bj][m][1] * (f32x4){bf_lo(w.z), bf_hi(w.z), bf_lo(w.w), bf_hi(w.w)}; }
            asm volatile("" ::: "memory"); }
    }
    __device__ __forceinline__ void operator()(const f32x4 (&acc)[2][2][4][2], const Unit& u, int wr, int wc, int fr, int fq) const {
        asm volatile("" : "+v"(fr), "+v"(fq));
        const unsigned base = (unsigned)((u.pm * BM + wr * 64 + fr) * 1024 + u.pn * BM + wc * 32 + 8 * fq) * 2u;
        const char* gbb = (const char*)gb; char* Ob = (char*)O;
#pragma unroll
        for (int ai = 0; ai < 2; ++ai) { u32x4 a[4][2];
#pragma unroll
            for (int m = 0; m < 4; ++m)
#pragma unroll
                for (int bj = 0; bj < 2; ++bj) a[m][bj] = *(const u32x4*)(gbb + base + (unsigned)((ai * HALF + m * 16) * 1024) * 2u + bj * HALF * 2);
#pragma unroll
            for (int m = 0; m < 4; ++m)
#pragma unroll
                for (int bj = 0; bj < 2; ++bj) { const u32x4 b = a[m][bj]; const f32x4 v0 = acc[ai][bj][m][0], v1 = acc[ai][bj][m][1];
                    u32x4 w; w.x = cvt_pk_bf16(v0[0] * bf_lo(b.x), v0[1] * bf_hi(b.x)); w.y = cvt_pk_bf16(v0[2] * bf_lo(b.y), v0[3] * bf_hi(b.y));
                    w.z = cvt_pk_bf16(v1[0] * bf_lo(b.z), v1[1] * bf_hi(b.z)); w.w = cvt_pk_bf16(v1[2] * bf_lo(b.w), v1[3] * bf_hi(b.w));
                    *(u32x4*)(Ob + base + (unsigned)((ai * HALF + m * 16) * 1024) * 2u + bj * HALF * 2) = w; }
            asm volatile("" ::: "memory"); }
    }
};
struct EpiPle {
    static constexpr bool RS = true; static constexpr int ID = 4; static constexpr bool PERM = true, MID = false;
    const float* rs; bf16_t* O; const bf16_t* emb; const float* bias;
    __device__ __forceinline__ void unit_dma(const Unit&, int, int, PG8_LAS float*) const {}
    __device__ __forceinline__ void operator()(const f32x4 (&acc)[2][2][4][2], const PG8_LAS float* lrs, const Unit& u, int wr, int wc, int fr, int fq) const {
        float pre[8];
#pragma unroll
        for (int q = 0; q < 8; ++q) pre[q] = lrs[(q >> 2) * HALF + wr * 64 + (q & 3) * 16 + fr];
        asm volatile("" : "+v"(fr), "+v"(fq));
        const int col0 = u.pn * BM + wc * 32 + 8 * fq;
        const unsigned base = (unsigned)((u.pm * BM + wr * 64 + fr) * 1024 + col0) * 2u;
        const char* eb = (const char*)emb; char* Ob = (char*)O;
        f32x4 bv[2][2];
#pragma unroll
        for (int bj = 0; bj < 2; ++bj)
#pragma unroll
            for (int n = 0; n < 2; ++n) bv[bj][n] = *(const f32x4*)(bias + col0 + bj * HALF + 4 * n);
#pragma unroll
        for (int ai = 0; ai < 2; ++ai) { u32x4 a[4][2];
#pragma unroll
            for (int m = 0; m < 4; ++m)
#pragma unroll
                for (int bj = 0; bj < 2; ++bj) a[m][bj] = *(const u32x4*)(eb + base + (unsigned)((ai * HALF + m * 16) * 1024) * 2u + bj * HALF * 2);
#pragma unroll
            for (int m = 0; m < 4; ++m)
#pragma unroll
                for (int bj = 0; bj < 2; ++bj) { const u32x4 b = a[m][bj]; const float r = pre[ai * 4 + m];
                    const f32x4 v0 = acc[ai][bj][m][0] * r + bv[bj][0], v1 = acc[ai][bj][m][1] * r + bv[bj][1];
                    u32x4 w; w.x = cvt_pk_bf16(sigmoid_f(v0[0]) * bf_lo(b.x), sigmoid_f(v0[1]) * bf_hi(b.x)); w.y = cvt_pk_bf16(sigmoid_f(v0[2]) * bf_lo(b.y), sigmoid_f(v0[3]) * bf_hi(b.y));
                    w.z = cvt_pk_bf16(sigmoid_f(v1[0]) * bf_lo(b.z), sigmoid_f(v1[1]) * bf_hi(b.z)); w.w = cvt_pk_bf16(sigmoid_f(v1[2]) * bf_lo(b.w), sigmoid_f(v1[3]) * bf_hi(b.w));
                    *(u32x4*)(Ob + base + (unsigned)((ai * HALF + m * 16) * 1024) * 2u + bj * HALF * 2) = w; }
            asm volatile("" ::: "memory"); }
    }
};
}
namespace fox_body {
#define FLAS __attribute__((address_space(3)))
using bf16=__hip_bfloat16;
using bf16x8=__attribute__((ext_vector_type(8)))short;
using s16x4=__attribute__((ext_vector_type(4)))short;
using f32x16=__attribute__((ext_vector_type(16)))float;
using u32x4=__attribute__((ext_vector_type(4)))unsigned;
constexpr int BATCH=8,NHEAD=8,SEQ=4096,D=64,DM=512,DMO=1024;
constexpr int NW=8,QBLK=32,QB=QBLK*NW,KVBLK=64,NQB=SEQ/QB;
__device__ __forceinline__ int crow(int r,int hi){return (r&3)+8*(r>>2)+4*hi;}
#define SBAR() __builtin_amdgcn_sched_barrier(0)
__device__ __forceinline__ void cmask(f32x16&p0,f32x16&p1,int jb,int qrel,int hi){
  const float NEG=-INFINITY; int kb=64*jb+4*hi;
  #pragma unroll
  for(int r=0;r<16;++r){int kv=kb+(r&3)+8*(r>>2); if(kv>qrel)p0[r]=NEG; if(kv+32>qrel)p1[r]=NEG;}
}

constexpr int NSLOT=3, SLOTB=8192;
constexpr int LDS_K=0, LDS_V=NSLOT*SLOTB, LDS_WS=2*NSLOT*SLOTB, LDS_OST=LDS_WS+NW*64*4, LDS_CS=LDS_OST+NW*4096, LDS_BYTES=LDS_CS+SEQ*4;
constexpr float C2=0.125f*1.4426950408889634f; typedef float f32x4 __attribute__((ext_vector_type(4)));
__device__ __forceinline__ void glds16(const void*gsrc,unsigned lds_dst){unsigned keep;
  asm volatile("s_mov_b32 %0, m0\n\ts_mov_b32 m0, %2\n\ts_nop 0\n\tglobal_load_lds_dwordx4 %1, off\n\ts_mov_b32 m0, %0":"=&s"(keep):"v"(gsrc),"s"(lds_dst):"memory");}
__device__ __forceinline__ float max3f(float a,float b,float c){float r;asm("v_max3_f32 %0, %1, %2, %3":"=v"(r):"v"(a),"v"(b),"v"(c));return r;}
__device__ __forceinline__ float max2f(float a,float b){float r;asm("v_max_f32_e32 %0, %1, %2":"=v"(r):"v"(a),"v"(b));return r;}
__device__ __forceinline__ float fadd_s(float a,float b){float r;asm("v_add_f32_e32 %0, %1, %2":"=v"(r):"v"(a),"v"(b));return r;}
__device__ __forceinline__ float fsub_s(float a,float b){float r;asm("v_sub_f32_e32 %0, %1, %2":"=v"(r):"v"(a),"v"(b));return r;}
typedef float f32x2_t __attribute__((ext_vector_type(2))); typedef __bf16 bf16x2_t __attribute__((ext_vector_type(2)));
__device__ __forceinline__ unsigned cvtpk_s(float lo,float hi){f32x2_t v={lo,hi};bf16x2_t b=__builtin_convertvector(v,bf16x2_t);return __builtin_bit_cast(unsigned,b);}
#define WAIT_BAR(N) asm volatile("s_waitcnt vmcnt(" #N ") lgkmcnt(0)\n\ts_barrier":::"memory")

__device__ __forceinline__ void qkt(f32x16&p0,f32x16&p1,const char*Kslot,const bf16x8*qr,int r32,int hi){
  const char*kb=Kslot+hi*1024+r32*16;
  #pragma unroll
  for(int d0=0;d0<4;++d0){
    const bf16x8 b0=*reinterpret_cast<const bf16x8*>(kb+d0*2048);
    const bf16x8 b1=*reinterpret_cast<const bf16x8*>(kb+d0*2048+512);
    p0=__builtin_amdgcn_mfma_f32_32x32x16_bf16(b0,qr[d0],p0,0,0,0);p1=__builtin_amdgcn_mfma_f32_32x32x16_bf16(b1,qr[d0],p1,0,0,0);}
}
typedef __attribute__((address_space(3))) const char* lds_cptr;
typedef short v4i16_t __attribute__((ext_vector_type(4)));
__device__ __forceinline__ void kload8(bf16x8*kf,lds_cptr kp){
  kf[0]=*(const __attribute__((address_space(3))) bf16x8*)(kp);      kf[1]=*(const __attribute__((address_space(3))) bf16x8*)(kp+512);
  kf[2]=*(const __attribute__((address_space(3))) bf16x8*)(kp+2048); kf[3]=*(const __attribute__((address_space(3))) bf16x8*)(kp+2560);
  kf[4]=*(const __attribute__((address_space(3))) bf16x8*)(kp+4096); kf[5]=*(const __attribute__((address_space(3))) bf16x8*)(kp+4608);
  kf[6]=*(const __attribute__((address_space(3))) bf16x8*)(kp+6144); kf[7]=*(const __attribute__((address_space(3))) bf16x8*)(kp+6656);
}
__device__ __forceinline__ void kload2(bf16x8*kf,lds_cptr kp,int j){ kf[2*j]=*(const __attribute__((address_space(3))) bf16x8*)(kp+j*2048); kf[2*j+1]=*(const __attribute__((address_space(3))) bf16x8*)(kp+j*2048+512); }
__device__ __forceinline__ s16x4 vtr(lds_cptr p){ return __builtin_bit_cast(s16x4,__builtin_amdgcn_ds_read_tr16_b64_v4i16((__attribute__((address_space(3))) v4i16_t*)p)); }
__device__ __forceinline__ float rowmax(const f32x16&p0,const f32x16&p1){
  float a=max3f(p0[0],p0[1],p1[0]),b=max3f(p0[2],p0[3],p1[1]);a=max3f(a,p1[2],p1[3]);
  #pragma unroll
  for(int r=4;r<16;r+=4){a=max3f(a,p0[r],p0[r+1]);b=max3f(b,p0[r+2],p0[r+3]);a=max3f(a,p1[r],p1[r+1]);b=max3f(b,p1[r+2],p1[r+3]);}
  const float m=max2f(a,b);
  auto rr=__builtin_amdgcn_permlane32_swap(__float_as_uint(m),__float_as_uint(m),false,false);
  return max2f(__uint_as_float(rr[0]),__uint_as_float(rr[1]));
}
__device__ __forceinline__ void pv(f32x16*o,int vb,bf16x8 pa0,bf16x8 pa1,bf16x8 pa2,bf16x8 pa3){
  #pragma unroll
  for(int d0=0;d0<2;++d0){s16x4 lo[4],hi[4];
    #pragma unroll
    for(int ks=0;ks<4;++ks){
      asm volatile("ds_read_b64_tr_b16 %0,%1 offset:%c2":"=&v"(lo[ks]):"v"(vb),"i"(d0*4096+ks*1024):"memory");
      asm volatile("ds_read_b64_tr_b16 %0,%1 offset:%c2":"=&v"(hi[ks]):"v"(vb),"i"(d0*4096+ks*1024+512):"memory");}
    asm volatile("s_waitcnt lgkmcnt(0)":::"memory");SBAR();
    #define PK(k) (bf16x8){lo[k][0],lo[k][1],lo[k][2],lo[k][3],hi[k][0],hi[k][1],hi[k][2],hi[k][3]}
    o[d0]=__builtin_amdgcn_mfma_f32_32x32x16_bf16(pa0,PK(0),o[d0],0,0,0);
    o[d0]=__builtin_amdgcn_mfma_f32_32x32x16_bf16(pa1,PK(1),o[d0],0,0,0);
    o[d0]=__builtin_amdgcn_mfma_f32_32x32x16_bf16(pa2,PK(2),o[d0],0,0,0);
    o[d0]=__builtin_amdgcn_mfma_f32_32x32x16_bf16(pa3,PK(3),o[d0],0,0,0);
    #undef PK
  }
}

__device__ __forceinline__ int fox_t0(const float*cs,int qb,float thr,int lane){ const int q0=qb*QB, nt_=(q0+QB)/KVBLK; const float c0_=cs[q0]; const float cv_=cs[(lane<nt_?lane:nt_-1)*KVBLK+KVBLK-1];
  const unsigned long long bm_=__ballot(lane<nt_ && (cv_-c0_)<=thr); int f_=bm_? (int)__builtin_ctzll(bm_):0; f_&=~1; return __builtin_amdgcn_readfirstlane(f_<nt_-4?f_:nt_-4); }
#ifndef ATTN_STORE16
#define ATTN_STORE16(p,v) (*(u32x4*)(p)=(v))
#endif
template<int THRL> __device__ __forceinline__ void attn_unit(int b,int h,int qb,const bf16*Q,const bf16*__restrict__ K,const bf16*__restrict__ V,bf16*O,int ocol,const float*cs,int t0,char*shm){
  int tid_=threadIdx.x; asm volatile("":"+v"(tid_));
  const int tid=tid_,lane=tid&63,r32=lane&31,hi=lane>>5; const int wid=__builtin_amdgcn_readfirstlane(tid>>6);
  const long rowbase=(long)b*SEQ; const int q0=qb*QB;
  const bf16*Qw=Q+(rowbase+q0+wid*QBLK)*DM+h*D;
  const bf16*Kh=K+(rowbase+(long)t0*KVBLK)*DM+h*D,*Vh=V+(rowbase+(long)t0*KVBLK)*DM+h*D;
  const unsigned lds0=(unsigned)(uintptr_t)shm;
  float*wsf=(float*)(shm+LDS_WS)+wid*64;
  const bf16*ksrc=Kh+(long)lane*DM+wid*8;
  const bf16*vsrc=Vh+(long)(16*(wid&3)+(lane>>2))*DM+(wid>>2)*32+(lane&3)*8;
  const unsigned kdst=lds0+LDS_K+wid*1024, vdst=lds0+LDS_V+wid*1024;
  #define DMA_K(t,slot) glds16(ksrc+(long)(t)*KVBLK*DM,(unsigned)__builtin_amdgcn_readfirstlane(kdst+(slot)))
  #define DMA_V(t,slot) glds16(vsrc+(long)(t)*KVBLK*DM,(unsigned)__builtin_amdgcn_readfirstlane(vdst+(slot)))
  const int vb0=(int)(lds0+LDS_V)+((lane>>4)&1)*32+(lane&3)*8+(4*hi+((lane&15)>>2))*64;
  const char*Kbase=shm+LDS_K; bf16x8 kf[8];
  const lds_cptr shm3=(lds_cptr)shm; const lds_cptr kp0=shm3+LDS_K+hi*1024+r32*16; const lds_cptr vp0=shm3+LDS_V+((lane>>4)&1)*32+(lane&3)*8+(4*hi+((lane&15)>>2))*64;
  const int NT=(q0+QB)/KVBLK-t0;
  DMA_K(0,0);DMA_V(0,0);DMA_K(1,SLOTB);
  bf16x8 qr[4];
  #pragma unroll
  for(int d0=0;d0<4;++d0)qr[d0]=*reinterpret_cast<const bf16x8*>(&Qw[(long)r32*DM+d0*16+hi*8]);
  { FLAS float*csw=(FLAS float*)((FLAS char*)shm+LDS_CS); for(int i=tid*4;i<q0+QB-t0*KVBLK;i+=NW*64*4){ const f32x4 v=*(const f32x4*)(cs+t0*KVBLK+i); *(FLAS f32x4*)(csw+i)=v; } }
  const FLAS float*csl=(const FLAS float*)((FLAS char*)shm+LDS_CS)+4*hi;
  float mhat=0.f,l_reg=0.f,nmh=0.f;f32x16 o[2];o[0]=f32x16{};o[1]=f32x16{};
  const int qrel=wid*QBLK+r32;
  #define CMASK(P0,P1,t) do{int jb_=(t)-(NT-4); if(jb_>=0)cmask(P0,P1,jb_,qrel,hi);}while(0)
  #define CINIT(P0,P1,t) do{ const FLAS float*cb_=csl+(t)*64; _Pragma("unroll") for(int g_=0;g_<4;++g_){ const f32x4 b0_=*(const FLAS f32x4*)(cb_+8*g_), b1_=*(const FLAS f32x4*)(cb_+32+8*g_); \
      { typedef float f2_ __attribute__((ext_vector_type(2))); const f2_ n2_={nmh,nmh}; const f2_ a0_=n2_-(f2_){b0_[0],b0_[1]}, a1_=n2_-(f2_){b0_[2],b0_[3]}, c0_=n2_-(f2_){b1_[0],b1_[1]}, c1_=n2_-(f2_){b1_[2],b1_[3]}; \
        P0[4*g_]=a0_.x; P0[4*g_+1]=a0_.y; P0[4*g_+2]=a1_.x; P0[4*g_+3]=a1_.y; P1[4*g_]=c0_.x; P1[4*g_+1]=c0_.y; P1[4*g_+2]=c1_.x; P1[4*g_+3]=c1_.y; } } }while(0)
  bool resc=false;
  #define START(P0,P1) do{ const float rm=rowmax(P0,P1); resc=false; \
    { const float dl=rm; mhat=fadd_s(mhat,dl); \
      _Pragma("unroll") for(int r=0;r<16;++r){P0[r]=fsub_s(P0[r],dl);P1[r]=fsub_s(P1[r],dl);} \
      nmh=-mhat; } \
    _Pragma("unroll") for(int r=0;r<16;++r)P0[r]=__builtin_amdgcn_exp2f(P0[r]); }while(0)
  #define RESC() do{ if(resc){ asm volatile("s_waitcnt lgkmcnt(0)":::"memory"); \
      _Pragma("unroll") for(int d_=0;d_<2;++d_) _Pragma("unroll") for(int r=0;r<16;++r)o[d_][r]*=wsf[crow(r,hi)]; } }while(0)
  f32x16 pA0,pA1,pB0,pB1;
  int sl_prev=0,sl_cur=0,sl_next=SLOTB;
  #define ROT() do{sl_prev=sl_cur;sl_cur=sl_next;sl_next=(sl_next==(NSLOT-1)*SLOTB)?0:sl_next+SLOTB;}while(0)
  DMA_K(2,2*SLOTB);
  WAIT_BAR(3);
  CINIT(pA0,pA1,0); qkt(pA0,pA1,Kbase,qr,r32,hi);asm volatile("s_nop 15\n\ts_nop 7":"+v"(pA0),"+v"(pA1));CMASK(pA0,pA1,0);
  START(pA0,pA1);
  _Pragma("unroll") for(int r=0;r<16;++r)pA1[r]=__builtin_amdgcn_exp2f(pA1[r]);
  WAIT_BAR(0);
  DMA_K(3,0);DMA_V(1,SLOTB);
  ROT();
  kload8(kf,kp0+sl_cur);
  WAIT_BAR(2);
  s16x4 vlo[8],vhi[8]; u32x4 pw0,pw1,pw2,pw3;
  #define PKW(P,B) cvtpk_s(P[B],P[B+1])
  #define PAF(k) __builtin_bit_cast(bf16x8,pw##k)
  #define VFR(i) (bf16x8){vlo[i][0],vlo[i][1],vlo[i][2],vlo[i][3],vhi[i][0],vhi[i][1],vhi[i][2],vhi[i][3]}
  #define PIN(x) asm volatile("":"+v"(x))
  #define MX3(a,b,c) __builtin_fmaxf(__builtin_fmaxf((a),(b)),(c))
  #define GAPA(MF,A0,A1,A2,A3,W0,W1,PW) do{ MF; sacc+=A0; sacc+=A1; sacc+=A2; sacc+=A3; PIN(sacc); W0; W1; PIN(PW); SBAR(); }while(0)
  #define EX(v) __builtin_amdgcn_exp2f(v)
  #define GAPB(MF,X,B) do{ MF; X[B]=EX(X[B]); X[B+1]=EX(X[B+1]); X[B+2]=EX(X[B+2]); X[B+3]=EX(X[B+3]); PIN(X); SBAR(); }while(0)
  #define VRD(i) do{ vlo[i]=vtr(vp_+(((i)>>2)*4096+((i)&3)*1024)); vhi[i]=vtr(vp_+(((i)>>2)*4096+((i)&3)*1024+512)); }while(0)
  #define KRD(G,j) do{ if(G){ kload2(kf,kp0+sl_next,j); SBAR(); } }while(0)
  #define STEP(C0,C1,P0,P1,t,GK,GV,GL) do{ SBAR(); CINIT(C0,C1,t); SBAR(); \
    const lds_cptr vp_=vp0+sl_prev; \
    VRD(0); SBAR(); float sacc=(P0[0]+P0[1]); \
    GAPA(C0=__builtin_amdgcn_mfma_f32_32x32x16_bf16(kf[0],qr[0],C0,0,0,0), P0[2],P0[3],P0[4],P0[5],     pw0[0]=PKW(P0,0), pw0[1]=PKW(P0,2), pw0); \
    VRD(4); SBAR(); GAPA(C1=__builtin_amdgcn_mfma_f32_32x32x16_bf16(kf[1],qr[0],C1,0,0,0), P0[6],P0[7],P0[8],P0[9],     pw0[2]=PKW(P0,4), pw0[3]=PKW(P0,6), pw0); \
    VRD(1); SBAR(); GAPA(C0=__builtin_amdgcn_mfma_f32_32x32x16_bf16(kf[2],qr[1],C0,0,0,0),   P0[10],P0[11],P0[12],P0[13], pw1[0]=PKW(P0,8), pw1[1]=PKW(P0,10), pw1); \
    VRD(5); SBAR(); GAPA(C1=__builtin_amdgcn_mfma_f32_32x32x16_bf16(kf[3],qr[1],C1,0,0,0),   P0[14],P0[15],P1[0],P1[1],   pw1[2]=PKW(P0,12),pw1[3]=PKW(P0,14), pw1); \
    VRD(2); SBAR(); GAPA(C0=__builtin_amdgcn_mfma_f32_32x32x16_bf16(kf[4],qr[2],C0,0,0,0),   P1[2],P1[3],P1[4],P1[5],     pw2[0]=PKW(P1,0), pw2[1]=PKW(P1,2), pw2); \
    VRD(6); SBAR(); GAPA(C1=__builtin_amdgcn_mfma_f32_32x32x16_bf16(kf[5],qr[2],C1,0,0,0),   P1[6],P1[7],P1[8],P1[9],     pw2[2]=PKW(P1,4), pw2[3]=PKW(P1,6), pw2); \
    VRD(3); SBAR(); GAPA(C0=__builtin_amdgcn_mfma_f32_32x32x16_bf16(kf[6],qr[3],C0,0,0,0),   P1[10],P1[11],P1[12],P1[13], pw3[0]=PKW(P1,8), pw3[1]=PKW(P1,10), pw3); \
    VRD(7); SBAR(); GAPA(C1=__builtin_amdgcn_mfma_f32_32x32x16_bf16(kf[7],qr[3],C1,0,0,0),   P1[14],P1[15],0.f,0.f,       pw3[2]=PKW(P1,12),pw3[3]=PKW(P1,14), pw3); \
    l_reg+=sacc; \
    if(GK){DMA_K((t)+3,sl_cur);} if(GV){DMA_V((t)+1,sl_next);} \
    CMASK(C0,C1,t); \
    { float a=MX3(C0[0],C0[1],C1[0]),b=MX3(C0[2],C0[3],C1[1]); a=MX3(a,C1[2],C1[3]); \
      _Pragma("unroll") for(int r=4;r<16;r+=4){a=MX3(a,C0[r],C0[r+1]);b=MX3(b,C0[r+2],C0[r+3]);a=MX3(a,C1[r],C1[r+1]);b=MX3(b,C1[r+2],C1[r+3]);} \
      float rm=__builtin_fmaxf(a,b); { auto rr=__builtin_amdgcn_permlane32_swap(__float_as_uint(rm),__float_as_uint(rm),false,false); rm=__builtin_fmaxf(__uint_as_float(rr[0]),__uint_as_float(rr[1])); } \
      resc=false; \
      if(__builtin_expect(__any(rm>(float)THRL),0)){ const float dl=__builtin_fmaxf(rm,0.f); mhat+=dl; \
        _Pragma("unroll") for(int r=0;r<16;++r){C0[r]-=dl;C1[r]-=dl;} \
        nmh=-mhat; \
        const float f=__builtin_amdgcn_exp2f(-dl); l_reg*=f; if(hi==0)wsf[r32]=f; resc=true; } } \
    SBAR(); \
    GAPB(o[0]=__builtin_amdgcn_mfma_f32_32x32x16_bf16(PAF(0),VFR(0),o[0],0,0,0), C0,0); \
    GAPB(o[1]=__builtin_amdgcn_mfma_f32_32x32x16_bf16(PAF(0),VFR(4),o[1],0,0,0), C0,4); \
    KRD(GL,0); GAPB(o[0]=__builtin_amdgcn_mfma_f32_32x32x16_bf16(PAF(1),VFR(1),o[0],0,0,0), C0,8); \
    KRD(GL,1); GAPB(o[1]=__builtin_amdgcn_mfma_f32_32x32x16_bf16(PAF(1),VFR(5),o[1],0,0,0), C0,12); \
    KRD(GL,2); GAPB(o[0]=__builtin_amdgcn_mfma_f32_32x32x16_bf16(PAF(2),VFR(2),o[0],0,0,0), C1,0); \
    KRD(GL,3); GAPB(o[1]=__builtin_amdgcn_mfma_f32_32x32x16_bf16(PAF(2),VFR(6),o[1],0,0,0), C1,4); \
    GAPB(o[0]=__builtin_amdgcn_mfma_f32_32x32x16_bf16(PAF(3),VFR(3),o[0],0,0,0), C1,8); \
    GAPB(o[1]=__builtin_amdgcn_mfma_f32_32x32x16_bf16(PAF(3),VFR(7),o[1],0,0,0), C1,12); \
    }while(0)
  int t=1;
  #undef CMASK
  #define CMASK(P0,P1,t) do{}while(0)
  for(;t+5<NT;t+=2){
    STEP(pB0,pB1,pA0,pA1,t,true,true,true);     WAIT_BAR(2); RESC(); ROT();
    STEP(pA0,pA1,pB0,pB1,t+1,true,true,true);   WAIT_BAR(2); RESC(); ROT();
  }
  #undef CMASK
  #define CMASK(P0,P1,t) do{int jb_=(t)-(NT-4); if(jb_>=0)cmask(P0,P1,jb_,qrel,hi);}while(0)
  #define ENDW(tt) do{ if((tt)+3<NT){WAIT_BAR(2);} else if((tt)+2<NT){WAIT_BAR(1);} else {WAIT_BAR(0);} }while(0)
  for(;t+1<NT;t+=2){
    STEP(pB0,pB1,pA0,pA1,t,(t+3<NT),(t+1<NT),(t+1<NT));       ENDW(t);   RESC(); ROT();
    STEP(pA0,pA1,pB0,pB1,t+1,(t+4<NT),(t+2<NT),(t+2<NT));     ENDW(t+1); RESC(); ROT();
  }
  STEP(pB0,pB1,pA0,pA1,NT-1,false,false,false); RESC();
  { float sacc=pB0[0]+pB0[1]; _Pragma("unroll") for(int r=2;r<16;++r)sacc+=pB0[r]; _Pragma("unroll") for(int r=0;r<16;++r)sacc+=pB1[r]; l_reg+=sacc;
    pw0=(u32x4){PKW(pB0,0),PKW(pB0,2),PKW(pB0,4),PKW(pB0,6)};pw1=(u32x4){PKW(pB0,8),PKW(pB0,10),PKW(pB0,12),PKW(pB0,14)};pw2=(u32x4){PKW(pB1,0),PKW(pB1,2),PKW(pB1,4),PKW(pB1,6)};pw3=(u32x4){PKW(pB1,8),PKW(pB1,10),PKW(pB1,12),PKW(pB1,14)};
    SBAR(); pv(o,vb0+sl_cur,PAF(0),PAF(1),PAF(2),PAF(3)); }
  #undef PKW
  #undef PAF
  #undef VFR
  #undef PIN
  #undef MX3
  #undef GAPA
  #undef GAPB
  #undef EX
  #undef VRD
  #undef KRD
  #undef STEP
  #undef ENDW
  {auto rr=__builtin_amdgcn_permlane32_swap(__float_as_uint(l_reg),__float_as_uint(l_reg),false,false);l_reg=__uint_as_float(rr[0])+__uint_as_float(rr[1]);}
  if(hi==0)wsf[32+r32]=l_reg;asm volatile("s_waitcnt lgkmcnt(0)":::"memory");
  float rli[16];
  #pragma unroll
  for(int r=0;r<16;++r)rli[r]=__builtin_amdgcn_rcpf(wsf[32+crow(r,hi)]);
  bf16*Ow=O+(rowbase+q0+wid*QBLK)*DMO+ocol;
  { bf16*stg=(bf16*)(shm+LDS_OST)+wid*2048;
    #pragma unroll
    for(int r=0;r<16;++r){const int orow=crow(r,hi);
      #pragma unroll
      for(int d0=0;d0<2;++d0)stg[orow*64+d0*32+r32]=__float2bfloat16(o[d0][r]*rli[r]);}
    asm volatile("s_waitcnt lgkmcnt(0)":::"memory");
    #pragma unroll
    for(int i=0;i<4;++i){const int row=i*8+(lane>>3),ch=lane&7; const u32x4 v=*(const u32x4*)(stg+row*64+ch*8); ATTN_STORE16(Ow+(long)row*DMO+ch*8,v);} }
  asm volatile("s_waitcnt lgkmcnt(0)\n\ts_barrier":::"memory");
  #undef DMA_K
  #undef DMA_V
  #undef CMASK
  #undef CINIT
  #undef START
  #undef RESC
  #undef ROT
}
constexpr int ATTN_LDS_BYTES=LDS_BYTES;
#undef SBAR
#undef WAIT_BAR
#undef FLAS
}
constexpr int NWAVES = 8;
constexpr int BATCH = 8, SEQ = 4096, DM = 1024, DFF = 2816, TOK = BATCH * SEQ;
constexpr int NWIN = 5120;
constexpr int MH = 4, MDK = 64, MDV = 128, FH = 8, FD = 64, CH = 64, NCH = SEQ / CH;
constexpr float EPS = 1e-6f;
constexpr float LOG2E = 1.4426950408889634f;
constexpr float QC2 = 0.125f * LOG2E;

constexpr size_t MiB = 1u << 20;
constexpr size_t WS_CTL = 0, CTL_ZERO_BYTES = 32768;
constexpr size_t WS_W1GU = 2 * MiB;
constexpr size_t WS_W1D = 13 * MiB;
constexpr size_t WS_W2GU = 19 * MiB;
constexpr size_t WS_W2D = 30 * MiB;
constexpr size_t WS_WIN = 36 * MiB;
constexpr size_t WS_WAB = 47 * MiB;
constexpr size_t WS_WOUT = 49 * MiB;
constexpr size_t WS_WPG = 51 * MiB;
constexpr size_t WS_WPP = 53 * MiB;
constexpr size_t WS_GATES = 54 * MiB;
constexpr size_t WS_MA = 56 * MiB;
constexpr size_t WS_MB = 56 * MiB + 512 * 1024;
constexpr size_t WS_MSC = 57 * MiB;
constexpr size_t WS_MDN = 57 * MiB + 256 * 1024;
constexpr size_t WS_FCS = 58 * MiB;
constexpr size_t WS_FCT = 59 * MiB;
constexpr size_t WS_RMS = 60 * MiB;
constexpr size_t WS_XN = 64 * MiB;
constexpr size_t WS_Y = 128 * MiB;
constexpr size_t WS_R = 192 * MiB;
constexpr size_t WS_H = WS_R;
constexpr size_t WS_PB = WS_R + 176 * MiB;
constexpr size_t WS_EMB = WS_R + 192 * MiB;
constexpr size_t WS_SEG0 = WS_R;
constexpr size_t WS_GA = WS_R + 192 * MiB, WS_GB = WS_R + 256 * MiB;
constexpr size_t WS_QK = WS_Y;
constexpr size_t WS_CST = WS_Y + 32 * MiB;
constexpr size_t WS_END = 512 * MiB;
constexpr int CW_TMO = 0, CW_CODE = 1, CW_DBG = 64, CW_NRM = 256, CW_BAR = 4096;
static_assert((CW_BAR + 3456) * 4 <= (int)CTL_ZERO_BYTES && (CW_NRM + 256) <= CW_BAR, "control words inside the per-call memset");

constexpr int RING_OFF = 0, RING_BYTES = 131072;
constexpr int LDSCTL_OFF = RING_BYTES, MISC_OFF = LDSCTL_OFF + 320;
constexpr int LDS_BYTES = 147456;

#define GAS __attribute__((address_space(1)))
#define LAS __attribute__((address_space(3)))
typedef unsigned short bf16;
typedef unsigned v4u __attribute__((ext_vector_type(4)));
typedef unsigned v2u __attribute__((ext_vector_type(2)));
typedef float f32x4 __attribute__((ext_vector_type(4)));
typedef short bf16x8 __attribute__((ext_vector_type(8)));
typedef GAS unsigned gu32;
#define RLX_AGENT __ATOMIC_RELAXED, __HIP_MEMORY_SCOPE_AGENT
#define LDS_WAIT() asm volatile("s_waitcnt lgkmcnt(0)" ::: "memory")
#define VM_WAIT() asm volatile("s_waitcnt vmcnt(0)" ::: "memory")
__device__ __forceinline__ unsigned f2bf(float f) { unsigned u = __builtin_bit_cast(unsigned, f); return (u + 0x7fffu + ((u >> 16) & 1u)) >> 16; }
__device__ __forceinline__ unsigned pk2(float lo, float hi) { return f2bf(lo) | (f2bf(hi) << 16); }
__device__ __forceinline__ float bf2f(unsigned short h) { return __uint_as_float(((unsigned)h) << 16); }

#define XB_TMO      128
#define XB_XCNT(j)  (256  + 64 * (j))
#define XB_XSUB(j)  (1280 + 64 * (j))
#define XB_XGEN(j)  (2304 + 64 * (j))
#define XB_TOP      3328
#define XB_TOPGEN   3392
#define XCD_BAR_WORDS 3456
#define XB_SPIN_CAP (1u << 20)
__device__ __forceinline__ unsigned xb_ld(unsigned* p)              { return __hip_atomic_load(p, __ATOMIC_RELAXED, __HIP_MEMORY_SCOPE_AGENT); }
__device__ __forceinline__ unsigned xb_add(unsigned* p, unsigned v) { return __hip_atomic_fetch_add(p, v, __ATOMIC_RELAXED, __HIP_MEMORY_SCOPE_AGENT); }
__device__ __forceinline__ unsigned xb_xcc_id() { return (unsigned)__builtin_amdgcn_s_getreg((3 << 11) | 20) & 0xFu; }
#define XB_SPIN(cond, bar) do { unsigned _sp = 0; while (cond) { __builtin_amdgcn_s_sleep(1); \
    if ((++_sp & 255u) == 0u) { if (xb_ld(&(bar)[XB_TMO])) break; if (_sp > XB_SPIN_CAP) { atomicAdd(&(bar)[XB_TMO], 1u); break; } } } } while (0)
struct XcdBarrier { unsigned* bar; unsigned x; volatile LAS unsigned* st; };
__device__ __forceinline__ XcdBarrier xcd_barrier_post(unsigned* bar, volatile LAS unsigned* st) {
    XcdBarrier b; b.bar = bar; b.x = xb_xcc_id(); b.st = st;
    if (threadIdx.x == 0) (void)xb_add(&bar[XB_XCNT(b.x)], 1u);
    return b;
}
__device__ __forceinline__ void xcd_barrier_complete(unsigned* bar, unsigned x, unsigned& nloc, unsigned& nx) {
    const unsigned G = gridDim.x * gridDim.y * gridDim.z;
    unsigned sum, cnt, mine, sp = 0u;
    for (;;) {
        sum = 0u; cnt = 0u; mine = 0u;
#pragma unroll
        for (unsigned j = 0; j < 16; ++j) { const unsigned c = xb_ld(&bar[XB_XCNT(j)]); sum += c; cnt += (c > 0u) ? 1u : 0u; mine = (j == x) ? c : mine; }
        if (sum == G) break;
        __builtin_amdgcn_s_sleep(1);
        if ((++sp & 255u) == 0u) { if (xb_ld(&bar[XB_TMO])) break; if (sp > XB_SPIN_CAP) { atomicAdd(&bar[XB_TMO], 1u); break; } }
    }
    nloc = mine > 0u ? mine : 1u; nx = cnt > 0u ? cnt : 1u;
}
__device__ __forceinline__ void xcd_barrier(const XcdBarrier& b) {
    asm volatile("s_waitcnt vmcnt(0)" ::: "memory");
    __syncthreads();
    if (threadIdx.x == 0) {
        unsigned* bar = b.bar;
        __builtin_amdgcn_s_waitcnt(0);
        unsigned nloc = b.st[0], nx = b.st[1];
        if (nloc == 0u) { xcd_barrier_complete(bar, b.x, nloc, nx); b.st[0] = nloc; b.st[1] = nx; }
        const unsigned old = xb_add(&bar[XB_XSUB(b.x)], 1u);
        const unsigned gen = old / nloc;
        if (old + 1u == (gen + 1u) * nloc) {
            __builtin_amdgcn_fence(__ATOMIC_RELEASE, "agent");
            asm volatile("s_waitcnt vmcnt(0)" ::: "memory");
            const unsigned og = xb_add(&bar[XB_TOP], 1u);
            const unsigned tg = og / nx;
            if (og + 1u == (tg + 1u) * nx) xb_add(&bar[XB_TOPGEN], 1u);
            else XB_SPIN(xb_ld(&bar[XB_TOPGEN]) == tg, bar);
            __builtin_amdgcn_fence(__ATOMIC_ACQUIRE, "agent");
            xb_add(&bar[XB_XGEN(b.x)], 1u);
            asm volatile("s_waitcnt vmcnt(0)" ::: "memory");
        } else {
            XB_SPIN(xb_ld(&bar[XB_XGEN(b.x)]) == gen, bar);
            __builtin_amdgcn_fence(__ATOMIC_ACQUIRE, "agent");
            asm volatile("s_waitcnt vmcnt(0)" ::: "memory");
        }
    }
    __syncthreads();
}

struct Args { const float* in[30]; float* out; unsigned char* ws; int ph_lo, ph_hi; };
static_assert(sizeof(Args) == 32 * 8 + 8, "Args has no padding");
struct Frame {
    LAS unsigned char* lds;
    volatile LAS unsigned* MISC;
    gu32* ctl;
    int vcu, G;
    unsigned char* ws;
    const Args* A;
    float* out;
};
struct Tc { int tid, lane, wave; };
__device__ __forceinline__ Tc get_tc() { int t = threadIdx.x; asm volatile("" : "+v"(t)); Tc c; c.tid = t; c.lane = t & 63; c.wave = __builtin_amdgcn_readfirstlane(t >> 6); return c; }
__device__ __forceinline__ float wave_sum(float v) {
#pragma unroll
    for (int o = 1; o < 64; o <<= 1) v += __shfl_xor(v, o);
    return v;
}
__device__ __forceinline__ float wave_max(float v) {
#pragma unroll
    for (int o = 1; o < 64; o <<= 1) v = fmaxf(v, __shfl_xor(v, o));
    return v;
}

constexpr int ER = 4;
__device__ __forceinline__ void bf8_to_f32(const v4u w, f32x4& a, f32x4& b) {
    a.x = __uint_as_float(w.x << 16); a.y = __uint_as_float(w.x & 0xffff0000u); a.z = __uint_as_float(w.y << 16); a.w = __uint_as_float(w.y & 0xffff0000u);
    b.x = __uint_as_float(w.z << 16); b.y = __uint_as_float(w.z & 0xffff0000u); b.z = __uint_as_float(w.w << 16); b.w = __uint_as_float(w.w & 0xffff0000u); }
__device__ __forceinline__ v4u f32_to_bf8(const f32x4 a, const f32x4 b) { v4u w; w.x = pk2(a.x, a.y); w.y = pk2(a.z, a.w); w.z = pk2(b.x, b.y); w.w = pk2(b.z, b.w); return w; }
__device__ __forceinline__ float sumsq8(const f32x4 a, const f32x4 b) { return ((a.x * a.x + a.y * a.y) + (a.z * a.z + a.w * a.w)) + ((b.x * b.x + b.y * b.y) + (b.z * b.z + b.w * b.w)); }
__device__ __forceinline__ void xpose_item(const float* W, const float* gk, float wsc, int Nsrc, int k0, int srccol, int srcvec, bf16* WT, int ldd, int drow0, int dcol0, LAS float* scr, int lane) {
    if (srcvec >= 0) {
        f32x4 t[8];
#pragma unroll
        for (int i = 0; i < 8; ++i) t[i] = *(const f32x4*)(W + (size_t)(k0 + 8 * i + (lane >> 3)) * Nsrc + srcvec + 4 * (lane & 7));
#pragma unroll
        for (int i = 0; i < 8; ++i) { LAS float* d = scr + (8 * i + (lane >> 3)) * 33 + 4 * (lane & 7); const float wv = gk ? wsc * gk[k0 + 8 * i + (lane >> 3)] : wsc; d[0] = t[i].x * wv; d[1] = t[i].y * wv; d[2] = t[i].z * wv; d[3] = t[i].w * wv; }
    } else {
#pragma unroll 8
        for (int i = 0; i < 32; ++i) { const int kk = 2 * i + (lane >> 5); const float wv = gk ? wsc * gk[k0 + kk] : wsc; scr[kk * 33 + (lane & 31)] = (srccol >= 0) ? W[(size_t)(k0 + kk) * Nsrc + srccol] * wv : 0.f; }
    }
    LDS_WAIT(); asm volatile("" ::: "memory");
    const int c = lane & 7;
#pragma unroll
    for (int j = 0; j < 4; ++j) { const int n = (lane >> 3) + 8 * j; const LAS float* s = scr + (8 * c) * 33 + n;
        v4u o; o.x = pk2(s[0 * 33], s[1 * 33]); o.y = pk2(s[2 * 33], s[3 * 33]); o.z = pk2(s[4 * 33], s[5 * 33]); o.w = pk2(s[6 * 33], s[7 * 33]);
        *(GAS v4u*)(WT + (size_t)(drow0 + n) * ldd + dcol0 + 8 * c) = o; }
    LDS_WAIT(); asm volatile("" ::: "memory");
}
__device__ __forceinline__ void rms_row_to_bf16(int lane, const float* xrow, const float* g, bf16* orow) {
    const GAS f32x4* xr = (const GAS f32x4*)xrow + lane; const GAS f32x4* gr = (const GAS f32x4*)g + lane;
    f32x4 v[4]; float s = 0.f;
#pragma unroll
    for (int j = 0; j < 4; ++j) { v[j] = xr[64 * j]; s += (v[j].x * v[j].x + v[j].y * v[j].y) + (v[j].z * v[j].z + v[j].w * v[j].w); }
    const float r = 1.f / sqrtf(wave_sum(s) * (1.f / DM) + EPS);
    GAS v2u* o8 = (GAS v2u*)orow + lane;
#pragma unroll
    for (int j = 0; j < 4; ++j) { const f32x4 gg = gr[64 * j]; v2u w; w.x = pk2(v[j].x * r * gg.x, v[j].y * r * gg.y); w.y = pk2(v[j].z * r * gg.z, v[j].w * r * gg.w); o8[64 * j] = w; }
}
__device__ __forceinline__ void p0_prologue(Frame& F) {
    const Tc tc = get_tc();
    LAS float* scr = (LAS float*)(F.lds + RING_OFF + tc.wave * 16384);
    const int gw = F.vcu * NWAVES + tc.wave, NGW = F.G * NWAVES; const int lane = tc.lane, l31 = lane & 31;
    unsigned char* ws = F.ws;
    constexpr int I0 = 2816, I1 = 1408, I4 = 2688, I5 = 256, I6 = 512, I8 = 128;
    constexpr int NITEMS = 2 * (I0 + I1) + I4 + 2 * I5 + 2 * I6 + I8;
    for (int it = gw; it < NITEMS; it += NGW) {
        int r = it;
        if (r < 2 * (I0 + I1)) {
            const int l2 = r >= (I0 + I1); if (l2) r -= (I0 + I1);
            if (r < I0) {
                const int kb = r / 176, g = r % 176, j = g >> 3, sub = g & 7;
                const float* W = l2 ? ((sub >> 2) ? F.A->in[22] : F.A->in[21]) : ((sub >> 2) ? F.A->in[4] : F.A->in[3]);
                xpose_item(W, l2 ? F.A->in[20] : F.A->in[2], (sub >> 2) ? -0.6931471805599453f : -LOG2E, DFF, 64 * kb,
                           128 * j + 32 * (sub & 3) + l31, 128 * j + 32 * (sub & 3), (bf16*)(ws + (l2 ? WS_W2GU : WS_W1GU)), DM, 32 * g, 64 * kb, scr, lane);
            } else { r -= I0;
                const int kb = r / 32, g = r % 32;
                xpose_item(l2 ? F.A->in[23] : F.A->in[5], nullptr, 1.0f, DM, 64 * kb, 32 * g + l31, 32 * g, (bf16*)(ws + (l2 ? WS_W2D : WS_W1D)) + (size_t)(kb >> 1) * (DM * 128), 128, 32 * g, 64 * (kb & 1), scr, lane);
            }
            continue;
        }
        r -= 2 * (I0 + I1);
        if (r < I4) {
            const int kb = r / 168, g = r % 168, r0 = 32 * g; int sc;
            if (r0 < 1536) sc = r0 + l31; else if (r0 < 3072) sc = r0 + 8 + l31;
            else if (r0 < 5120) { const int tj = (r0 - 3072) >> 8, wi = (r0 - 3072) & 255; sc = ((wi < 128) ? 3088 + 128 * tj + wi : 4112 + 128 * tj + (wi - 128)) + l31; }
            else if (r0 == 5120) sc = (l31 < 8) ? 1536 + l31 : (l31 < 16) ? 3080 + (l31 - 8) : -1; else sc = -1;
            const int sv = (r0 < 5120) ? sc - l31 : -1;
            const float wsc = ((r0 >= 1024 && r0 < 1536) || (r0 >= 3072 && r0 < 5120)) ? -LOG2E : 1.0f;
            xpose_item(F.A->in[8], F.A->in[7], wsc, 5136, 64 * kb, sc, sv, (bf16*)(ws + WS_WIN), DM, r0, 64 * kb, scr, lane);
            continue;
        }
        r -= I4;
        if (r < 2 * I5) { const int hb = r >= I5; if (hb) r -= I5; const int kb = r / 32, g = r % 32;
            xpose_item(hb ? F.A->in[17] : F.A->in[16], nullptr, 1.0f, DM, 64 * kb, 32 * g + l31, 32 * g, (bf16*)(ws + WS_WAB), DM, 32 * g, 512 * hb + 64 * kb, scr, lane); continue; }
        r -= 2 * I5;
        if (r < 2 * I6) { const int hb = r >= I6; if (hb) r -= I6; const int kb = r / 32, g = r % 32;
            xpose_item(hb ? F.A->in[26] : F.A->in[18], hb ? F.A->in[25] : nullptr, 1.0f,     DM, 64 * kb, 32 * g + l31, 32 * g, (bf16*)(ws + (hb ? WS_WPG : WS_WOUT)), DM, 32 * g, 64 * kb, scr, lane); continue; }
        r -= 2 * I6;
        { const int kb = r / 32, g = r % 32;
            xpose_item(F.A->in[28], nullptr, 1.0f, DM, 64 * kb, 32 * g + l31, 32 * g, (bf16*)(ws + WS_WPP), 256, 32 * g, 64 * kb, scr, lane); }
    }
    bf16* XN = (bf16*)(ws + WS_XN);
    {
        for (int m0 = gw; m0 < TOK; m0 += ER * NGW) {
            f32x4 v[ER][2][2]; float sq[ER];
#pragma unroll
            for (int i = 0; i < ER; ++i) { const int m = (m0 + i * NGW < TOK) ? m0 + i * NGW : m0; const float* xr = F.A->in[0] + (size_t)m * DM + 8 * lane;
#pragma unroll
                for (int j = 0; j < 2; ++j) { v[i][j][0] = *(const f32x4*)(xr + 512 * j); v[i][j][1] = *(const f32x4*)(xr + 512 * j + 4); } }
#pragma unroll
            for (int i = 0; i < ER; ++i) sq[i] = sumsq8(v[i][0][0], v[i][0][1]) + sumsq8(v[i][1][0], v[i][1][1]);
#pragma unroll
            for (int o = 1; o < 64; o <<= 1)
#pragma unroll
                for (int i = 0; i < ER; ++i) sq[i] += __shfl_xor(sq[i], o);
#pragma unroll
            for (int i = 0; i < ER; ++i) if (m0 + i * NGW < TOK) { bf16* orow = XN + (size_t)(m0 + i * NGW) * DM + 8 * lane;
                if (lane == 0) ((float*)(ws + WS_RMS))[m0 + i * NGW] = 1.f / sqrtf(sq[i] * (1.f / DM) + EPS);
#pragma unroll
                for (int j = 0; j < 2; ++j) *(v4u*)(orow + 512 * j) = f32_to_bf8(v[i][j][0], v[i][j][1]); }
        }
    }
}

constexpr int EB = 2;
template <int XNM, bool GATES, int RIN, bool ROUT16>
__device__ __forceinline__ void ew_phase(Frame& F, const bf16* Y, const void* res, void* out, float coef, const float* gpost, const float* gpre, bf16* XN, const float* gin = nullptr, const float* rms = nullptr, float* rsout = nullptr) {
    constexpr bool RIN16 = (RIN != 0); constexpr bool HAS_XN = (XNM == 1);
    const Tc tc = get_tc(); const int lane = tc.lane;
    const int gw = F.vcu * NWAVES + tc.wave, NGW = F.G * NWAVES;
    const int nbat = (TOK / EB - gw + NGW - 1) / NGW;
    v4u yw[EB][2]; v4u rw16[EB][2]; f32x4 rw32[EB][2][2]; float rmv[EB];
    constexpr int WGP = 1032;
    if constexpr (GATES) {
        LAS bf16* LWG = (LAS bf16*)F.lds;
        for (int i = tc.tid; i < 16 * 128; i += NWAVES * 64) { const int r = i >> 7, c8 = (i & 127) * 8;
            *(LAS v4u*)(LWG + r * WGP + c8) = *(const v4u*)((const bf16*)(F.ws + WS_WIN) + (size_t)(5120 + r) * DM + c8); }
        LDS_WAIT(); __syncthreads();
    }
#define EW_ROW0(it) (EB * (gw + (it) * NGW))
#define EW_LOAD(it) do { unsigned l16_ = (unsigned)lane * 16u; asm volatile("" : "+v"(l16_)); const int mb_ = EW_ROW0(it); \
        _Pragma("unroll") for (int i = 0; i < EB; ++i) { const char* yb_ = (const char*)Y + (size_t)(mb_ + i) * (DM * 2); \
            if constexpr (RIN == 2) rmv[i] = rms[mb_ + i]; \
            if constexpr (RIN16) { const char* rb_ = (const char*)res + (size_t)(mb_ + i) * (DM * 2); \
                _Pragma("unroll") for (int j = 0; j < 2; ++j) { yw[i][j] = *(const v4u*)(yb_ + l16_ + 1024 * j); rw16[i][j] = *(const v4u*)(rb_ + l16_ + 1024 * j); } } \
            else { const char* rb_ = (const char*)res + (size_t)(mb_ + i) * (DM * 4); \
                _Pragma("unroll") for (int j = 0; j < 2; ++j) { yw[i][j] = *(const v4u*)(yb_ + l16_ + 1024 * j); rw32[i][j][0] = *(const f32x4*)(rb_ + 2 * l16_ + 2048 * j); rw32[i][j][1] = *(const f32x4*)(rb_ + 2 * l16_ + 2048 * j + 16); } } } } while (0)
    f32x4 g1[2][2], g2[2][2], gi[2][2];
    { const unsigned lg = (unsigned)lane * 32u;
#pragma unroll
      for (int j = 0; j < 2; ++j)
#pragma unroll
        for (int q = 0; q < 2; ++q) { g1[j][q] = *(const f32x4*)((const char*)gpost + lg + 2048 * j + 16 * q);
            if constexpr (XNM == 1) g2[j][q] = *(const f32x4*)((const char*)gpre + lg + 2048 * j + 16 * q);
            if constexpr (RIN == 2) { const f32x4 g = *(const f32x4*)((const char*)gin + lg + 2048 * j + 16 * q); gi[j][q] = (f32x4){__builtin_amdgcn_rcpf(g.x), __builtin_amdgcn_rcpf(g.y), __builtin_amdgcn_rcpf(g.z), __builtin_amdgcn_rcpf(g.w)}; } } }
    if (nbat > 0) EW_LOAD(0);
#pragma unroll 1
    for (int it = 0; it < nbat; ++it) {
        const int m0 = EW_ROW0(it);
        unsigned l16 = (unsigned)lane * 16u; asm volatile("" : "+v"(l16));
        f32x4 y[EB][2][2], h[EB][2][2]; float s[EB], s2[EB];
#pragma unroll
        for (int i = 0; i < EB; ++i) { s[i] = 0.f;
#pragma unroll
            for (int j = 0; j < 2; ++j) { bf8_to_f32(yw[i][j], y[i][j][0], y[i][j][1]);
                if constexpr (RIN16) bf8_to_f32(rw16[i][j], h[i][j][0], h[i][j][1]); else { h[i][j][0] = rw32[i][j][0]; h[i][j][1] = rw32[i][j][1]; }
                if constexpr (RIN == 2) { h[i][j][0] = h[i][j][0] * rmv[i] * gi[j][0]; h[i][j][1] = h[i][j][1] * rmv[i] * gi[j][1]; }
                s[i] += sumsq8(y[i][j][0], y[i][j][1]); } }
        asm volatile("" ::: "memory");
        if (it + 1 < nbat) EW_LOAD(it + 1);
#pragma unroll
        for (int o = 1; o < 64; o <<= 1)
#pragma unroll
            for (int i = 0; i < EB; ++i) s[i] += __shfl_xor(s[i], o);
#pragma unroll
        for (int i = 0; i < EB; ++i) { const float r = coef / sqrtf(s[i] * (1.f / DM) + EPS); s2[i] = 0.f;
#pragma unroll
            for (int j = 0; j < 2; ++j) { h[i][j][0] = h[i][j][0] + y[i][j][0] * r * g1[j][0]; h[i][j][1] = h[i][j][1] + y[i][j][1] * r * g1[j][1]; s2[i] += sumsq8(h[i][j][0], h[i][j][1]); }
            if constexpr (ROUT16) { char* ob = (char*)out + (size_t)(m0 + i) * (DM * 2);
#pragma unroll
                for (int j = 0; j < 2; ++j) *(v4u*)(ob + l16 + 1024 * j) = f32_to_bf8(h[i][j][0], h[i][j][1]);
            } else { char* ob = (char*)out + (size_t)(m0 + i) * (DM * 4);
#pragma unroll
                for (int j = 0; j < 2; ++j) { *(f32x4*)(ob + 2 * l16 + 2048 * j) = h[i][j][0]; *(f32x4*)(ob + 2 * l16 + 2048 * j + 16) = h[i][j][1]; } } }
        if constexpr (XNM == 2) {
#pragma unroll
            for (int o = 1; o < 64; o <<= 1)
#pragma unroll
                for (int i = 0; i < EB; ++i) s2[i] += __shfl_xor(s2[i], o);
            if (lane == 0) {
#pragma unroll
                for (int i = 0; i < EB; ++i) rsout[m0 + i] = 1.f / sqrtf(s2[i] * (1.f / DM) + EPS); }
        }
        if constexpr (HAS_XN) {
#pragma unroll
            for (int o = 1; o < 64; o <<= 1)
#pragma unroll
                for (int i = 0; i < EB; ++i) s2[i] += __shfl_xor(s2[i], o);
#pragma unroll
            for (int i = 0; i < EB; ++i) { const float r2 = 1.f / sqrtf(s2[i] * (1.f / DM) + EPS);
                char* xb = (char*)XN + (size_t)(m0 + i) * (DM * 2);
#pragma unroll
                for (int j = 0; j < 2; ++j) *(v4u*)(xb + l16 + 1024 * j) = f32_to_bf8(h[i][j][0] * r2 * g2[j][0], h[i][j][1] * r2 * g2[j][1]); }
        }
        if constexpr (GATES) { if ((it & 7) == 7 || it + 1 == nbat) {
            const int it0 = it & ~7;
            VM_WAIT();
            int ln = lane; asm volatile("" : "+v"(ln));
            const int qa = ln & 15; int ita = it0 + (qa >> 1); ita = ita < nbat ? ita : it0;
            const bf16* arow = (const bf16*)out + (size_t)(EW_ROW0(ita) + (qa & 1)) * DM + 8 * (ln >> 4);
            const LAS bf16* brow = (const LAS bf16*)F.lds + (ln & 15) * WGP + 8 * (ln >> 4);
            f32x4 acc = {0.f, 0.f, 0.f, 0.f};
#pragma unroll 16
            for (int kk = 0; kk < 32; ++kk) { const bf16x8 a = *(const bf16x8*)(arow + 32 * kk), b = *(const LAS bf16x8*)(brow + 32 * kk);
                acc = __builtin_amdgcn_mfma_f32_16x16x32_bf16(a, b, acc, 0, 0, 0); }
            const int n = ln & 15; const float* bp = (n < 4) ? F.A->in[11] + n : (n < 8) ? F.A->in[12] + (n - 4) : F.A->in[14] + (n - 8); const float bias = *bp;
#pragma unroll
            for (int r = 0; r < 4; ++r) { const int q = 4 * (ln >> 4) + r, itq = it0 + (q >> 1);
                if (itq < nbat) { const int grow = EW_ROW0(itq) + (q & 1); ((float*)(F.ws + WS_GATES))[(size_t)grow * 16 + n] = acc[r] * rsout[grow] + bias; } }
        } }
    }
#undef EW_ROW0
#undef EW_LOAD
}
typedef float f32x16 __attribute__((ext_vector_type(16)));
#define MFMA32(a, b, c) __builtin_amdgcn_mfma_f32_32x32x16_bf16(a, b, c, 0, 0, 0)
__device__ __forceinline__ int crow16(int r, int hi) { return (r & 3) + 8 * (r >> 2) + 4 * hi; }
__device__ __forceinline__ float log_sigmoid_f(float x) { return fminf(x, 0.f) - log1pf(expf(-fabsf(x))); }
__device__ __forceinline__ float wave_incl_scan_add(float v, int lane) {
#pragma unroll
    for (int o = 1; o < 64; o <<= 1) { const float t = __shfl_up(v, o); if (lane >= o) v += t; }
    return v;
}
__device__ __forceinline__ float wave_incl_scan_max(float v, int lane) {
#pragma unroll
    for (int o = 1; o < 64; o <<= 1) { const float t = __shfl_up(v, o); if (lane >= o) v = fmaxf(v, t); }
    return v;
}
__device__ __forceinline__ int swap23(int s) { return (s & ~12) | ((s & 4) << 1) | ((s & 8) >> 1); }
constexpr int LP = 72;

struct M1In { v4u xq[4], xk[4]; v4u v0, v1; float g0, g1; };
__device__ __forceinline__ void m1_load(Frame& F, int u, M1In& R) {
    const Tc tc = get_tc(); const int tid = tc.tid, lane = tc.lane, wave = tc.wave;
    const int h = u & 3, c = (u >> 2) & 63, b = u >> 8, tok0 = b * SEQ + c * CH, tt = tid >> 3, cg = tid & 7;
    unsigned char* ws = F.ws;
    const bf16* mqk = (const bf16*)(ws + WS_SEG0);
#pragma unroll
    for (int j = 0; j < 4; ++j) { const int ts = c * CH + tt - 3 + j;
        R.xq[j] = (v4u){0u, 0u, 0u, 0u}; R.xk[j] = (v4u){0u, 0u, 0u, 0u};
        if (ts >= 0 && (j == 3 || (tt & 7) < 3 - j)) { const bf16* rp = mqk + (size_t)(b * SEQ + ts) * 512 + 64 * h + 8 * cg; R.xq[j] = *(const v4u*)rp; R.xk[j] = *(const v4u*)(rp + 256); } }
    const bf16* mv = (const bf16*)(ws + WS_SEG0 + 32 * MiB) + (size_t)(tok0 + tt) * 512 + 128 * h + 16 * cg;
    R.v0 = *(const v4u*)mv; R.v1 = *(const v4u*)(mv + 8);
    const float* gr = (const float*)(ws + WS_GATES) + (size_t)(tok0 + lane) * 16;
    R.g0 = 0.f; R.g1 = 0.f;
    if (wave == 0) { R.g0 = gr[h]; R.g1 = gr[4 + h]; } else if (wave <= 2) { R.g0 = gr[8 + 2 * h + (wave - 1)]; }
}
__device__ __forceinline__ void m1_phase(Frame& F) {
    constexpr int NU = BATCH * NCH * MH;
    int u = F.vcu; if (u >= NU) return;
    unsigned char* ws = F.ws; LAS unsigned char* L = F.lds;
    LAS bf16* LKT = (LAS bf16*)(L);
    LAS bf16* LVT = (LAS bf16*)(L + 64 * LP * 2);
    LAS float* LW = (LAS float*)(L + 64 * LP * 2 + 128 * LP * 2);
    M1In R; m1_load(F, u, R);
    f32x4 cwv[2][4][2]; f32x4 cbv[2][2]; int hcur = -1;
#pragma unroll 1
    for (; u < NU; u += F.G) {
        const Tc tc = get_tc(); const int tid = tc.tid, lane = tc.lane, wave = tc.wave;
        const int h = u & 3, c = (u >> 2) & 63, b = u >> 8, tok0 = b * SEQ + c * CH, uidx = (b * MH + h) * NCH + c, tt = tid >> 3, cg = tid & 7;
        if (h != hcur) { hcur = h; const float* cw = F.A->in[9]; const float* cb = F.A->in[10];
#pragma unroll
            for (int part = 0; part < 2; ++part) { const int ch0 = part * 256 + 64 * h + 8 * cg; cbv[part][0] = *(const f32x4*)(cb + ch0); cbv[part][1] = *(const f32x4*)(cb + ch0 + 4);
#pragma unroll
                for (int j = 0; j < 4; ++j) { cwv[part][j][0] = *(const f32x4*)(cw + j * 512 + ch0); cwv[part][j][1] = *(const f32x4*)(cw + j * 512 + ch0 + 4); } } }
        if (wave == 0) {
            const float ig = R.g0, lf = log_sigmoid_f(R.g1);
            const float bs = wave_incl_scan_add(lf, lane), a = ig - bs, amax = wave_max(a);
            ((float*)(ws + WS_MA))[(size_t)(b * MH + h) * SEQ + c * CH + lane] = a;
            ((float*)(ws + WS_MB))[(size_t)(b * MH + h) * SEQ + c * CH + lane] = bs;
            LW[lane] = __expf(a - amax);
            if (lane == 63) { float* sc = (float*)(ws + WS_MSC); sc[uidx] = amax; sc[BATCH * MH * NCH + uidx] = bs; }
        } else if (wave <= 2) {
            const int fh = 2 * h + (wave - 1);
            const float lf = log_sigmoid_f(R.g0) * LOG2E;
            const float cs = wave_incl_scan_add(lf, lane);
            ((float*)(ws + WS_FCS))[(size_t)(b * FH + fh) * SEQ + c * CH + lane] = cs;
            if (lane == 63) ((float*)(ws + WS_FCT))[(b * FH + fh) * NCH + c] = cs;
        }
#pragma unroll
        for (int j = 0; j < 3; ++j) { const int d = 8 * (3 - j); const bool take = (tt & 7) >= 3 - j;
            v4u sq, sk; sq.x = __shfl_up(R.xq[3].x, d); sq.y = __shfl_up(R.xq[3].y, d); sq.z = __shfl_up(R.xq[3].z, d); sq.w = __shfl_up(R.xq[3].w, d);
            sk.x = __shfl_up(R.xk[3].x, d); sk.y = __shfl_up(R.xk[3].y, d); sk.z = __shfl_up(R.xk[3].z, d); sk.w = __shfl_up(R.xk[3].w, d);
            if (take) { R.xq[j] = sq; R.xk[j] = sk; } }
        v4u wq, wk;
        {
            float q[8], k[8];
#pragma unroll
            for (int part = 0; part < 2; ++part) {
                float accv[8];
#pragma unroll
                for (int e = 0; e < 8; ++e) accv[e] = cbv[part][e >> 2][e & 3];
#pragma unroll
                for (int j = 0; j < 4; ++j) {
                    const v4u w = part ? R.xk[j] : R.xq[j];
                    const f32x4 w0 = cwv[part][j][0], w1 = cwv[part][j][1];
                    accv[0] += w0.x * pg8::bf_lo(w.x); accv[1] += w0.y * pg8::bf_hi(w.x); accv[2] += w0.z * pg8::bf_lo(w.y); accv[3] += w0.w * pg8::bf_hi(w.y);
                    accv[4] += w1.x * pg8::bf_lo(w.z); accv[5] += w1.y * pg8::bf_hi(w.z); accv[6] += w1.z * pg8::bf_lo(w.w); accv[7] += w1.w * pg8::bf_hi(w.w);
                }
#pragma unroll
                for (int e = 0; e < 8; ++e) { const float sv = accv[e] * pg8::sigmoid_f(accv[e]); if (part == 0) q[e] = sv; else k[e] = sv * 0.125f; }
            }
            bf16* qk = (bf16*)(ws + WS_QK) + (size_t)(tok0 + tt) * 512;
            wq.x = pk2(q[0], q[1]); wq.y = pk2(q[2], q[3]); wq.z = pk2(q[4], q[5]); wq.w = pk2(q[6], q[7]);
            wk.x = pk2(k[0], k[1]); wk.y = pk2(k[2], k[3]); wk.z = pk2(k[4], k[5]); wk.w = pk2(k[6], k[7]);
            *(v4u*)(qk + 64 * h + 8 * cg) = wq; *(v4u*)(qk + 256 + 64 * h + 8 * cg) = wk;
        }
        LDS_WAIT(); __syncthreads();
        {
            const float wgt = LW[tt]; const int pos = swap23(tt);
            const unsigned kw[4] = {wk.x, wk.y, wk.z, wk.w};
#pragma unroll
            for (int e = 0; e < 8; ++e) { const float kv = (e & 1) ? pg8::bf_hi(kw[e >> 1]) : pg8::bf_lo(kw[e >> 1]); LKT[(8 * cg + e) * LP + pos] = (bf16)f2bf(kv * wgt); }
            const unsigned vw[8] = {R.v0.x, R.v0.y, R.v0.z, R.v0.w, R.v1.x, R.v1.y, R.v1.z, R.v1.w};
#pragma unroll
            for (int e = 0; e < 16; ++e) LVT[(16 * cg + e) * LP + pos] = (bf16)((e & 1) ? (vw[e >> 1] >> 16) : (vw[e >> 1] & 0xffffu));
        }
        LDS_WAIT(); __syncthreads();
        if (u + F.G < NU) m1_load(F, u + F.G, R);
        {
            const int r = lane & 31, hi = lane >> 5, dvt = wave >> 1, dkt = wave & 1;
            f32x16 acc = {};
#pragma unroll
            for (int ks = 0; ks < 4; ++ks) {
                const bf16x8 av = *(const LAS bf16x8*)(LVT + (32 * dvt + r) * LP + 16 * ks + 8 * hi);
                const bf16x8 bk = *(const LAS bf16x8*)(LKT + (32 * dkt + r) * LP + 16 * ks + 8 * hi);
                acc = MFMA32(av, bk, acc);
            }
            bf16* dst = (bf16*)(ws + WS_CST) + (size_t)uidx * (MDV * MDK) + 32 * dkt + r;
#pragma unroll
            for (int rg = 0; rg < 16; ++rg) dst[(size_t)(32 * dvt + crow16(rg, hi)) * MDK] = (bf16)f2bf(acc[rg]);
            if (wave == 0) {
                float sacc = 0.f;
#pragma unroll
                for (int j = 0; j < 8; ++j) { const v4u w = *(const LAS v4u*)(LKT + lane * LP + 8 * j);
                    sacc += (pg8::bf_lo(w.x) + pg8::bf_hi(w.x)) + (pg8::bf_lo(w.y) + pg8::bf_hi(w.y)) + (pg8::bf_lo(w.z) + pg8::bf_hi(w.z)) + (pg8::bf_lo(w.w) + pg8::bf_hi(w.w)); }
                ((float*)(ws + WS_MDN))[(size_t)uidx * 64 + lane] = sacc;
            }
        }
        LDS_WAIT();
    }
    __syncthreads();
}

__device__ __forceinline__ void m2_phase(Frame& F) {
    unsigned char* ws = F.ws; const Tc tc = get_tc(); const int tid = tc.tid;
    const float* sc = (const float*)(ws + WS_MSC); float* mstv = (float*)(ws + WS_MSC) + 2 * BATCH * MH * NCH;
    for (int job = F.vcu; job < BATCH * MH * 8; job += F.G) {
        const int bh = job >> 3, part = job & 7;
        unsigned* cst = (unsigned*)(ws + WS_CST) + (size_t)bh * NCH * (MDV * MDK / 2) + part * 512 + tid;
        float* dn = (float*)(ws + WS_MDN) + (size_t)bh * NCH * 64 + tid;
        float c0 = 0.f, c1 = 0.f, nn = 0.f, mst = 0.f;
        const bool do_n = (part == 0 && tid < 64), do_m = (part == 1 && tid == 0);
        unsigned wv[NCH]; float dv[NCH];
#pragma unroll
        for (int c = 0; c < NCH; ++c) { wv[c] = cst[(size_t)c * (MDV * MDK / 2)]; dv[c] = do_n ? dn[c * 64] : 0.f; }
#pragma unroll
        for (int c = 0; c < NCH; ++c) {
            const float amax = sc[bh * NCH + c], blast = sc[BATCH * MH * NCH + bh * NCH + c];
            const float mu = fmaxf(mst, amax), d1 = __expf(mst - mu), d2 = __expf(amax - mu);
            if (do_m) mstv[bh * NCH + c] = mst;
            const unsigned w = wv[c];
            c0 = d1 * c0 + d2 * pg8::bf_lo(w); c1 = d1 * c1 + d2 * pg8::bf_hi(w);
            cst[(size_t)c * (MDV * MDK / 2)] = pk2(c0, c1);
            if (do_n) { nn = d1 * nn + d2 * dv[c]; dn[c * 64] = nn; }
            mst = blast + mu;
        }
    }
    const int gw = F.vcu * NWAVES + tc.wave;
    if (gw < BATCH * FH) {
        const float tot = ((const float*)(ws + WS_FCT))[gw * NCH + tc.lane];
        const float incl = wave_incl_scan_add(tot, tc.lane), excl = incl - tot;
        float* cs = (float*)(ws + WS_FCS) + (size_t)gw * SEQ;
        float cv[NCH];
#pragma unroll
        for (int c = 0; c < NCH; ++c) cv[c] = cs[c * CH + tc.lane];
#pragma unroll
        for (int c = 0; c < NCH; ++c) cs[c * CH + tc.lane] = cv[c] + __shfl(excl, c);
    }
}

struct M3In { v4u q, k, v0, v1, c0, c1, o0, o1; float a, bs, mst, np; };
__device__ __forceinline__ void m3_load(Frame& F, int u, M3In& R) {
    const Tc tc = get_tc(); const int tid = tc.tid, lane = tc.lane, wave = tc.wave;
    const int h = u & 3, c = (u >> 2) & 63, b = u >> 8, tok0 = b * SEQ + c * CH, uidx = (b * MH + h) * NCH + c, tt = tid >> 3, cg = tid & 7;
    unsigned char* ws = F.ws;
    const bf16* qk = (const bf16*)(ws + WS_QK) + (size_t)(tok0 + tt) * 512;
    R.q = *(const v4u*)(qk + 64 * h + 8 * cg); R.k = *(const v4u*)(qk + 256 + 64 * h + 8 * cg);
    const bf16* mv = (const bf16*)(ws + WS_SEG0 + 32 * MiB) + (size_t)(tok0 + tt) * 512 + 128 * h + 16 * cg;
    R.v0 = *(const v4u*)mv; R.v1 = *(const v4u*)(mv + 8);
    const bf16* mo = (const bf16*)(ws + WS_SEG0 + 64 * MiB) + (size_t)(tok0 + tt) * 512 + 128 * h + 16 * cg;
    R.o0 = *(const v4u*)mo; R.o1 = *(const v4u*)(mo + 8);
    const int dv = tid >> 2, c16 = (tid & 3) * 16;
    R.c0 = (v4u){0u, 0u, 0u, 0u}; R.c1 = (v4u){0u, 0u, 0u, 0u};
    if (c > 0) { const bf16* cp = (const bf16*)(ws + WS_CST) + (size_t)(uidx - 1) * (MDV * MDK) + dv * MDK + c16; R.c0 = *(const v4u*)cp; R.c1 = *(const v4u*)(cp + 8); }
    R.a = 0.f; R.bs = 0.f; R.mst = 0.f; R.np = 0.f;
    if (wave == 0) {
        R.a = ((const float*)(ws + WS_MA))[(size_t)(b * MH + h) * SEQ + c * CH + lane];
        R.bs = ((const float*)(ws + WS_MB))[(size_t)(b * MH + h) * SEQ + c * CH + lane];
        R.mst = ((const float*)(ws + WS_MSC))[2 * BATCH * MH * NCH + uidx];
        R.np = (c > 0) ? ((const float*)(ws + WS_MDN))[(size_t)(uidx - 1) * 64 + lane] : 0.f;
    }
}
__device__ __forceinline__ void m3_phase(Frame& F, int reps) {
    constexpr int NU = BATCH * NCH * MH;
    unsigned char* ws = F.ws; LAS unsigned char* L = F.lds;
    LAS bf16* LQ = (LAS bf16*)(L);
    LAS bf16* LK = (LAS bf16*)(L + 9216);
    LAS bf16* LVT = (LAS bf16*)(L + 18432);
    LAS bf16* LCT = (LAS bf16*)(L + 36864);
    LAS float* LH = (LAS float*)(L + 55296);
    LAS float* LSC = (LAS float*)(L + 89088);
    for (int rp = 0; rp < reps; ++rp) {
    int u = F.vcu; if (u >= NU) return;
    M3In R; m3_load(F, u, R);
    f32x4 gnv[4]; int hcur = -1;
#pragma unroll 1
    for (; u < NU; u += F.G) {
        const Tc tc = get_tc(); const int tid = tc.tid, lane = tc.lane, wave = tc.wave;
        const int h = u & 3, c = (u >> 2) & 63, b = u >> 8, tok0 = b * SEQ + c * CH, tt = tid >> 3, cg = tid & 7;
        if (h != hcur) { hcur = h; const float* gp = F.A->in[13] + 128 * h + 16 * cg;
#pragma unroll
            for (int j = 0; j < 4; ++j) gnv[j] = *(const f32x4*)(gp + 4 * j); }
        LAS float* LWS = (LAS float*)(L + 89088 + 2048) + wave * 64;
        const v4u mo0 = R.o0, mo1 = R.o1;
        {
            *(LAS v4u*)(LQ + tt * LP + 8 * cg) = R.q; *(LAS v4u*)(LK + tt * LP + 8 * cg) = R.k;
            const unsigned vw[8] = {R.v0.x, R.v0.y, R.v0.z, R.v0.w, R.v1.x, R.v1.y, R.v1.z, R.v1.w}; const int pos = swap23(tt);
#pragma unroll
            for (int e = 0; e < 16; ++e) LVT[(16 * cg + e) * LP + pos] = (bf16)((e & 1) ? (vw[e >> 1] >> 16) : (vw[e >> 1] & 0xffffu));
            const int dv = tid >> 2, c16 = (tid & 3) * 16;
            *(LAS v4u*)(LCT + dv * LP + c16) = R.c0; *(LAS v4u*)(LCT + dv * LP + c16 + 8) = R.c1;
            if (wave == 0) {
                const float mu = fmaxf(R.mst, wave_incl_scan_max(R.a, lane));
                LSC[lane] = R.a; LSC[64 + lane] = mu; LSC[128 + lane] = __expf(R.mst - mu); LSC[192 + lane] = __expf(-(R.bs + mu)); LSC[256 + lane] = R.np;
            }
        }
        LDS_WAIT(); __syncthreads();
        if (u + F.G < NU) m3_load(F, u + F.G, R);
        {
            const int r = lane & 31, hi = lane >> 5, ti = wave >> 2, dvj = wave & 3;
            const int t = 32 * ti + r;
            const float mu_t = LSC[64 + t], inter_t = LSC[128 + t], emt_t = LSC[192 + t];
            float qn = 0.f;
#pragma unroll
            for (int j = 0; j < 4; ++j) { const v4u w = *(const LAS v4u*)(LQ + t * LP + 32 * hi + 8 * j); const f32x4 n0 = *(const LAS f32x4*)(LSC + 256 + 32 * hi + 8 * j), n1 = *(const LAS f32x4*)(LSC + 256 + 32 * hi + 8 * j + 4);
                qn += pg8::bf_lo(w.x) * n0.x + pg8::bf_hi(w.x) * n0.y + pg8::bf_lo(w.y) * n0.z + pg8::bf_hi(w.y) * n0.w + pg8::bf_lo(w.z) * n1.x + pg8::bf_hi(w.z) * n1.y + pg8::bf_lo(w.w) * n1.z + pg8::bf_hi(w.w) * n1.w; }
            qn += __shfl_xor(qn, 32);
            bf16x8 qf[4];
#pragma unroll
            for (int ks = 0; ks < 4; ++ks) qf[ks] = *(const LAS bf16x8*)(LQ + t * LP + 16 * ks + 8 * hi);
            f32x16 z1 = {}, z2 = {}; float den = 0.f;
#pragma unroll
            for (int si = 0; si < 2; ++si) {
                if (si <= ti) {
                    f32x16 x = {};
#pragma unroll
                    for (int ks = 0; ks < 4; ++ks) { const bf16x8 kf = *(const LAS bf16x8*)(LK + (32 * si + r) * LP + 16 * ks + 8 * hi); x = MFMA32(kf, qf[ks], x); }
#pragma unroll
                    for (int g = 0; g < 4; ++g) { const f32x4 av = *(const LAS f32x4*)(LSC + 32 * si + 8 * g + 4 * hi);
#pragma unroll
                        for (int e = 0; e < 4; ++e) { const int sidx = 32 * si + 8 * g + 4 * hi + e; const float w = (sidx <= t) ? __expf(fminf(av[e] - mu_t, 0.f)) : 0.f; const float pp = x[4 * g + e] * w; x[4 * g + e] = pp; den += pp; } }
#pragma unroll
                    for (int k2 = 0; k2 < 2; ++k2) {
                        v4u pw; pw.x = pk2(x[8 * k2 + 0], x[8 * k2 + 1]); pw.y = pk2(x[8 * k2 + 2], x[8 * k2 + 3]); pw.z = pk2(x[8 * k2 + 4], x[8 * k2 + 5]); pw.w = pk2(x[8 * k2 + 6], x[8 * k2 + 7]);
                        const bf16x8 vf = *(const LAS bf16x8*)(LVT + (32 * dvj + r) * LP + 32 * si + 16 * k2 + 8 * hi);
                        z1 = MFMA32(__builtin_bit_cast(bf16x8, pw), vf, z1);
                    }
                }
            }
#pragma unroll
            for (int ks = 0; ks < 4; ++ks) { const bf16x8 cf = *(const LAS bf16x8*)(LCT + (32 * dvj + r) * LP + 16 * ks + 8 * hi); z2 = MFMA32(qf[ks], cf, z2); }
            den += __shfl_xor(den, 32);
            den += inter_t * qn;
            const float rden = 1.0f / fmaxf(fabsf(den), emt_t);
            if (hi == 0) { LWS[r] = inter_t; LWS[32 + r] = rden; }
            LDS_WAIT();
#pragma unroll
            for (int g = 0; g < 4; ++g) { const f32x4 iv = *(const LAS f32x4*)(LWS + 8 * g + 4 * hi), rv = *(const LAS f32x4*)(LWS + 32 + 8 * g + 4 * hi);
#pragma unroll
                for (int e = 0; e < 4; ++e) LH[(32 * ti + 8 * g + 4 * hi + e) * 132 + 32 * dvj + r] = (z1[4 * g + e] + iv[e] * z2[4 * g + e]) * rv[e]; }
        }
        LDS_WAIT(); __syncthreads();
        {
            float v[16]; float sm = 0.f;
#pragma unroll
            for (int j = 0; j < 4; ++j) { const f32x4 x = *(const LAS f32x4*)(LH + tt * 132 + 16 * cg + 4 * j); v[4 * j] = x.x; v[4 * j + 1] = x.y; v[4 * j + 2] = x.z; v[4 * j + 3] = x.w; sm += (x.x + x.y) + (x.z + x.w); }
            sm += __shfl_xor(sm, 1); sm += __shfl_xor(sm, 2); sm += __shfl_xor(sm, 4);
            const float mean = sm * (1.f / MDV); float q = 0.f;
#pragma unroll
            for (int e = 0; e < 16; ++e) { v[e] -= mean; q += v[e] * v[e]; }
            q += __shfl_xor(q, 1); q += __shfl_xor(q, 2); q += __shfl_xor(q, 4);
            const float rstd = 1.0f / sqrtf(q * (1.f / MDV) + EPS);
            const float gn[16] = {gnv[0].x, gnv[0].y, gnv[0].z, gnv[0].w, gnv[1].x, gnv[1].y, gnv[1].z, gnv[1].w, gnv[2].x, gnv[2].y, gnv[2].z, gnv[2].w, gnv[3].x, gnv[3].y, gnv[3].z, gnv[3].w};
            const unsigned ow[8] = {mo0.x, mo0.y, mo0.z, mo0.w, mo1.x, mo1.y, mo1.z, mo1.w};
            unsigned res[8];
#pragma unroll
            for (int e = 0; e < 8; ++e) { const float y0 = v[2 * e] * rstd * gn[2 * e] * pg8::bf_lo(ow[e]), y1 = v[2 * e + 1] * rstd * gn[2 * e + 1] * pg8::bf_hi(ow[e]); res[e] = pk2(y0, y1); }
            bf16* ya = (bf16*)(ws + WS_XN) + (size_t)(tok0 + tt) * 1024 + 128 * h + 16 * cg;
            *(v4u*)ya = (v4u){res[0], res[1], res[2], res[3]}; *(v4u*)(ya + 8) = (v4u){res[4], res[5], res[6], res[7]};
        }
        LDS_WAIT();
    }
    __syncthreads();
    }
}
#ifndef MK_N_LAUNCHES
#define MK_N_LAUNCHES 1
#endif
constexpr int NPHASE = 16;
#ifndef FOX_MARGIN
#define FOX_MARGIN 32.0f
#endif
#ifndef ALIGN2
#define ALIGN2 true
#endif
#ifndef FOX_THR
#define FOX_THR 24
#endif
#ifndef REV2
#define REV2 0
#endif

__device__ __forceinline__ void p7_mixer(Frame& F) {
    unsigned char* ws = F.ws;
    const fox_body::bf16* FQ = (const fox_body::bf16*)(ws + WS_SEG0 + 96 * MiB);
    const fox_body::bf16* FK = (const fox_body::bf16*)(ws + WS_SEG0 + 128 * MiB);
    const fox_body::bf16* FV = (const fox_body::bf16*)(ws + WS_SEG0 + 160 * MiB);
    fox_body::bf16* YB = (fox_body::bf16*)(ws + WS_XN);
#ifndef DUP_FOX
#define DUP_FOX 0
#endif
#ifndef DUP_M3
#define DUP_M3 0
#endif
#ifndef NO_FOX
    for (int rf_ = 0; rf_ <= DUP_FOX; ++rf_)
    for (int job = F.vcu; job < BATCH * 32; job += F.G) {
        const int b = job >> 5, r = job & 31, f = r & 3, j = r >> 2;
        int t0s[4];
        { const Tc tc = get_tc();
#pragma unroll
          for (int i = 0; i < 4; ++i) { const int fh = (i & 1) ? 7 - f : f, qb = (i & 2) ? 15 - j : j; const int bh = b * FH + fh;
            const unsigned* nr = (const unsigned*)(F.ctl + CW_NRM) + bh * 4;
            const float xb = 1.02f * (sqrtf(__uint_as_float(nr[0]) * __uint_as_float(nr[2])) + sqrtf(__uint_as_float(nr[1]) * __uint_as_float(nr[3])));
            t0s[i] = fox_body::fox_t0((const float*)(ws + WS_FCS) + (size_t)bh * SEQ, qb, 2.0f * xb + FOX_MARGIN, tc.lane); } }
        const int t0a = t0s[0], t0b = t0s[1], t0c = t0s[2], t0d = t0s[3];
#pragma unroll 1
        for (int i = 0; i < 4; ++i) { const int fh = (i & 1) ? 7 - f : f, qb = (i & 2) ? 15 - j : j; const int bh = b * FH + fh;
            const float* cs = (const float*)(ws + WS_FCS) + (size_t)bh * SEQ;
            fox_body::attn_unit<FOX_THR>(b, fh, qb, FQ, FK, FV, YB, 512 + 64 * fh, cs, (i == 0) ? t0a : (i == 1) ? t0b : (i == 2) ? t0c : t0d, (char*)F.lds); }
    }
#endif
    __syncthreads();
#ifndef NO_M3
    m3_phase(F, 1 + DUP_M3);
#endif
}

__global__ void __launch_bounds__(NWAVES * 64, 2) mega_fwd(Args args) {
    extern __shared__ __attribute__((aligned(16))) unsigned char lds[];
    Frame F;
    F.lds = (LAS unsigned char*)lds;
    F.MISC = (volatile LAS unsigned*)(F.lds + MISC_OFF);
    F.G = gridDim.x; { const int bx = blockIdx.x; F.vcu = (F.G % 8 == 0) ? (bx % 8) * (F.G / 8) + bx / 8 : bx; }
    F.ws = args.ws; F.out = args.out;
    F.A = &args;
    F.ctl = (gu32*)(F.ws + WS_CTL);
    for (int u = threadIdx.x; u < (LDS_BYTES - LDSCTL_OFF) / 4; u += NWAVES * 64) ((LAS unsigned*)(F.lds + LDSCTL_OFF))[u] = 0u;
    __syncthreads();
    const int lo = args.ph_lo, hi = args.ph_hi;
    const bool use_bar = (hi - lo) > 1;
    XcdBarrier bar; bar.bar = (unsigned*)(F.ctl + CW_BAR); bar.x = 0; bar.st = nullptr;
    if (use_bar) bar = xcd_barrier_post((unsigned*)(F.ctl + CW_BAR), F.MISC + 8);
#ifndef PHMASK
#define PHMASK 0xffff
#endif
#define IN(k) (((PHMASK >> (k)) & 1) && lo <= (k) && (k) < hi)
#ifndef DUP_PHASE
#define DUP_PHASE -1
#endif
#ifndef DUP_N
#define DUP_N 1
#endif
#define REPS(k) (((k) == DUP_PHASE) ? 1 + DUP_N : 1)
#ifndef XBAR
#define XBAR 0
#endif
#define SEAM(k) do { if ((IN(k) && IN((k) + 1)) || rep_ + 1 < REPS(k)) { xcd_barrier(bar); for (int xb_ = 0; xb_ < XBAR; ++xb_) xcd_barrier(bar); } } while (0)
    unsigned char* ws = F.ws;
    bf16* XN = (bf16*)(ws + WS_XN); bf16* Y = (bf16*)(ws + WS_Y); bf16* H = (bf16*)(ws + WS_H);
    const int cid = (int)blockIdx.x;

#ifdef CLK_PHASE
    unsigned long long ck_t0 = 0, ck_r0 = 0;
#define CKB(k) do { if ((k) == CLK_PHASE && blockIdx.x == 0 && threadIdx.x == 0) { ck_t0 = __builtin_amdgcn_s_memtime(); ck_r0 = __builtin_amdgcn_s_memrealtime(); } } while (0)
#define CKE(k) do { if ((k) == CLK_PHASE && blockIdx.x == 0 && threadIdx.x == 0) { const unsigned long long t1 = __builtin_amdgcn_s_memtime(), r1 = __builtin_amdgcn_s_memrealtime(); \
        const float v = (CLK_MODE == 0) ? (float)(t1 - ck_t0) / (float)(r1 - ck_r0) : (CLK_MODE == 1) ? (float)(r1 - ck_r0) * 0.01f * CLK_SCALE : (float)CLK_SCALE; __hip_atomic_store((float*)(F.ctl + CW_DBG), CLK_Q * floorf(v / CLK_Q + 0.5f), RLX_AGENT); } } while (0)
#else
#define CKB(k) do {} while (0)
#define CKE(k) do {} while (0)
#endif
    if (IN(0)) for (int rep_ = 0; rep_ < REPS(0); ++rep_) { CKB(0); p0_prologue(F); CKE(0); SEAM(0); }
    if (IN(1)) for (int rep_ = 0; rep_ < REPS(1); ++rep_) { CKB(1);
        pg8::Gemm g{XN, (const bf16*)(ws + WS_W1GU), DM, DM, DM, 256, 256}; pg8::StaticOrder S; S.init(TOK, 2 * DFF, F.G, cid);
        pg8::EpiSwiGLU E{(const float*)(ws + WS_RMS), H};
        pg8::gemm_phase<pg8::EpiSwiGLU, pg8::StaticOrder, true>(F.lds + RING_OFF, g, S, E); CKE(1); SEAM(1); }
    if (IN(2)) for (int rep_ = 0; rep_ < REPS(2); ++rep_) { CKB(2);
        pg8::Gemm g{H, (const bf16*)(ws + WS_W1D), 128, 128, DFF, (size_t)TOK * 256, (size_t)DM * 256}; pg8::StaticOrder S; S.init(TOK, DM, F.G, cid);
        pg8::EpiBf16 E{Y, DM};
        pg8::gemm_phase<pg8::EpiBf16, pg8::StaticOrder, ALIGN2>(F.lds + RING_OFF, g, S, E); CKE(2); SEAM(2); }
    if (IN(3)) for (int rep_ = 0; rep_ < REPS(3); ++rep_) { CKB(3); ew_phase<2, true, 1, true>(F, Y, XN, F.out, 0.5f, args.in[6], nullptr, nullptr, nullptr, nullptr, (float*)(ws + WS_RMS));     CKE(3); SEAM(3); }
    if (IN(4)) for (int rep_ = 0; rep_ < REPS(4); ++rep_) { CKB(4);
        pg8::Gemm g{(const bf16*)F.out, (const bf16*)(ws + WS_WIN), DM, DM, DM, 256, 256}; pg8::StaticOrder S; S.init(TOK, NWIN, F.G, cid);
        pg8::EpiWin E{(const float*)(ws + WS_RMS), (bf16*)(ws + WS_SEG0), (bf16*)(ws + WS_GA), (bf16*)(ws + WS_GB), args.in[15], QC2, (unsigned*)(F.ctl + CW_NRM)};
        pg8::gemm_phase<pg8::EpiWin, pg8::StaticOrder, true>(F.lds + RING_OFF, g, S, E); CKE(4); SEAM(4); }
    if (IN(5)) for (int rep_ = 0; rep_ < REPS(5); ++rep_) { CKB(5); m1_phase(F); CKE(5); SEAM(5); }
    if (IN(6)) for (int rep_ = 0; rep_ < REPS(6); ++rep_) { CKB(6); m2_phase(F); CKE(6); SEAM(6); }
    if (IN(7)) for (int rep_ = 0; rep_ < REPS(7); ++rep_) { CKB(7); p7_mixer(F); CKE(7); SEAM(7); }
    if (IN(8)) for (int rep_ = 0; rep_ < REPS(8); ++rep_) { CKB(8);
        pg8::Gemm g{XN, (const bf16*)(ws + WS_WAB), DM, DM, DM, 256, 256}; pg8::StaticOrder S; S.init(TOK, DM, F.G, cid);
        pg8::EpiMerge E{Y, (const bf16*)(ws + WS_GA), (const bf16*)(ws + WS_GB)};
        pg8::gemm_phase<pg8::EpiMerge, pg8::StaticOrder, ALIGN2>(F.lds + RING_OFF, g, S, E); CKE(8); SEAM(8); }
    if (IN(9)) for (int rep_ = 0; rep_ < REPS(9); ++rep_) { CKB(9);
        pg8::Gemm g{Y, (const bf16*)(ws + WS_WOUT), DM, DM, DM, 256, 256}; pg8::StaticOrder S; S.init(TOK, DM, F.G, cid);
        pg8::EpiBf16 E{XN, DM};
        pg8::gemm_phase<pg8::EpiBf16, pg8::StaticOrder, ALIGN2>(F.lds + RING_OFF, g, S, E); CKE(9); SEAM(9); }
    if (IN(10)) for (int rep_ = 0; rep_ < REPS(10); ++rep_) { CKB(10); ew_phase<2, false, 1, true>(F, XN, F.out, F.out, 1.0f, args.in[19], nullptr, nullptr, nullptr, nullptr, (float*)(ws + WS_RMS));     CKE(10); SEAM(10); }
    if (IN(11)) for (int rep_ = 0; rep_ < REPS(11); ++rep_) { CKB(11);
        pg8::Gemm g{(const bf16*)F.out, (const bf16*)(ws + WS_W2GU), DM, DM, DM, 256, 256}; pg8::StaticOrder S; S.init(TOK, 2 * DFF, F.G, cid);
        pg8::EpiSwiGLU E{(const float*)(ws + WS_RMS), H};
        pg8::gemm_phase<pg8::EpiSwiGLU, pg8::StaticOrder, true>(F.lds + RING_OFF, g, S, E); CKE(11); SEAM(11); }
    if (IN(12)) for (int rep_ = 0; rep_ < REPS(12); ++rep_) { CKB(12);
        pg8::Gemm g{H, (const bf16*)(ws + WS_W2D), 128, 128, DFF, (size_t)TOK * 256, (size_t)DM * 256}; pg8::StaticOrder S; S.init(TOK, DM, F.G, cid);
        pg8::EpiBf16 E{XN, DM};
        pg8::gemm_phase<pg8::EpiBf16, pg8::StaticOrder, ALIGN2>(F.lds + RING_OFF, g, S, E); CKE(12); SEAM(12); }
    if (IN(13)) for (int rep_ = 0; rep_ < REPS(13); ++rep_) { CKB(13);
        ew_phase<2, false, 1, true>(F, XN, F.out, H, 0.5f, args.in[24], nullptr, nullptr, nullptr, nullptr, (float*)(ws + WS_RMS));
        const Tc tc = get_tc(); const int gw = F.vcu * NWAVES + tc.wave, NGW = F.G * NWAVES; bf16* PB = (bf16*)(ws + WS_PB);
#pragma unroll 4
        for (int m2 = 2 * gw; m2 < TOK; m2 += 2 * NGW) { const int m = m2 + (tc.lane >> 5), c8 = 8 * (tc.lane & 31);
            const float* pr = args.in[1] + (size_t)m * 256 + c8; const f32x4 a = *(const f32x4*)pr, b = *(const f32x4*)(pr + 4);
            *(v4u*)(PB + (size_t)m * 256 + c8) = f32_to_bf8(a, b); }
        CKE(13); SEAM(13); }
    if (IN(14)) for (int rep_ = 0; rep_ < REPS(14); ++rep_) { CKB(14);
        { pg8::Gemm g{(const bf16*)(ws + WS_PB), (const bf16*)(ws + WS_WPP), 256, 256, 256, 256, 256}; pg8::StaticOrder S; S.init(TOK, DM, F.G, cid);
          pg8::EpiBf16 E{(bf16*)(ws + WS_EMB), DM};
          pg8::gemm_phase<pg8::EpiBf16, pg8::StaticOrder, ALIGN2>(F.lds + RING_OFF, g, S, E); }
        VM_WAIT(); __syncthreads();
        { pg8::Gemm g{H, (const bf16*)(ws + WS_WPG), DM, DM, DM, 256, 256}; pg8::StaticOrder S; S.init(TOK, DM, F.G, cid);
          pg8::EpiPle E{(const float*)(ws + WS_RMS), XN, (const bf16*)(ws + WS_EMB), args.in[27]};
          pg8::gemm_phase<pg8::EpiPle, pg8::StaticOrder, ALIGN2>(F.lds + RING_OFF, g, S, E); }
        CKE(14); SEAM(14); }
    if (IN(15)) for (int rep_ = 0; rep_ < REPS(15); ++rep_) { ew_phase<0, false, 1, false>(F, XN, H, F.out, 1.0f, args.in[29], nullptr, nullptr);
#ifdef CLK_PHASE
        { xcd_barrier(bar); const float dv = __hip_atomic_load((float*)(F.ctl + CW_DBG), RLX_AGENT); const Tc tc = get_tc(); const int gw = F.vcu * NWAVES + tc.wave, NGW = F.G * NWAVES;
          for (int m = gw; m < TOK; m += NGW) { GAS f32x4* o = (GAS f32x4*)(F.out + (size_t)m * DM) + tc.lane;
#pragma unroll
              for (int j = 0; j < 4; ++j) { f32x4 v = o[64 * j]; v = v + dv; o[64 * j] = v; } } }
#endif
    }
#ifdef EWP_PROBE
    for (int rp = 0; rp < EWP_PROBE; ++rp) { xcd_barrier(bar);
        ew_phase<1, false, 1, true>(F, XN, H, (bf16*)(ws + WS_H + 64 * MiB), 1.0f, args.in[19], args.in[20], (bf16*)(ws + WS_H + 128 * MiB)); }
#endif
#ifdef COPY_PROBE
    for (int rp = 0; rp < COPY_PROBE; ++rp) { xcd_barrier(bar);
        const Tc tc = get_tc(); const size_t nvec = (size_t)128 * MiB / 16; const size_t gtid = (size_t)(F.vcu * NWAVES + tc.wave) * 64 + tc.lane, gsz = (size_t)F.G * NWAVES * 64;
        const v4u* src = (const v4u*)(ws + WS_H + 192 * MiB); v4u* dst = (v4u*)(ws + WS_H + 64 * MiB);
        for (size_t i = gtid; i < nvec; i += gsz * COPY_U) { v4u t[COPY_U];
#pragma unroll
            for (int j = 0; j < COPY_U; ++j) t[j] = src[i + j * gsz];
#pragma unroll
            for (int j = 0; j < COPY_U; ++j) dst[i + j * gsz] = t[j]; } }
#endif
#undef IN
#undef SEAM
}

extern "C" void kernel_launch(void* const* d_in, const int* in_sizes, int n_in, void* d_out, int out_size, void* d_ws, size_t ws_size, hipStream_t stream) {
    static int grid = 0;
    if (grid == 0) {
        if (n_in != 30 || in_sizes[0] != TOK * DM || out_size != TOK * DM || ws_size < WS_END) { fprintf(stderr, "kernel_launch: unexpected shapes (n_in %d, in0 %d, out %d, ws %zu); nothing launched\n", n_in, n_in > 0 ? in_sizes[0] : -1, out_size, ws_size); grid = -1; return; }
        int dev = 0, cus = 0, per_cu = 0;
        if (hipGetDevice(&dev) != hipSuccess || hipDeviceGetAttribute(&cus, hipDeviceAttributeMultiprocessorCount, dev) != hipSuccess) { grid = -1; return; }
        if (hipFuncSetAttribute((const void*)mega_fwd, hipFuncAttributeMaxDynamicSharedMemorySize, LDS_BYTES) != hipSuccess) { fprintf(stderr, "kernel_launch: hipFuncSetAttribute failed\n"); grid = -1; return; }
        if (hipOccupancyMaxActiveBlocksPerMultiprocessor(&per_cu, (const void*)mega_fwd, NWAVES * 64, LDS_BYTES) != hipSuccess || per_cu < 1) { fprintf(stderr, "kernel_launch: occupancy query reports %d\n", per_cu); }
        (void)hipGetLastError();
        grid = cus;
        if (grid != 256) fprintf(stderr, "kernel_launch: %d CUs (built for 256)\n", grid);
    }
    if (grid < 0) return;
    hipMemsetAsync((char*)d_ws + WS_CTL, 0, CTL_ZERO_BYTES, stream);
    Args a{};
    for (int i = 0; i < 30; ++i) a.in[i] = (const float*)d_in[i];
    a.out = (float*)d_out; a.ws = (unsigned char*)d_ws;
#if MK_N_LAUNCHES == 1
    a.ph_lo = 0; a.ph_hi = NPHASE;
    hipLaunchKernelGGL(mega_fwd, dim3(grid), dim3(NWAVES * 64), LDS_BYTES, stream, a);
#else
    for (int p = 0; p < NPHASE; ++p) { a.ph_lo = p; a.ph_hi = p + 1; hipLaunchKernelGGL(mega_fwd, dim3(grid), dim3(NWAVES * 64), LDS_BYTES, stream, a); }
#endif
}
```

```cpp
#include <hip/hip_runtime.h>
#include <hip/hip_bf16.h>
#include <cstdio>
#include <cstdint>
#include <cmath>
namespace pg8 {
#define PG8_LAS __attribute__((address_space(3)))
typedef unsigned short bf16_t;
typedef short bf16x8 __attribute__((ext_vector_type(8)));
typedef float f32x4 __attribute__((ext_vector_type(4)));
typedef unsigned u32x4 __attribute__((ext_vector_type(4)));
constexpr int BM = 256, BK = 64, HALF = 128, HTB = HALF * BK * 2  , STAGE_BYTES = 8 * HTB, NXCD = 8, WGM = 8;

__host__ __device__ __forceinline__ int lds_byte(int r, int c) { const int st = (r >> 4) * 2 + (c >> 5), rr = r & 15, cc = c & 31, ob = rr * 64 + cc * 2; return st * 1024 + (ob ^ (((ob >> 9) & 1) << 5)); }
__host__ __device__ __forceinline__ void stage_rc(int b, int& R, int& C) { const int st = b / 1024, sb = b % 1024, swz = sb ^ (((sb >> 9) & 1) << 5); R = (st >> 1) * 16 + swz / 64; C = (st & 1) * 32 + (swz % 64) / 2; }
__host__ __device__ __forceinline__ int perm32(int rho) { const int n = rho >> 4, i = rho & 15; return 8 * (i >> 2) + 4 * n + (i & 3); }

struct Unit { int pm, pn; };
struct Gemm { const bf16_t* A; const bf16_t* Bt; int lda, ldb, K; size_t bstepA, bstepB; };

struct StaticOrder {
    int nM, nN, nwg, G, c, rev;
    __host__ __device__ void init(int M, int N, int G_, int c_, int rev_ = 0) { nM = M / BM; nN = N / BM; nwg = nM * nN; G = G_; c = c_; rev = rev_; }
    __host__ __device__ bool next(int i, Unit& u) const {
        if (rev) { if (i >= rev) return false; i = rev - 1 - i; }
        const long L = (long)i * G + c; if (L >= nwg) return false;
        int wgid = (int)L; { const int q = nwg / NXCD, r = nwg % NXCD, xcd = wgid % NXCD, off = wgid / NXCD; wgid = (xcd < r ? xcd * (q + 1) : r * (q + 1) + (xcd - r) * q) + off; }
        const int nig = WGM * nN, gid = wgid / nig, fm = gid * WGM, gsz = (nM - fm) < WGM ? (nM - fm) : WGM;
        u.pm = fm + ((wgid % nig) % gsz); u.pn = (wgid % nig) / gsz; return true;
    }
};

typedef float f32x2_t __attribute__((ext_vector_type(2))); typedef __bf16 bf16x2_t __attribute__((ext_vector_type(2)));
__device__ __forceinline__ unsigned cvt_pk_bf16(float lo, float hi) { f32x2_t v = {lo, hi}; bf16x2_t b = __builtin_convertvector(v, bf16x2_t); return __builtin_bit_cast(unsigned, b); }
__device__ __forceinline__ float bf_lo(unsigned w) { return __uint_as_float(w << 16); }
__device__ __forceinline__ float bf_hi(unsigned w) { return __uint_as_float(w & 0xffff0000u); }
__device__ __forceinline__ float sigmoid_f(float x) { return __builtin_amdgcn_rcpf(1.0f + __builtin_amdgcn_exp2f(-1.4426950408889634f * x)); }

template <class Epi, class Sched, bool ALIGN_EPI = false>
__device__ __forceinline__ void gemm_phase(PG8_LAS unsigned char* lds, const Gemm g, const Sched& S, const Epi& E) {
    int tid_ = threadIdx.x; asm volatile("" : "+v"(tid_));
    const int tid = tid_, wid = __builtin_amdgcn_readfirstlane(tid >> 6), lane = tid & 63, wr = wid >> 2, wc = wid & 3, fr = lane & 15, fq = lane >> 4;
    const int K = g.K, nt = K / BK;
    unsigned voffA[2], voffB[2];
#pragma unroll
    for (int i = 0; i < 2; ++i) { int R, C; stage_rc(tid * 16 + i * 8192, R, C); const int Rb = Epi::PERM ? ((R & ~31) + perm32(R & 31)) : R;
        voffA[i] = (unsigned)(R * g.lda + C) * 2u; voffB[i] = (unsigned)(Rb * g.ldb + C) * 2u; }
    const size_t kstep = (size_t)(BK * 2);
    const size_t bstepA = g.bstepA, bstepB = g.bstepB;
    const size_t hstepA = (size_t)HALF * g.lda * 2, hstepB = (size_t)HALF * g.ldb * 2;
    const size_t tstepA = 2 * hstepA, tstepB = 2 * hstepB;
    const unsigned ldsw = (unsigned)wid * 1024u;
    const int aoff = lds_byte(wr * 64 + fr, fq * 8), boff = lds_byte(wc * 32 + fr, fq * 8);
#define PG8_SA(b, h) (((b) * 2 + (h)) * HTB)
#define PG8_SB(b, h) ((4 + (b) * 2 + (h)) * HTB)
#define PG8_STAGE(bufoff, gbase, voff) do { _Pragma("unroll") for (int _i = 0; _i < 2; ++_i) \
        __builtin_amdgcn_global_load_lds((const unsigned*)((const char*)(gbase) + (voff)[_i]), (PG8_LAS unsigned*)(lds + (bufoff) + ldsw + _i * 8192), 16, 0, 0); } while (0)
#define PG8_LDA(dst, b, h) do { _Pragma("unroll") for (int m = 0; m < 4; ++m) _Pragma("unroll") for (int k = 0; k < 2; ++k) dst[m][k] = *(const PG8_LAS bf16x8*)(lds + PG8_SA(b, h) + aoff + m * 2048 + k * 1024); } while (0)
#define PG8_LDB(dst, b, h) do { _Pragma("unroll") for (int n = 0; n < 2; ++n) _Pragma("unroll") for (int k = 0; k < 2; ++k) dst[n][k] = *(const PG8_LAS bf16x8*)(lds + PG8_SB(b, h) + boff + n * 2048 + k * 1024); } while (0)
#define PG8_MMA(ai, bj, At, Bt) do { __builtin_amdgcn_s_setprio(1); _Pragma("unroll") for (int m = 0; m < 4; ++m) _Pragma("unroll") for (int n = 0; n < 2; ++n) _Pragma("unroll") for (int k = 0; k < 2; ++k) \
        acc[ai][bj][m][n] = __builtin_amdgcn_mfma_f32_16x16x32_bf16(Bt[n][k], At[m][k], acc[ai][bj][m][n], 0, 0, 0); __builtin_amdgcn_s_setprio(0); } while (0)
#define PG8_WAIT_V(n) asm volatile("s_waitcnt vmcnt(" #n ")" ::: "memory")
#define PG8_WAIT_L(n) asm volatile("s_waitcnt lgkmcnt(" #n ")" ::: "memory")
#define PG8_BAR __builtin_amdgcn_s_barrier()
#define PG8_SCHED __builtin_amdgcn_sched_barrier(0)
    Unit cur, nxt; int ui = 0;
    if (!S.next(0, cur)) return;
    f32x4 acc[2][2][4][2];
#pragma unroll
    for (int a = 0; a < 2; ++a)
#pragma unroll
        for (int b = 0; b < 2; ++b)
#pragma unroll
            for (int m = 0; m < 4; ++m)
#pragma unroll
                for (int n = 0; n < 2; ++n) acc[a][b][m][n] = (f32x4){0.f, 0.f, 0.f, 0.f};
    bf16x8 At[4][2], B0[2][2], B1[2][2];
    PG8_LAS float* const lrs = (PG8_LAS float*)(lds + STAGE_BYTES + 1024);
    const char* cA = (const char*)g.A + (size_t)cur.pm * tstepA; const char* cB = (const char*)g.Bt + (size_t)cur.pn * tstepB;
    PG8_STAGE(PG8_SB(0, 0), cB, voffB); PG8_STAGE(PG8_SB(0, 1), cB + hstepB, voffB); PG8_STAGE(PG8_SA(0, 0), cA, voffA); PG8_STAGE(PG8_SA(0, 1), cA + hstepA, voffA);
    if (wr == 1) PG8_BAR;
    PG8_WAIT_V(2); PG8_BAR;
    PG8_STAGE(PG8_SB(1, 0), cB + kstep, voffB); PG8_STAGE(PG8_SA(1, 0), cA + kstep, voffA); PG8_STAGE(PG8_SB(1, 1), cB + hstepB + kstep, voffB);
    PG8_WAIT_V(6); PG8_BAR;
    for (;;) {
        const bool has_next = S.next(ui + 1, nxt);
        const char* nA = has_next ? (const char*)g.A + (size_t)nxt.pm * tstepA : cA; const char* nB = has_next ? (const char*)g.Bt + (size_t)nxt.pn * tstepB : cB;
        const char* pA = cA; const char* pB = cB;
        if constexpr (Epi::RS) { E.unit_dma(cur, wid, lane, lrs + 512 + (ui & 1) * 256);
            if (wid == 0)
            __builtin_amdgcn_global_load_lds((const unsigned*)(E.rs + (size_t)cur.pm * BM + lane * 4), (PG8_LAS unsigned*)(lrs + (ui & 1) * 256), 16, 0, 0); }
        for (int t = 0; t < nt; t += 2) {
            const bool last = (t == nt - 2);
            if constexpr (Epi::MID) { if (t == (nt >> 1)) E.mid(acc, cur, wr, wc, fr, fq); }
            const char* a1 = pA + kstep;
            const char* a2 = last ? nA : pA + bstepA; const char* b2 = last ? nB : pB + bstepB;
            const char* a3 = a2 + kstep; const char* b3 = b2 + kstep;
            pA = a2; pB = b2;
            PG8_LDB(B0, 0, 0); PG8_LDB(B1, 0, 1); PG8_SCHED; PG8_LDA(At, 0, 0); PG8_STAGE(PG8_SA(1, 1), a1 + hstepA, voffA);
            PG8_WAIT_V(8); PG8_WAIT_L(0); PG8_BAR; PG8_MMA(0, 0, At, B0); PG8_MMA(0, 1, At, B1); PG8_BAR; PG8_SCHED;
            PG8_LDA(At, 0, 1); PG8_STAGE(PG8_SB(0, 0), b2, voffB); PG8_STAGE(PG8_SB(0, 1), b2 + hstepB, voffB); PG8_STAGE(PG8_SA(0, 0), a2, voffA);
            PG8_WAIT_V(8); PG8_WAIT_L(0); PG8_BAR; PG8_MMA(1, 0, At, B0); PG8_MMA(1, 1, At, B1); PG8_BAR; PG8_SCHED;
            PG8_LDB(B0, 1, 0); PG8_LDB(B1, 1, 1); PG8_SCHED; PG8_LDA(At, 1, 0); PG8_STAGE(PG8_SA(0, 1), a2 + hstepA, voffA);
            PG8_WAIT_V(8); PG8_WAIT_L(0); PG8_BAR; PG8_MMA(0, 0, At, B0); PG8_MMA(0, 1, At, B1); PG8_BAR; PG8_SCHED;
            PG8_LDA(At, 1, 1); PG8_STAGE(PG8_SB(1, 0), b3, voffB); PG8_STAGE(PG8_SB(1, 1), b3 + hstepB, voffB); PG8_STAGE(PG8_SA(1, 0), a3, voffA);
            PG8_WAIT_V(8); PG8_WAIT_L(0); PG8_BAR; PG8_MMA(1, 0, At, B0); PG8_MMA(1, 1, At, B1); PG8_BAR; PG8_SCHED;
        }
        if constexpr (ALIGN_EPI) { if (wr == 0) PG8_BAR; }
        if constexpr (Epi::RS) E(acc, lrs + (ui & 1) * 256, cur, wr, wc, fr, fq); else E(acc, cur, wr, wc, fr, fq);
#ifdef DUP_EPI
        if (DUP_EPI == Epi::ID) { asm volatile("" ::: "memory"); if constexpr (Epi::RS) E(acc, lrs + (ui & 1) * 256, cur, wr, wc, fr, fq); else E(acc, cur, wr, wc, fr, fq); }
#endif
        if (!has_next) break;
#pragma unroll
        for (int a = 0; a < 2; ++a)
#pragma unroll
            for (int b = 0; b < 2; ++b)
#pragma unroll
                for (int m = 0; m < 4; ++m)
#pragma unroll
                    for (int n = 0; n < 2; ++n) acc[a][b][m][n] = (f32x4){0.f, 0.f, 0.f, 0.f};
        cur = nxt; cA = nA; cB = nB; ++ui;
        if constexpr (ALIGN_EPI) { if (wr == 1) PG8_BAR; }
    }
    PG8_WAIT_V(0);
    if constexpr (!ALIGN_EPI) { if (wr == 0) PG8_BAR; }
    PG8_BAR;
#undef PG8_SA
#undef PG8_SB
#undef PG8_STAGE
#undef PG8_LDA
#undef PG8_LDB
#undef PG8_MMA
#undef PG8_WAIT_V
#undef PG8_WAIT_L
#undef PG8_BAR
#undef PG8_SCHED
}
}
namespace pg8 {
struct EpiBf16 {
    static constexpr bool RS = false; static constexpr int ID = 0; static constexpr bool PERM = true, MID = false;
    bf16_t* O; int ldc;
    __device__ __forceinline__ void operator()(const f32x4 (&acc)[2][2][4][2], const Unit& u, int wr, int wc, int fr, int fq) const {
        const int row0 = u.pm * BM + wr * 64 + fr, col0 = u.pn * BM + wc * 32 + 8 * fq;
#pragma unroll
        for (int ai = 0; ai < 2; ++ai)
#pragma unroll
            for (int m = 0; m < 4; ++m) { bf16_t* rowp = O + (size_t)(row0 + ai * HALF + m * 16) * ldc + col0;
#pragma unroll
                for (int bj = 0; bj < 2; ++bj) { const f32x4 v0 = acc[ai][bj][m][0], v1 = acc[ai][bj][m][1];
                    u32x4 w; w.x = cvt_pk_bf16(v0[0], v0[1]); w.y = cvt_pk_bf16(v0[2], v0[3]); w.z = cvt_pk_bf16(v1[0], v1[1]); w.w = cvt_pk_bf16(v1[2], v1[3]);
                    *(u32x4*)(rowp + bj * HALF) = w; } }
    }
};
struct EpiSwiGLU {
    static constexpr bool RS = true; static constexpr int ID = 1; static constexpr bool PERM = true, MID = false;
    const float* rs;
    bf16_t* O;
    __device__ __forceinline__ void unit_dma(const Unit&, int, int, PG8_LAS float*) const {}
    __device__ __forceinline__ void operator()(const f32x4 (&acc)[2][2][4][2], const PG8_LAS float* lrs, const Unit& u, int wr, int wc, int fr, int fq) const {
        const int row0 = u.pm * BM + wr * 64 + fr, col0 = wc * 32 + 8 * fq;
        bf16_t* Ob = O + (size_t)u.pn * ((size_t)32768 * HALF);
#pragma unroll
        for (int ai = 0; ai < 2; ++ai)
#pragma unroll
            for (int m = 0; m < 4; ++m) { bf16_t* rowp = Ob + (size_t)(row0 + ai * HALF + m * 16) * HALF + col0; const float r = lrs[ai * HALF + wr * 64 + m * 16 + fr];
                typedef float f32x2 __attribute__((ext_vector_type(2)));
                f32x2 h2[4];
#pragma unroll
                for (int n = 0; n < 2; ++n)
#pragma unroll
                    for (int e2 = 0; e2 < 2; ++e2) { const f32x2 a = (f32x2){acc[ai][0][m][n][2 * e2], acc[ai][0][m][n][2 * e2 + 1]} * r, b = (f32x2){acc[ai][1][m][n][2 * e2], acc[ai][1][m][n][2 * e2 + 1]} * r;
                        f32x2 ex; ex.x = __builtin_amdgcn_exp2f(a.x); ex.y = __builtin_amdgcn_exp2f(a.y);
                        const f32x2 d = ex + 1.0f; f32x2 r; r.x = __builtin_amdgcn_rcpf(d.x); r.y = __builtin_amdgcn_rcpf(d.y);
                        h2[n * 2 + e2] = (a * b) * r; }
                u32x4 w; w.x = cvt_pk_bf16(h2[0].x, h2[0].y); w.y = cvt_pk_bf16(h2[1].x, h2[1].y); w.z = cvt_pk_bf16(h2[2].x, h2[2].y); w.w = cvt_pk_bf16(h2[3].x, h2[3].y);
                *(u32x4*)rowp = w; }
    }
};
struct EpiWin {
    static constexpr bool RS = true; static constexpr int ID = 2; static constexpr bool PERM = true, MID = false;
    const float* rs;
    bf16_t* seg0; bf16_t* rho; bf16_t* gb; const float* bgate; float qscale; unsigned* nrm;
    __device__ __forceinline__ void unit_dma(const Unit& u, int wid, int lane, PG8_LAS float* dst) const {
        if (wid == 1 && u.pn >= 12) __builtin_amdgcn_global_load_lds((const unsigned*)(bgate + ((lane >> 5) ? 1024 : 0) + (u.pn - 12) * HALF + 4 * (lane & 31)), (PG8_LAS unsigned*)dst, 16, 0, 0); }
    __device__ __forceinline__ void operator()(const f32x4 (&acc_)[2][2][4][2], const PG8_LAS float* lrs, const Unit& u, int wr, int wc, int fr, int fq) const {
        const int pn = u.pn; const int row0 = u.pm * BM + wr * 64 + fr;
        f32x4 acc[2][2][4][2];
#pragma unroll
        for (int ai = 0; ai < 2; ++ai)
#pragma unroll
            for (int m = 0; m < 4; ++m) { const float r = lrs[ai * HALF + wr * 64 + m * 16 + fr];
#pragma unroll
                for (int bj = 0; bj < 2; ++bj) { acc[ai][bj][m][0] = acc_[ai][bj][m][0] * r; acc[ai][bj][m][1] = acc_[ai][bj][m][1] * r; } }
        if (pn >= 6 && pn < 10) {
            const float sc = (pn < 8) ? qscale : 1.0f;
#pragma unroll
            for (int bj = 0; bj < 2; ++bj) { float mx = 0.f;
#pragma unroll
                for (int ai = 0; ai < 2; ++ai)
#pragma unroll
                    for (int m = 0; m < 4; ++m) { const f32x4 a = acc[ai][bj][m][0] * sc, b = acc[ai][bj][m][1] * sc;
                        float q = (a[0] * a[0] + a[1] * a[1]) + (a[2] * a[2] + a[3] * a[3]) + (b[0] * b[0] + b[1] * b[1]) + (b[2] * b[2] + b[3] * b[3]);
                        q += __shfl_xor(q, 16); q += __shfl_xor(q, 32); mx = fmaxf(mx, q); }
                mx = fmaxf(mx, __shfl_xor(mx, 1)); mx = fmaxf(mx, __shfl_xor(mx, 2)); mx = fmaxf(mx, __shfl_xor(mx, 4)); mx = fmaxf(mx, __shfl_xor(mx, 8));
                if (fr == 0 && fq == 0) { const int fh = 4 * (pn & 1) + 2 * bj + (wc >> 1), b = u.pm >> 4;
                    atomicMax(nrm + ((b * 8 + fh) * 4 + ((pn >= 8) ? 2 : 0) + (wc & 1)), __float_as_uint(mx)); } }
        }
        typedef float f32x2 __attribute__((ext_vector_type(2)));
        if (pn < 12) {
            const int sg = pn >> 1; bf16_t* dst = seg0 + (size_t)sg * (size_t)(16u << 20);
            const int col0 = (pn & 1) * 256 + wc * 32 + 8 * fq;
            if (sg == 2) {
#pragma unroll
                for (int ai = 0; ai < 2; ++ai)
#pragma unroll
                    for (int m = 0; m < 4; ++m) { bf16_t* rowp = dst + (size_t)(row0 + ai * HALF + m * 16) * 512 + col0;
#pragma unroll
                        for (int bj = 0; bj < 2; ++bj) { unsigned w[4];
#pragma unroll
                            for (int n = 0; n < 2; ++n)
#pragma unroll
                                for (int e2 = 0; e2 < 2; ++e2) { f32x2 ex; ex.x = __builtin_amdgcn_exp2f(acc[ai][bj][m][n][2 * e2]); ex.y = __builtin_amdgcn_exp2f(acc[ai][bj][m][n][2 * e2 + 1]);
                                    const f32x2 d = ex + 1.0f; w[2 * n + e2] = cvt_pk_bf16(__builtin_amdgcn_rcpf(d.x), __builtin_amdgcn_rcpf(d.y)); }
                            *(u32x4*)(rowp + bj * HALF) = (u32x4){w[0], w[1], w[2], w[3]}; } }
            } else {
                const float sc = (sg == 3) ? qscale : 1.0f;
#pragma unroll
                for (int ai = 0; ai < 2; ++ai)
#pragma unroll
                    for (int m = 0; m < 4; ++m) { bf16_t* rowp = dst + (size_t)(row0 + ai * HALF + m * 16) * 512 + col0;
#pragma unroll
                        for (int bj = 0; bj < 2; ++bj) { const f32x4 v0 = acc[ai][bj][m][0] * sc, v1 = acc[ai][bj][m][1] * sc;
                            u32x4 w; w.x = cvt_pk_bf16(v0[0], v0[1]); w.y = cvt_pk_bf16(v0[2], v0[3]); w.z = cvt_pk_bf16(v1[0], v1[1]); w.w = cvt_pk_bf16(v1[2], v1[3]);
                            *(u32x4*)(rowp + bj * HALF) = w; } }
            }
        } else {
            const int col0 = (pn - 12) * HALF + wc * 32 + 8 * fq;
            f32x2 ba[4], bb[4]; const PG8_LAS float* lb = lrs + 512 + wc * 32 + 8 * fq;
#pragma unroll
            for (int q = 0; q < 4; ++q) { const f32x2 x = *(const PG8_LAS f32x2*)(lb + 2 * q), y = *(const PG8_LAS f32x2*)(lb + 128 + 2 * q); ba[q] = x * -1.4426950408889634f; bb[q] = y * -1.4426950408889634f; }
#pragma unroll
            for (int ai = 0; ai < 2; ++ai)
#pragma unroll
                for (int m = 0; m < 4; ++m) { const size_t off = (size_t)(row0 + ai * HALF + m * 16) * 1024 + col0;
                    unsigned wr_[4], wg_[4];
#pragma unroll
                    for (int q = 0; q < 4; ++q) { const int n = q >> 1, e = 2 * (q & 1);
                        const f32x2 a = __builtin_elementwise_min((f32x2){acc[ai][0][m][n][e], acc[ai][0][m][n][e + 1]} + ba[q], (f32x2){80.f, 80.f}), b = __builtin_elementwise_min((f32x2){acc[ai][1][m][n][e], acc[ai][1][m][n][e + 1]} + bb[q], (f32x2){80.f, 80.f});
                        f32x2 ea, eb; ea.x = __builtin_amdgcn_exp2f(a.x); ea.y = __builtin_amdgcn_exp2f(a.y); eb.x = __builtin_amdgcn_exp2f(b.x); eb.y = __builtin_amdgcn_exp2f(b.y);
                        const f32x2 da = ea + 1.0f, db = eb + 1.0f; f32x2 ra, rb; ra.x = __builtin_amdgcn_rcpf(da.x); ra.y = __builtin_amdgcn_rcpf(da.y); rb.x = __builtin_amdgcn_rcpf(db.x); rb.y = __builtin_amdgcn_rcpf(db.y);
                        const f32x2 rr = db * ra; wr_[q] = cvt_pk_bf16(rr.x, rr.y); wg_[q] = cvt_pk_bf16(rb.x, rb.y); }
                    *(u32x4*)(rho + off) = (u32x4){wr_[0], wr_[1], wr_[2], wr_[3]};
                    *(u32x4*)(gb + off) = (u32x4){wg_[0], wg_[1], wg_[2], wg_[3]}; }
        }
    }
};
struct EpiMerge {
    static constexpr bool RS = false; static constexpr int ID = 3; static constexpr bool PERM = true, MID = true;
    bf16_t* O; const bf16_t* rho; const bf16_t* gb;
    __device__ __forceinline__ void mid(f32x4 (&acc)[2][2][4][2], const Unit& u, int wr, int wc, int fr, int fq) const {
        asm volatile("" : "+v"(fr), "+v"(fq));
        const unsigned base = (unsigned)((u.pm * BM + wr * 64 + fr) * 1024 + u.pn * BM + wc * 32 + 8 * fq) * 2u;
        const char* rb = (const char*)rho;
#pragma unroll
        for (int ai = 0; ai < 2; ++ai) { u32x4 a[4][2];
#pragma unroll
            for (int m = 0; m < 4; ++m)
#pragma unroll
                for (int bj = 0; bj < 2; ++bj) a[m][bj] = *(const u32x4*)(rb + base + (unsigned)((ai * HALF + m * 16) * 1024) * 2u + bj * HALF * 2);
#pragma unroll
            for (int m = 0; m < 4; ++m)
#pragma unroll
                for (int bj = 0; bj < 2; ++bj) { const u32x4 w = a[m][bj];
                    acc[ai][bj][m][0] = acc[ai][bj][m][0] * (f32x4){bf_lo(w.x), bf_hi(w.x), bf_lo(w.y), bf_hi(w.y)};
                    acc[ai][bj][m][1] = acc[ai][bj][m][1] * (f32x4){bf_lo(w.z), bf_hi(w.z), bf_lo(w.w), bf_hi(w.w)}; }
            asm volatile("" ::: "memory"); }
    }
    __device__ __forceinline__ void operator()(const f32x4 (&acc)[2][2][4][2], const Unit& u, int wr, int wc, int fr, int fq) const {
        asm volatile("" : "+v"(fr), "+v"(fq));
        const unsigned base = (unsigned)((u.pm * BM + wr * 64 + fr) * 1024 + u.pn * BM + wc * 32 + 8 * fq) * 2u;
        const char* gbb = (const char*)gb; char* Ob = (char*)O;
#pragma unroll
        for (int ai = 0; ai < 2; ++ai) { u32x4 a[4][2];
#pragma unroll
            for (int m = 0; m < 4; ++m)
#pragma unroll
                for (int bj = 0; bj < 2; ++bj) a[m][bj] = *(const u32x4*)(gbb + base + (unsigned)((ai * HALF + m * 16) * 1024) * 2u + bj * HALF * 2);
#pragma unroll
            for (int m = 0; m < 4; ++m)
#pragma unroll
                for (int bj = 0; bj < 2; ++bj) { const u32x4 b = a[m][bj]; const f32x4 v0 = acc[ai][bj][m][0], v1 = acc[ai][bj][m][1];
                    u32x4 w; w.x = cvt_pk_bf16(v0[0] * bf_lo(b.x), v0[1] * bf_hi(b.x)); w.y = cvt_pk_bf16(v0[2] * bf_lo(b.y), v0[3] * bf_hi(b.y));
                    w.z = cvt_pk_bf16(v1[0] * bf_lo(b.z), v1[1] * bf_hi(b.z)); w.w = cvt_pk_bf16(v1[2] * bf_lo(b.w), v1[3] * bf_hi(b.w));
                    *(u32x4*)(Ob + base + (unsigned)((ai * HALF + m * 16) * 1024) * 2u + bj * HALF * 2) = w; }
            asm volatile("" ::: "memory"); }
    }
};
struct EpiPle {
    static constexpr bool RS = true; static constexpr int ID = 4; static constexpr bool PERM = true, MID = false;
    const float* rs; bf16_t* O; const bf16_t* emb; const float* bias;
    __device__ __forceinline__ void unit_dma(const Unit&, int, int, PG8_LAS float*) const {}
    __device__ __forceinline__ void operator()(const f32x4 (&acc)[2][2][4][2], const PG8_LAS float* lrs, const Unit& u, int wr, int wc, int fr, int fq) const {
        float pre[8];
#pragma unroll
        for (int q = 0; q < 8; ++q) pre[q] = lrs[(q >> 2) * HALF + wr * 64 + (q & 3) * 16 + fr];
        asm volatile("" : "+v"(fr), "+v"(fq));
        const int col0 = u.pn * BM + wc * 32 + 8 * fq;
        const unsigned base = (unsigned)((u.pm * BM + wr * 64 + fr) * 1024 + col0) * 2u;
        const char* eb = (const char*)emb; char* Ob = (char*)O;
        f32x4 bv[2][2];
#pragma unroll
        for (int bj = 0; bj < 2; ++bj)
#pragma unroll
            for (int n = 0; n < 2; ++n) bv[bj][n] = *(const f32x4*)(bias + col0 + bj * HALF + 4 * n);
#pragma unroll
        for (int ai = 0; ai < 2; ++ai) { u32x4 a[4][2];
#pragma unroll
            for (int m = 0; m < 4; ++m)
#pragma unroll
                for (int bj = 0; bj < 2; ++bj) a[m][bj] = *(const u32x4*)(eb + base + (unsigned)((ai * HALF + m * 16) * 1024) * 2u + bj * HALF * 2);
#pragma unroll
            for (int m = 0; m < 4; ++m)
#pragma unroll
                for (int bj = 0; bj < 2; ++bj) { const u32x4 b = a[m][bj]; const float r = pre[ai * 4 + m];
                    const f32x4 v0 = acc[ai][bj][m][0] * r + bv[bj][0], v1 = acc[ai][bj][m][1] * r + bv[bj][1];
                    u32x4 w; w.x = cvt_pk_bf16(sigmoid_f(v0[0]) * bf_lo(b.x), sigmoid_f(v0[1]) * bf_hi(b.x)); w.y = cvt_pk_bf16(sigmoid_f(v0[2]) * bf_lo(b.y), sigmoid_f(v0[3]) * bf_hi(b.y));
                    w.z = cvt_pk_bf16(sigmoid_f(v1[0]) * bf_lo(b.z), sigmoid_f(v1[1]) * bf_hi(b.z)); w.w = cvt_pk_bf16(sigmoid_f(v1[2]) * bf_lo(b.w), sigmoid_f(v1[3]) * bf_hi(b.w));
                    *(u32x4*)(Ob + base + (unsigned)((ai * HALF + m * 16) * 1024) * 2u + bj * HALF * 2) = w; }
            asm volatile("" ::: "memory"); }
    }
};
}
namespace fox_body {
#define FLAS __attribute__((address_space(3)))
using bf16=__hip_bfloat16;
using bf16x8=__attribute__((ext_vector_type(8)))short;
using s16x4=__attribute__((ext_vector_type(4)))short;
using f32x16=__attribute__((ext_vector_type(16)))float;
using u32x4=__attribute__((ext_vector_type(4)))unsigned;
constexpr int BATCH=8,NHEAD=8,SEQ=4096,D=64,DM=512,DMO=1024;
constexpr int NW=8,QBLK=32,QB=QBLK*NW,KVBLK=64,NQB=SEQ/QB;
__device__ __forceinline__ int crow(int r,int hi){return (r&3)+8*(r>>2)+4*hi;}
#define SBAR() __builtin_amdgcn_sched_barrier(0)
__device__ __forceinline__ void cmask(f32x16&p0,f32x16&p1,int jb,int qrel,int hi){
  const float NEG=-INFINITY; int kb=64*jb+4*hi;
  #pragma unroll
  for(int r=0;r<16;++r){int kv=kb+(r&3)+8*(r>>2); if(kv>qrel)p0[r]=NEG; if(kv+32>qrel)p1[r]=NEG;}
}

constexpr int NSLOT=3, SLOTB=8192;
constexpr int LDS_K=0, LDS_V=NSLOT*SLOTB, LDS_WS=2*NSLOT*SLOTB, LDS_OST=LDS_WS+NW*64*4, LDS_CS=LDS_OST+NW*4096, LDS_BYTES=LDS_CS+SEQ*4;
constexpr float C2=0.125f*1.4426950408889634f; typedef float f32x4 __attribute__((ext_vector_type(4)));
__device__ __forceinline__ void glds16(const void*gsrc,unsigned lds_dst){unsigned keep;
  asm volatile("s_mov_b32 %0, m0\n\ts_mov_b32 m0, %2\n\ts_nop 0\n\tglobal_load_lds_dwordx4 %1, off\n\ts_mov_b32 m0, %0":"=&s"(keep):"v"(gsrc),"s"(lds_dst):"memory");}
__device__ __forceinline__ float max3f(float a,float b,float c){float r;asm("v_max3_f32 %0, %1, %2, %3":"=v"(r):"v"(a),"v"(b),"v"(c));return r;}
__device__ __forceinline__ float max2f(float a,float b){float r;asm("v_max_f32_e32 %0, %1, %2":"=v"(r):"v"(a),"v"(b));return r;}
__device__ __forceinline__ float fadd_s(float a,float b){float r;asm("v_add_f32_e32 %0, %1, %2":"=v"(r):"v"(a),"v"(b));return r;}
__device__ __forceinline__ float fsub_s(float a,float b){float r;asm("v_sub_f32_e32 %0, %1, %2":"=v"(r):"v"(a),"v"(b));return r;}
typedef float f32x2_t __attribute__((ext_vector_type(2))); typedef __bf16 bf16x2_t __attribute__((ext_vector_type(2)));
__device__ __forceinline__ unsigned cvtpk_s(float lo,float hi){f32x2_t v={lo,hi};bf16x2_t b=__builtin_convertvector(v,bf16x2_t);return __builtin_bit_cast(unsigned,b);}
#define WAIT_BAR(N) asm volatile("s_waitcnt vmcnt(" #N ") lgkmcnt(0)\n\ts_barrier":::"memory")

__device__ __forceinline__ void qkt(f32x16&p0,f32x16&p1,const char*Kslot,const bf16x8*qr,int r32,int hi){
  const char*kb=Kslot+hi*1024+r32*16;
  #pragma unroll
  for(int d0=0;d0<4;++d0){
    const bf16x8 b0=*reinterpret_cast<const bf16x8*>(kb+d0*2048);
    const bf16x8 b1=*reinterpret_cast<const bf16x8*>(kb+d0*2048+512);
    p0=__builtin_amdgcn_mfma_f32_32x32x16_bf16(b0,qr[d0],p0,0,0,0);p1=__builtin_amdgcn_mfma_f32_32x32x16_bf16(b1,qr[d0],p1,0,0,0);}
}
typedef __attribute__((address_space(3))) const char* lds_cptr;
typedef short v4i16_t __attribute__((ext_vector_type(4)));
__device__ __forceinline__ void kload8(bf16x8*kf,lds_cptr kp){
  kf[0]=*(const __attribute__((address_space(3))) bf16x8*)(kp);      kf[1]=*(const __attribute__((address_space(3))) bf16x8*)(kp+512);
  kf[2]=*(const __attribute__((address_space(3))) bf16x8*)(kp+2048); kf[3]=*(const __attribute__((address_space(3))) bf16x8*)(kp+2560);
  kf[4]=*(const __attribute__((address_space(3))) bf16x8*)(kp+4096); kf[5]=*(const __attribute__((address_space(3))) bf16x8*)(kp+4608);
  kf[6]=*(const __attribute__((address_space(3))) bf16x8*)(kp+6144); kf[7]=*(const __attribute__((address_space(3))) bf16x8*)(kp+6656);
}
__device__ __forceinline__ void kload2(bf16x8*kf,lds_cptr kp,int j){ kf[2*j]=*(const __attribute__((address_space(3))) bf16x8*)(kp+j*2048); kf[2*j+1]=*(const __attribute__((address_space(3))) bf16x8*)(kp+j*2048+512); }
__device__ __forceinline__ s16x4 vtr(lds_cptr p){ return __builtin_bit_cast(s16x4,__builtin_amdgcn_ds_read_tr16_b64_v4i16((__attribute__((address_space(3))) v4i16_t*)p)); }
__device__ __forceinline__ float rowmax(const f32x16&p0,const f32x16&p1){
  float a=max3f(p0[0],p0[1],p1[0]),b=max3f(p0[2],p0[3],p1[1]);a=max3f(a,p1[2],p1[3]);
  #pragma unroll
  for(int r=4;r<16;r+=4){a=max3f(a,p0[r],p0[r+1]);b=max3f(b,p0[r+2],p0[r+3]);a=max3f(a,p1[r],p1[r+1]);b=max3f(b,p1[r+2],p1[r+3]);}
  const float m=max2f(a,b);
  auto rr=__builtin_amdgcn_permlane32_swap(__float_as_uint(m),__float_as_uint(m),false,false);
  return max2f(__uint_as_float(rr[0]),__uint_as_float(rr[1]));
}
__device__ __forceinline__ void pv(f32x16*o,int vb,bf16x8 pa0,bf16x8 pa1,bf16x8 pa2,bf16x8 pa3){
  #pragma unroll
  for(int d0=0;d0<2;++d0){s16x4 lo[4],hi[4];
    #pragma unroll
    for(int ks=0;ks<4;++ks){
      asm volatile("ds_read_b64_tr_b16 %0,%1 offset:%c2":"=&v"(lo[ks]):"v"(vb),"i"(d0*4096+ks*1024):"memory");
      asm volatile("ds_read_b64_tr_b16 %0,%1 offset:%c2":"=&v"(hi[ks]):"v"(vb),"i"(d0*4096+ks*1024+512):"memory");}
    asm volatile("s_waitcnt lgkmcnt(0)":::"memory");SBAR();
    #define PK(k) (bf16x8){lo[k][0],lo[k][1],lo[k][2],lo[k][3],hi[k][0],hi[k][1],hi[k][2],hi[k][3]}
    o[d0]=__builtin_amdgcn_mfma_f32_32x32x16_bf16(pa0,PK(0),o[d0],0,0,0);
    o[d0]=__builtin_amdgcn_mfma_f32_32x32x16_bf16(pa1,PK(1),o[d0],0,0,0);
    o[d0]=__builtin_amdgcn_mfma_f32_32x32x16_bf16(pa2,PK(2),o[d0],0,0,0);
    o[d0]=__builtin_amdgcn_mfma_f32_32x32x16_bf16(pa3,PK(3),o[d0],0,0,0);
    #undef PK
  }
}

__device__ __forceinline__ int fox_t0(const float*cs,int qb,float thr,int lane){ const int q0=qb*QB, nt_=(q0+QB)/KVBLK; const float c0_=cs[q0]; const float cv_=cs[(lane<nt_?lane:nt_-1)*KVBLK+KVBLK-1];
  const unsigned long long bm_=__ballot(lane<nt_ && (cv_-c0_)<=thr); int f_=bm_? (int)__builtin_ctzll(bm_):0; f_&=~1; return __builtin_amdgcn_readfirstlane(f_<nt_-4?f_:nt_-4); }
#ifndef ATTN_STORE16
#define ATTN_STORE16(p,v) (*(u32x4*)(p)=(v))
#endif
template<int THRL> __device__ __forceinline__ void attn_unit(int b,int h,int qb,const bf16*Q,const bf16*__restrict__ K,const bf16*__restrict__ V,bf16*O,int ocol,const float*cs,int t0,char*shm){
  int tid_=threadIdx.x; asm volatile("":"+v"(tid_));
  const int tid=tid_,lane=tid&63,r32=lane&31,hi=lane>>5; const int wid=__builtin_amdgcn_readfirstlane(tid>>6);
  const long rowbase=(long)b*SEQ; const int q0=qb*QB;
  const bf16*Qw=Q+(rowbase+q0+wid*QBLK)*DM+h*D;
  const bf16*Kh=K+(rowbase+(long)t0*KVBLK)*DM+h*D,*Vh=V+(rowbase+(long)t0*KVBLK)*DM+h*D;
  const unsigned lds0=(unsigned)(uintptr_t)shm;
  float*wsf=(float*)(shm+LDS_WS)+wid*64;
  const bf16*ksrc=Kh+(long)lane*DM+wid*8;
  const bf16*vsrc=Vh+(long)(16*(wid&3)+(lane>>2))*DM+(wid>>2)*32+(lane&3)*8;
  const unsigned kdst=lds0+LDS_K+wid*1024, vdst=lds0+LDS_V+wid*1024;
  #define DMA_K(t,slot) glds16(ksrc+(long)(t)*KVBLK*DM,(unsigned)__builtin_amdgcn_readfirstlane(kdst+(slot)))
  #define DMA_V(t,slot) glds16(vsrc+(long)(t)*KVBLK*DM,(unsigned)__builtin_amdgcn_readfirstlane(vdst+(slot)))
  const int vb0=(int)(lds0+LDS_V)+((lane>>4)&1)*32+(lane&3)*8+(4*hi+((lane&15)>>2))*64;
  const char*Kbase=shm+LDS_K; bf16x8 kf[8];
  const lds_cptr shm3=(lds_cptr)shm; const lds_cptr kp0=shm3+LDS_K+hi*1024+r32*16; const lds_cptr vp0=shm3+LDS_V+((lane>>4)&1)*32+(lane&3)*8+(4*hi+((lane&15)>>2))*64;
  const int NT=(q0+QB)/KVBLK-t0;
  DMA_K(0,0);DMA_V(0,0);DMA_K(1,SLOTB);
  bf16x8 qr[4];
  #pragma unroll
  for(int d0=0;d0<4;++d0)qr[d0]=*reinterpret_cast<const bf16x8*>(&Qw[(long)r32*DM+d0*16+hi*8]);
  { FLAS float*csw=(FLAS float*)((FLAS char*)shm+LDS_CS); for(int i=tid*4;i<q0+QB-t0*KVBLK;i+=NW*64*4){ const f32x4 v=*(const f32x4*)(cs+t0*KVBLK+i); *(FLAS f32x4*)(csw+i)=v; } }
  const FLAS float*csl=(const FLAS float*)((FLAS char*)shm+LDS_CS)+4*hi;
  float mhat=0.f,l_reg=0.f,nmh=0.f;f32x16 o[2];o[0]=f32x16{};o[1]=f32x16{};
  const int qrel=wid*QBLK+r32;
  #define CMASK(P0,P1,t) do{int jb_=(t)-(NT-4); if(jb_>=0)cmask(P0,P1,jb_,qrel,hi);}while(0)
  #define CINIT(P0,P1,t) do{ const FLAS float*cb_=csl+(t)*64; _Pragma("unroll") for(int g_=0;g_<4;++g_){ const f32x4 b0_=*(const FLAS f32x4*)(cb_+8*g_), b1_=*(const FLAS f32x4*)(cb_+32+8*g_); \
      { typedef float f2_ __attribute__((ext_vector_type(2))); const f2_ n2_={nmh,nmh}; const f2_ a0_=n2_-(f2_){b0_[0],b0_[1]}, a1_=n2_-(f2_){b0_[2],b0_[3]}, c0_=n2_-(f2_){b1_[0],b1_[1]}, c1_=n2_-(f2_){b1_[2],b1_[3]}; \
        P0[4*g_]=a0_.x; P0[4*g_+1]=a0_.y; P0[4*g_+2]=a1_.x; P0[4*g_+3]=a1_.y; P1[4*g_]=c0_.x; P1[4*g_+1]=c0_.y; P1[4*g_+2]=c1_.x; P1[4*g_+3]=c1_.y; } } }while(0)
  bool resc=false;
  #define START(P0,P1) do{ const float rm=rowmax(P0,P1); resc=false; \
    { const float dl=rm; mhat=fadd_s(mhat,dl); \
      _Pragma("unroll") for(int r=0;r<16;++r){P0[r]=fsub_s(P0[r],dl);P1[r]=fsub_s(P1[r],dl);} \
      nmh=-mhat; } \
    _Pragma("unroll") for(int r=0;r<16;++r)P0[r]=__builtin_amdgcn_exp2f(P0[r]); }while(0)
  #define RESC() do{ if(resc){ asm volatile("s_waitcnt lgkmcnt(0)":::"memory"); \
      _Pragma("unroll") for(int d_=0;d_<2;++d_) _Pragma("unroll") for(int r=0;r<16;++r)o[d_][r]*=wsf[crow(r,hi)]; } }while(0)
  f32x16 pA0,pA1,pB0,pB1;
  int sl_prev=0,sl_cur=0,sl_next=SLOTB;
  #define ROT() do{sl_prev=sl_cur;sl_cur=sl_next;sl_next=(sl_next==(NSLOT-1)*SLOTB)?0:sl_next+SLOTB;}while(0)
  DMA_K(2,2*SLOTB);
  WAIT_BAR(3);
  CINIT(pA0,pA1,0); qkt(pA0,pA1,Kbase,qr,r32,hi);asm volatile("s_nop 15\n\ts_nop 7":"+v"(pA0),"+v"(pA1));CMASK(pA0,pA1,0);
  START(pA0,pA1);
  _Pragma("unroll") for(int r=0;r<16;++r)pA1[r]=__builtin_amdgcn_exp2f(pA1[r]);
  WAIT_BAR(0);
  DMA_K(3,0);DMA_V(1,SLOTB);
  ROT();
  kload8(kf,kp0+sl_cur);
  WAIT_BAR(2);
  s16x4 vlo[8],vhi[8]; u32x4 pw0,pw1,pw2,pw3;
  #define PKW(P,B) cvtpk_s(P[B],P[B+1])
  #define PAF(k) __builtin_bit_cast(bf16x8,pw##k)
  #define VFR(i) (bf16x8){vlo[i][0],vlo[i][1],vlo[i][2],vlo[i][3],vhi[i][0],vhi[i][1],vhi[i][2],vhi[i][3]}
  #define PIN(x) asm volatile("":"+v"(x))
  #define MX3(a,b,c) __builtin_fmaxf(__builtin_fmaxf((a),(b)),(c))
  #define GAPA(MF,A0,A1,A2,A3,W0,W1,PW) do{ MF; sacc+=A0; sacc+=A1; sacc+=A2; sacc+=A3; PIN(sacc); W0; W1; PIN(PW); SBAR(); }while(0)
  #define EX(v) __builtin_amdgcn_exp2f(v)
  #define GAPB(MF,X,B) do{ MF; X[B]=EX(X[B]); X[B+1]=EX(X[B+1]); X[B+2]=EX(X[B+2]); X[B+3]=EX(X[B+3]); PIN(X); SBAR(); }while(0)
  #define VRD(i) do{ vlo[i]=vtr(vp_+(((i)>>2)*4096+((i)&3)*1024)); vhi[i]=vtr(vp_+(((i)>>2)*4096+((i)&3)*1024+512)); }while(0)
  #define KRD(G,j) do{ if(G){ kload2(kf,kp0+sl_next,j); SBAR(); } }while(0)
  #define STEP(C0,C1,P0,P1,t,GK,GV,GL) do{ SBAR(); CINIT(C0,C1,t); SBAR(); \
    const lds_cptr vp_=vp0+sl_prev; \
    VRD(0); SBAR(); float sacc=(P0[0]+P0[1]); \
    GAPA(C0=__builtin_amdgcn_mfma_f32_32x32x16_bf16(kf[0],qr[0],C0,0,0,0), P0[2],P0[3],P0[4],P0[5],     pw0[0]=PKW(P0,0), pw0[1]=PKW(P0,2), pw0); \
    VRD(4); SBAR(); GAPA(C1=__builtin_amdgcn_mfma_f32_32x32x16_bf16(kf[1],qr[0],C1,0,0,0), P0[6],P0[7],P0[8],P0[9],     pw0[2]=PKW(P0,4), pw0[3]=PKW(P0,6), pw0); \
    VRD(1); SBAR(); GAPA(C0=__builtin_amdgcn_mfma_f32_32x32x16_bf16(kf[2],qr[1],C0,0,0,0),   P0[10],P0[11],P0[12],P0[13], pw1[0]=PKW(P0,8), pw1[1]=PKW(P0,10), pw1); \
    VRD(5); SBAR(); GAPA(C1=__builtin_amdgcn_mfma_f32_32x32x16_bf16(kf[3],qr[1],C1,0,0,0),   P0[14],P0[15],P1[0],P1[1],   pw1[2]=PKW(P0,12),pw1[3]=PKW(P0,14), pw1); \
    VRD(2); SBAR(); GAPA(C0=__builtin_amdgcn_mfma_f32_32x32x16_bf16(kf[4],qr[2],C0,0,0,0),   P1[2],P1[3],P1[4],P1[5],     pw2[0]=PKW(P1,0), pw2[1]=PKW(P1,2), pw2); \
    VRD(6); SBAR(); GAPA(C1=__builtin_amdgcn_mfma_f32_32x32x16_bf16(kf[5],qr[2],C1,0,0,0),   P1[6],P1[7],P1[8],P1[9],     pw2[2]=PKW(P1,4), pw2[3]=PKW(P1,6), pw2); \
    VRD(3); SBAR(); GAPA(C0=__builtin_amdgcn_mfma_f32_32x32x16_bf16(kf[6],qr[3],C0,0,0,0),   P1[10],P1[11],P1[12],P1[13], pw3[0]=PKW(P1,8), pw3[1]=PKW(P1,10), pw3); \
    VRD(7); SBAR(); GAPA(C1=__builtin_amdgcn_mfma_f32_32x32x16_bf16(kf[7],qr[3],C1,0,0,0),   P1[14],P1[15],0.f,0.f,       pw3[2]=PKW(P1,12),pw3[3]=PKW(P1,14), pw3); \
    l_reg+=sacc; \
    if(GK){DMA_K((t)+3,sl_cur);} if(GV){DMA_V((t)+1,sl_next);} \
    CMASK(C0,C1,t); \
    { float a=MX3(C0[0],C0[1],C1[0]),b=MX3(C0[2],C0[3],C1[1]); a=MX3(a,C1[2],C1[3]); \
      _Pragma("unroll") for(int r=4;r<16;r+=4){a=MX3(a,C0[r],C0[r+1]);b=MX3(b,C0[r+2],C0[r+3]);a=MX3(a,C1[r],C1[r+1]);b=MX3(b,C1[r+2],C1[r+3]);} \
      float rm=__builtin_fmaxf(a,b); { auto rr=__builtin_amdgcn_permlane32_swap(__float_as_uint(rm),__float_as_uint(rm),false,false); rm=__builtin_fmaxf(__uint_as_float(rr[0]),__uint_as_float(rr[1])); } \
      resc=false; \
      if(__builtin_expect(__any(rm>(float)THRL),0)){ const float dl=__builtin_fmaxf(rm,0.f); mhat+=dl; \
        _Pragma("unroll") for(int r=0;r<16;++r){C0[r]-=dl;C1[r]-=dl;} \
        nmh=-mhat; \
        const float f=__builtin_amdgcn_exp2f(-dl); l_reg*=f; if(hi==0)wsf[r32]=f; resc=true; } } \
    SBAR(); \
    GAPB(o[0]=__builtin_amdgcn_mfma_f32_32x32x16_bf16(PAF(0),VFR(0),o[0],0,0,0), C0,0); \
    GAPB(o[1]=__builtin_amdgcn_mfma_f32_32x32x16_bf16(PAF(0),VFR(4),o[1],0,0,0), C0,4); \
    KRD(GL,0); GAPB(o[0]=__builtin_amdgcn_mfma_f32_32x32x16_bf16(PAF(1),VFR(1),o[0],0,0,0), C0,8); \
    KRD(GL,1); GAPB(o[1]=__builtin_amdgcn_mfma_f32_32x32x16_bf16(PAF(1),VFR(5),o[1],0,0,0), C0,12); \
    KRD(GL,2); GAPB(o[0]=__builtin_amdgcn_mfma_f32_32x32x16_bf16(PAF(2),VFR(2),o[0],0,0,0), C1,0); \
    KRD(GL,3); GAPB(o[1]=__builtin_amdgcn_mfma_f32_32x32x16_bf16(PAF(2),VFR(6),o[1],0,0,0), C1,4); \
    GAPB(o[0]=__builtin_amdgcn_mfma_f32_32x32x16_bf16(PAF(3),VFR(3),o[0],0,0,0), C1,8); \
    GAPB(o[1]=__builtin_amdgcn_mfma_f32_32x32x16_bf16(PAF(3),VFR(7),o[1],0,0,0), C1,12); \
    }while(0)
  int t=1;
  #undef CMASK
  #define CMASK(P0,P1,t) do{}while(0)
  for(;t+5<NT;t+=2){
    STEP(pB0,pB1,pA0,pA1,t,true,true,true);     WAIT_BAR(2); RESC(); ROT();
    STEP(pA0,pA1,pB0,pB1,t+1,true,true,true);   WAIT_BAR(2); RESC(); ROT();
  }
  #undef CMASK
  #define CMASK(P0,P1,t) do{int jb_=(t)-(NT-4); if(jb_>=0)cmask(P0,P1,jb_,qrel,hi);}while(0)
  #define ENDW(tt) do{ if((tt)+3<NT){WAIT_BAR(2);} else if((tt)+2<NT){WAIT_BAR(1);} else {WAIT_BAR(0);} }while(0)
  for(;t+1<NT;t+=2){
    STEP(pB0,pB1,pA0,pA1,t,(t+3<NT),(t+1<NT),(t+1<NT));       ENDW(t);   RESC(); ROT();
    STEP(pA0,pA1,pB0,pB1,t+1,(t+4<NT),(t+2<NT),(t+2<NT));     ENDW(t+1); RESC(); ROT();
  }
  STEP(pB0,pB1,pA0,pA1,NT-1,false,false,false); RESC();
  { float sacc=pB0[0]+pB0[1]; _Pragma("unroll") for(int r=2;r<16;++r)sacc+=pB0[r]; _Pragma("unroll") for(int r=0;r<16;++r)sacc+=pB1[r]; l_reg+=sacc;
    pw0=(u32x4){PKW(pB0,0),PKW(pB0,2),PKW(pB0,4),PKW(pB0,6)};pw1=(u32x4){PKW(pB0,8),PKW(pB0,10),PKW(pB0,12),PKW(pB0,14)};pw2=(u32x4){PKW(pB1,0),PKW(pB1,2),PKW(pB1,4),PKW(pB1,6)};pw3=(u32x4){PKW(pB1,8),PKW(pB1,10),PKW(pB1,12),PKW(pB1,14)};
    SBAR(); pv(o,vb0+sl_cur,PAF(0),PAF(1),PAF(2),PAF(3)); }
  #undef PKW
  #undef PAF
  #undef VFR
  #undef PIN
  #undef MX3
  #undef GAPA
  #undef GAPB
  #undef EX
  #undef VRD
  #undef KRD
  #undef STEP
  #undef ENDW
  {auto rr=__builtin_amdgcn_permlane32_swap(__float_as_uint(l_reg),__float_as_uint(l_reg),false,false);l_reg=__uint_as_float(rr[0])+__uint_as_float(rr[1]);}
  if(hi==0)wsf[32+r32]=l_reg;asm volatile("s_waitcnt lgkmcnt(0)":::"memory");
  float rli[16];
  #pragma unroll
  for(int r=0;r<16;++r)rli[r]=__builtin_amdgcn_rcpf(wsf[32+crow(r,hi)]);
  bf16*Ow=O+(rowbase+q0+wid*QBLK)*DMO+ocol;
  { bf16*stg=(bf16*)(shm+LDS_OST)+wid*2048;
    #pragma unroll
    for(int r=0;r<16;++r){const int orow=crow(r,hi);
      #pragma unroll
      for(int d0=0;d0<2;++d0)stg[orow*64+d0*32+r32]=__float2bfloat16(o[d0][r]*rli[r]);}
    asm volatile("s_waitcnt lgkmcnt(0)":::"memory");
    #pragma unroll
    for(int i=0;i<4;++i){const int row=i*8+(lane>>3),ch=lane&7; const u32x4 v=*(const u32x4*)(stg+row*64+ch*8); ATTN_STORE16(Ow+(long)row*DMO+ch*8,v);} }
  asm volatile("s_waitcnt lgkmcnt(0)\n\ts_barrier":::"memory");
  #undef DMA_K
  #undef DMA_V
  #undef CMASK
  #undef CINIT
  #undef START
  #undef RESC
  #undef ROT
}
constexpr int ATTN_LDS_BYTES=LDS_BYTES;
#undef SBAR
#undef WAIT_BAR
#undef FLAS
}
constexpr int NWAVES = 8;
constexpr int BATCH = 8, SEQ = 4096, DM = 1024, DFF = 2816, TOK = BATCH * SEQ;
constexpr int NWIN = 5120;
constexpr int MH = 4, MDK = 64, MDV = 128, FH = 8, FD = 64, CH = 64, NCH = SEQ / CH;
constexpr float EPS = 1e-6f;
constexpr float LOG2E = 1.4426950408889634f;
constexpr float QC2 = 0.125f * LOG2E;

constexpr size_t MiB = 1u << 20;
constexpr size_t WS_CTL = 0, CTL_ZERO_BYTES = 32768;
constexpr size_t WS_W1GU = 2 * MiB;
constexpr size_t WS_W1D = 13 * MiB;
constexpr size_t WS_W2GU = 19 * MiB;
constexpr size_t WS_W2D = 30 * MiB;
constexpr size_t WS_WIN = 36 * MiB;
constexpr size_t WS_WAB = 47 * MiB;
constexpr size_t WS_WOUT = 49 * MiB;
constexpr size_t WS_WPG = 51 * MiB;
constexpr size_t WS_WPP = 53 * MiB;
constexpr size_t WS_GATES = 54 * MiB;
constexpr size_t WS_MA = 56 * MiB;
constexpr size_t WS_MB = 56 * MiB + 512 * 1024;
constexpr size_t WS_MSC = 57 * MiB;
constexpr size_t WS_MDN = 57 * MiB + 256 * 1024;
constexpr size_t WS_FCS = 58 * MiB;
constexpr size_t WS_FCT = 59 * MiB;
constexpr size_t WS_RMS = 60 * MiB;
constexpr size_t WS_XN = 64 * MiB;
constexpr size_t WS_Y = 128 * MiB;
constexpr size_t WS_R = 192 * MiB;
constexpr size_t WS_H = WS_R;
constexpr size_t WS_PB = WS_R + 176 * MiB;
constexpr size_t WS_EMB = WS_R + 192 * MiB;
constexpr size_t WS_SEG0 = WS_R;
constexpr size_t WS_GA = WS_R + 192 * MiB, WS_GB = WS_R + 256 * MiB;
constexpr size_t WS_QK = WS_Y;
constexpr size_t WS_CST = WS_Y + 32 * MiB;
constexpr size_t WS_END = 512 * MiB;
constexpr int CW_TMO = 0, CW_CODE = 1, CW_DBG = 64, CW_M3Q = 128, CW_NRM = 256, CW_BAR = 4096;
static_assert((CW_BAR + 3456) * 4 <= (int)CTL_ZERO_BYTES && (CW_NRM + 256) <= CW_BAR, "control words inside the per-call memset");

constexpr int RING_OFF = 0, RING_BYTES = 131072;
constexpr int LDSCTL_OFF = RING_BYTES, MISC_OFF = LDSCTL_OFF + 320;
constexpr int LDS_BYTES = 147456;

#define GAS __attribute__((address_space(1)))
#define LAS __attribute__((address_space(3)))
typedef unsigned short bf16;
typedef unsigned v4u __attribute__((ext_vector_type(4)));
typedef unsigned v2u __attribute__((ext_vector_type(2)));
typedef float f32x4 __attribute__((ext_vector_type(4)));
typedef short bf16x8 __attribute__((ext_vector_type(8)));
typedef GAS unsigned gu32;
#define RLX_AGENT __ATOMIC_RELAXED, __HIP_MEMORY_SCOPE_AGENT
#define LDS_WAIT() asm volatile("s_waitcnt lgkmcnt(0)" ::: "memory")
#define VM_WAIT() asm volatile("s_waitcnt vmcnt(0)" ::: "memory")
__device__ __forceinline__ unsigned f2bf(float f) { unsigned u = __builtin_bit_cast(unsigned, f); return (u + 0x7fffu + ((u >> 16) & 1u)) >> 16; }
__device__ __forceinline__ unsigned pk2(float lo, float hi) { return f2bf(lo) | (f2bf(hi) << 16); }
__device__ __forceinline__ float bf2f(unsigned short h) { return __uint_as_float(((unsigned)h) << 16); }

#define XB_TMO      128
#define XB_XCNT(j)  (256  + 64 * (j))
#define XB_XSUB(j)  (1280 + 64 * (j))
#define XB_XGEN(j)  (2304 + 64 * (j))
#define XB_TOP      3328
#define XB_TOPGEN   3392
#define XCD_BAR_WORDS 3456
#define XB_SPIN_CAP (1u << 20)
__device__ __forceinline__ unsigned xb_ld(unsigned* p)              { return __hip_atomic_load(p, __ATOMIC_RELAXED, __HIP_MEMORY_SCOPE_AGENT); }
__device__ __forceinline__ unsigned xb_add(unsigned* p, unsigned v) { return __hip_atomic_fetch_add(p, v, __ATOMIC_RELAXED, __HIP_MEMORY_SCOPE_AGENT); }
__device__ __forceinline__ unsigned xb_xcc_id() { return (unsigned)__builtin_amdgcn_s_getreg((3 << 11) | 20) & 0xFu; }
#define XB_SPIN(cond, bar) do { unsigned _sp = 0; while (cond) { __builtin_amdgcn_s_sleep(1); \
    if ((++_sp & 255u) == 0u) { if (xb_ld(&(bar)[XB_TMO])) break; if (_sp > XB_SPIN_CAP) { atomicAdd(&(bar)[XB_TMO], 1u); break; } } } } while (0)
struct XcdBarrier { unsigned* bar; unsigned x; volatile LAS unsigned* st; };
__device__ __forceinline__ XcdBarrier xcd_barrier_post(unsigned* bar, volatile LAS unsigned* st) {
    XcdBarrier b; b.bar = bar; b.x = xb_xcc_id(); b.st = st;
    if (threadIdx.x == 0) (void)xb_add(&bar[XB_XCNT(b.x)], 1u);
    return b;
}
__device__ __forceinline__ void xcd_barrier_complete(unsigned* bar, unsigned x, unsigned& nloc, unsigned& nx) {
    const unsigned G = gridDim.x * gridDim.y * gridDim.z;
    unsigned sum, cnt, mine, sp = 0u;
    for (;;) {
        sum = 0u; cnt = 0u; mine = 0u;
#pragma unroll
        for (unsigned j = 0; j < 16; ++j) { const unsigned c = xb_ld(&bar[XB_XCNT(j)]); sum += c; cnt += (c > 0u) ? 1u : 0u; mine = (j == x) ? c : mine; }
        if (sum == G) break;
        __builtin_amdgcn_s_sleep(1);
        if ((++sp & 255u) == 0u) { if (xb_ld(&bar[XB_TMO])) break; if (sp > XB_SPIN_CAP) { atomicAdd(&bar[XB_TMO], 1u); break; } }
    }
    nloc = mine > 0u ? mine : 1u; nx = cnt > 0u ? cnt : 1u;
}
__device__ __forceinline__ void xcd_barrier(const XcdBarrier& b) {
    asm volatile("s_waitcnt vmcnt(0)" ::: "memory");
    __syncthreads();
    if (threadIdx.x == 0) {
        unsigned* bar = b.bar;
        __builtin_amdgcn_s_waitcnt(0);
        unsigned nloc = b.st[0], nx = b.st[1];
        if (nloc == 0u) { xcd_barrier_complete(bar, b.x, nloc, nx); b.st[0] = nloc; b.st[1] = nx; }
        const unsigned old = xb_add(&bar[XB_XSUB(b.x)], 1u);
        const unsigned gen = old / nloc;
        if (old + 1u == (gen + 1u) * nloc) {
            __builtin_amdgcn_fence(__ATOMIC_RELEASE, "agent");
            asm volatile("s_waitcnt vmcnt(0)" ::: "memory");
            const unsigned og = xb_add(&bar[XB_TOP], 1u);
            const unsigned tg = og / nx;
            if (og + 1u == (tg + 1u) * nx) xb_add(&bar[XB_TOPGEN], 1u);
            else XB_SPIN(xb_ld(&bar[XB_TOPGEN]) == tg, bar);
            __builtin_amdgcn_fence(__ATOMIC_ACQUIRE, "agent");
            xb_add(&bar[XB_XGEN(b.x)], 1u);
            asm volatile("s_waitcnt vmcnt(0)" ::: "memory");
        } else {
            XB_SPIN(xb_ld(&bar[XB_XGEN(b.x)]) == gen, bar);
            __builtin_amdgcn_fence(__ATOMIC_ACQUIRE, "agent");
            asm volatile("s_waitcnt vmcnt(0)" ::: "memory");
        }
    }
    __syncthreads();
}

struct Args { const float* in[30]; float* out; unsigned char* ws; int ph_lo, ph_hi; };
static_assert(sizeof(Args) == 32 * 8 + 8, "Args has no padding");
struct Frame {
    LAS unsigned char* lds;
    volatile LAS unsigned* MISC;
    gu32* ctl;
    int vcu, G;
    unsigned char* ws;
    const Args* A;
    float* out;
};
struct Tc { int tid, lane, wave; };
__device__ __forceinline__ Tc get_tc() { int t = threadIdx.x; asm volatile("" : "+v"(t)); Tc c; c.tid = t; c.lane = t & 63; c.wave = __builtin_amdgcn_readfirstlane(t >> 6); return c; }
__device__ __forceinline__ float wave_sum(float v) {
#pragma unroll
    for (int o = 1; o < 64; o <<= 1) v += __shfl_xor(v, o);
    return v;
}
__device__ __forceinline__ float wave_max(float v) {
#pragma unroll
    for (int o = 1; o < 64; o <<= 1) v = fmaxf(v, __shfl_xor(v, o));
    return v;
}

constexpr int ER = 4;
__device__ __forceinline__ void bf8_to_f32(const v4u w, f32x4& a, f32x4& b) {
    a.x = __uint_as_float(w.x << 16); a.y = __uint_as_float(w.x & 0xffff0000u); a.z = __uint_as_float(w.y << 16); a.w = __uint_as_float(w.y & 0xffff0000u);
    b.x = __uint_as_float(w.z << 16); b.y = __uint_as_float(w.z & 0xffff0000u); b.z = __uint_as_float(w.w << 16); b.w = __uint_as_float(w.w & 0xffff0000u); }
__device__ __forceinline__ v4u f32_to_bf8(const f32x4 a, const f32x4 b) { v4u w; w.x = pk2(a.x, a.y); w.y = pk2(a.z, a.w); w.z = pk2(b.x, b.y); w.w = pk2(b.z, b.w); return w; }
__device__ __forceinline__ float sumsq8(const f32x4 a, const f32x4 b) { return ((a.x * a.x + a.y * a.y) + (a.z * a.z + a.w * a.w)) + ((b.x * b.x + b.y * b.y) + (b.z * b.z + b.w * b.w)); }
__device__ __forceinline__ void xpose_item(const float* W, const float* gk, float wsc, int Nsrc, int k0, int srccol, int srcvec, bf16* WT, int ldd, int drow0, int dcol0, LAS float* scr, int lane) {
    if (srcvec >= 0) {
        f32x4 t[8];
#pragma unroll
        for (int i = 0; i < 8; ++i) t[i] = *(const f32x4*)(W + (size_t)(k0 + 8 * i + (lane >> 3)) * Nsrc + srcvec + 4 * (lane & 7));
#pragma unroll
        for (int i = 0; i < 8; ++i) { LAS float* d = scr + (8 * i + (lane >> 3)) * 33 + 4 * (lane & 7); const float wv = gk ? wsc * gk[k0 + 8 * i + (lane >> 3)] : wsc; d[0] = t[i].x * wv; d[1] = t[i].y * wv; d[2] = t[i].z * wv; d[3] = t[i].w * wv; }
    } else {
#pragma unroll 8
        for (int i = 0; i < 32; ++i) { const int kk = 2 * i + (lane >> 5); const float wv = gk ? wsc * gk[k0 + kk] : wsc; scr[kk * 33 + (lane & 31)] = (srccol >= 0) ? W[(size_t)(k0 + kk) * Nsrc + srccol] * wv : 0.f; }
    }
    LDS_WAIT(); asm volatile("" ::: "memory");
    const int c = lane & 7;
#pragma unroll
    for (int j = 0; j < 4; ++j) { const int n = (lane >> 3) + 8 * j; const LAS float* s = scr + (8 * c) * 33 + n;
        v4u o; o.x = pk2(s[0 * 33], s[1 * 33]); o.y = pk2(s[2 * 33], s[3 * 33]); o.z = pk2(s[4 * 33], s[5 * 33]); o.w = pk2(s[6 * 33], s[7 * 33]);
        *(GAS v4u*)(WT + (size_t)(drow0 + n) * ldd + dcol0 + 8 * c) = o; }
    LDS_WAIT(); asm volatile("" ::: "memory");
}
__device__ __forceinline__ void rms_row_to_bf16(int lane, const float* xrow, const float* g, bf16* orow) {
    const GAS f32x4* xr = (const GAS f32x4*)xrow + lane; const GAS f32x4* gr = (const GAS f32x4*)g + lane;
    f32x4 v[4]; float s = 0.f;
#pragma unroll
    for (int j = 0; j < 4; ++j) { v[j] = xr[64 * j]; s += (v[j].x * v[j].x + v[j].y * v[j].y) + (v[j].z * v[j].z + v[j].w * v[j].w); }
    const float r = 1.f / sqrtf(wave_sum(s) * (1.f / DM) + EPS);
    GAS v2u* o8 = (GAS v2u*)orow + lane;
#pragma unroll
    for (int j = 0; j < 4; ++j) { const f32x4 gg = gr[64 * j]; v2u w; w.x = pk2(v[j].x * r * gg.x, v[j].y * r * gg.y); w.y = pk2(v[j].z * r * gg.z, v[j].w * r * gg.w); o8[64 * j] = w; }
}
__device__ __forceinline__ void p0_prologue(Frame& F) {
    const Tc tc = get_tc();
    LAS float* scr = (LAS float*)(F.lds + RING_OFF + tc.wave * 16384);
    const int gw = F.vcu * NWAVES + tc.wave, NGW = F.G * NWAVES; const int lane = tc.lane, l31 = lane & 31;
    unsigned char* ws = F.ws;
    constexpr int I0 = 2816, I1 = 1408, I4 = 2688, I5 = 256, I6 = 512, I8 = 128;
    constexpr int NITEMS = 2 * (I0 + I1) + I4 + 2 * I5 + 2 * I6 + I8;
    for (int it = gw; it < NITEMS; it += NGW) {
        int r = it;
        if (r < 2 * (I0 + I1)) {
            const int l2 = r >= (I0 + I1); if (l2) r -= (I0 + I1);
            if (r < I0) {
                const int kb = r / 176, g = r % 176, j = g >> 3, sub = g & 7;
                const float* W = l2 ? ((sub >> 2) ? F.A->in[22] : F.A->in[21]) : ((sub >> 2) ? F.A->in[4] : F.A->in[3]);
                xpose_item(W, l2 ? F.A->in[20] : F.A->in[2], (sub >> 2) ? -0.6931471805599453f : -LOG2E, DFF, 64 * kb,
                           128 * j + 32 * (sub & 3) + l31, 128 * j + 32 * (sub & 3), (bf16*)(ws + (l2 ? WS_W2GU : WS_W1GU)), DM, 32 * g, 64 * kb, scr, lane);
            } else { r -= I0;
                const int kb = r / 32, g = r % 32;
                xpose_item(l2 ? F.A->in[23] : F.A->in[5], nullptr, 1.0f, DM, 64 * kb, 32 * g + l31, 32 * g, (bf16*)(ws + (l2 ? WS_W2D : WS_W1D)) + (size_t)(kb >> 1) * (DM * 128), 128, 32 * g, 64 * (kb & 1), scr, lane);
            }
            continue;
        }
        r -= 2 * (I0 + I1);
        if (r < I4) {
            const int kb = r / 168, g = r % 168, r0 = 32 * g; int sc;
            if (r0 < 1536) sc = r0 + l31; else if (r0 < 3072) sc = r0 + 8 + l31;
            else if (r0 < 5120) { const int tj = (r0 - 3072) >> 8, wi = (r0 - 3072) & 255; sc = ((wi < 128) ? 3088 + 128 * tj + wi : 4112 + 128 * tj + (wi - 128)) + l31; }
            else if (r0 == 5120) sc = (l31 < 8) ? 1536 + l31 : (l31 < 16) ? 3080 + (l31 - 8) : -1; else sc = -1;
            const int sv = (r0 < 5120) ? sc - l31 : -1;
            const float wsc = ((r0 >= 1024 && r0 < 1536) || (r0 >= 3072 && r0 < 5120)) ? -LOG2E : 1.0f;
            xpose_item(F.A->in[8], F.A->in[7], wsc, 5136, 64 * kb, sc, sv, (bf16*)(ws + WS_WIN), DM, r0, 64 * kb, scr, lane);
            continue;
        }
        r -= I4;
        if (r < 2 * I5) { const int hb = r >= I5; if (hb) r -= I5; const int kb = r / 32, g = r % 32;
            xpose_item(hb ? F.A->in[17] : F.A->in[16], nullptr, 1.0f, DM, 64 * kb, 32 * g + l31, 32 * g, (bf16*)(ws + WS_WAB), DM, 32 * g, 512 * hb + 64 * kb, scr, lane); continue; }
        r -= 2 * I5;
        if (r < 2 * I6) { const int hb = r >= I6; if (hb) r -= I6; const int kb = r / 32, g = r % 32;
            xpose_item(hb ? F.A->in[26] : F.A->in[18], hb ? F.A->in[25] : nullptr, 1.0f,     DM, 64 * kb, 32 * g + l31, 32 * g, (bf16*)(ws + (hb ? WS_WPG : WS_WOUT)), DM, 32 * g, 64 * kb, scr, lane); continue; }
        r -= 2 * I6;
        { const int kb = r / 32, g = r % 32;
            xpose_item(F.A->in[28], nullptr, 1.0f, DM, 64 * kb, 32 * g + l31, 32 * g, (bf16*)(ws + WS_WPP), 256, 32 * g, 64 * kb, scr, lane); }
    }
    bf16* XN = (bf16*)(ws + WS_XN);
    {
        for (int m0 = gw; m0 < TOK; m0 += ER * NGW) {
            f32x4 v[ER][2][2]; float sq[ER];
#pragma unroll
            for (int i = 0; i < ER; ++i) { const int m = (m0 + i * NGW < TOK) ? m0 + i * NGW : m0; const float* xr = F.A->in[0] + (size_t)m * DM + 8 * lane;
#pragma unroll
                for (int j = 0; j < 2; ++j) { v[i][j][0] = *(const f32x4*)(xr + 512 * j); v[i][j][1] = *(const f32x4*)(xr + 512 * j + 4); } }
#pragma unroll
            for (int i = 0; i < ER; ++i) sq[i] = sumsq8(v[i][0][0], v[i][0][1]) + sumsq8(v[i][1][0], v[i][1][1]);
#pragma unroll
            for (int o = 1; o < 64; o <<= 1)
#pragma unroll
                for (int i = 0; i < ER; ++i) sq[i] += __shfl_xor(sq[i], o);
#pragma unroll
            for (int i = 0; i < ER; ++i) if (m0 + i * NGW < TOK) { bf16* orow = XN + (size_t)(m0 + i * NGW) * DM + 8 * lane;
                if (lane == 0) ((float*)(ws + WS_RMS))[m0 + i * NGW] = 1.f / sqrtf(sq[i] * (1.f / DM) + EPS);
#pragma unroll
                for (int j = 0; j < 2; ++j) *(v4u*)(orow + 512 * j) = f32_to_bf8(v[i][j][0], v[i][j][1]); }
        }
    }
}

constexpr int EB = 2;
template <int XNM, bool GATES, int RIN, bool ROUT16>
__device__ __forceinline__ void ew_phase(Frame& F, const bf16* Y, const void* res, void* out, float coef, const float* gpost, const float* gpre, bf16* XN, const float* gin = nullptr, const float* rms = nullptr, float* rsout = nullptr) {
    constexpr bool RIN16 = (RIN != 0); constexpr bool HAS_XN = (XNM == 1);
    const Tc tc = get_tc(); const int lane = tc.lane;
    const int gw = F.vcu * NWAVES + tc.wave, NGW = F.G * NWAVES;
    const int nbat = (TOK / EB - gw + NGW - 1) / NGW;
    v4u yw[EB][2]; v4u rw16[EB][2]; f32x4 rw32[EB][2][2]; float rmv[EB];
    constexpr int WGP = 1032;
    if constexpr (GATES) {
        LAS bf16* LWG = (LAS bf16*)F.lds;
        for (int i = tc.tid; i < 16 * 128; i += NWAVES * 64) { const int r = i >> 7, c8 = (i & 127) * 8;
            *(LAS v4u*)(LWG + r * WGP + c8) = *(const v4u*)((const bf16*)(F.ws + WS_WIN) + (size_t)(5120 + r) * DM + c8); }
        LDS_WAIT(); __syncthreads();
    }
#define EW_ROW0(it) (EB * (gw + (it) * NGW))
#define EW_LOAD(it) do { unsigned l16_ = (unsigned)lane * 16u; asm volatile("" : "+v"(l16_)); const int mb_ = EW_ROW0(it); \
        _Pragma("unroll") for (int i = 0; i < EB; ++i) { const char* yb_ = (const char*)Y + (size_t)(mb_ + i) * (DM * 2); \
            if constexpr (RIN == 2) rmv[i] = rms[mb_ + i]; \
            if constexpr (RIN16) { const char* rb_ = (const char*)res + (size_t)(mb_ + i) * (DM * 2); \
                _Pragma("unroll") for (int j = 0; j < 2; ++j) { yw[i][j] = *(const v4u*)(yb_ + l16_ + 1024 * j); rw16[i][j] = *(const v4u*)(rb_ + l16_ + 1024 * j); } } \
            else { const char* rb_ = (const char*)res + (size_t)(mb_ + i) * (DM * 4); \
                _Pragma("unroll") for (int j = 0; j < 2; ++j) { yw[i][j] = *(const v4u*)(yb_ + l16_ + 1024 * j); rw32[i][j][0] = *(const f32x4*)(rb_ + 2 * l16_ + 2048 * j); rw32[i][j][1] = *(const f32x4*)(rb_ + 2 * l16_ + 2048 * j + 16); } } } } while (0)
    f32x4 g1[2][2], g2[2][2], gi[2][2];
    { const unsigned lg = (unsigned)lane * 32u;
#pragma unroll
      for (int j = 0; j < 2; ++j)
#pragma unroll
        for (int q = 0; q < 2; ++q) { g1[j][q] = *(const f32x4*)((const char*)gpost + lg + 2048 * j + 16 * q);
            if constexpr (XNM == 1) g2[j][q] = *(const f32x4*)((const char*)gpre + lg + 2048 * j + 16 * q);
            if constexpr (RIN == 2) { const f32x4 g = *(const f32x4*)((const char*)gin + lg + 2048 * j + 16 * q); gi[j][q] = (f32x4){__builtin_amdgcn_rcpf(g.x), __builtin_amdgcn_rcpf(g.y), __builtin_amdgcn_rcpf(g.z), __builtin_amdgcn_rcpf(g.w)}; } } }
    if (nbat > 0) EW_LOAD(0);
#pragma unroll 1
    for (int it = 0; it < nbat; ++it) {
        const int m0 = EW_ROW0(it);
        unsigned l16 = (unsigned)lane * 16u; asm volatile("" : "+v"(l16));
        f32x4 y[EB][2][2], h[EB][2][2]; float s[EB], s2[EB];
#pragma unroll
        for (int i = 0; i < EB; ++i) { s[i] = 0.f;
#pragma unroll
            for (int j = 0; j < 2; ++j) { bf8_to_f32(yw[i][j], y[i][j][0], y[i][j][1]);
                if constexpr (RIN16) bf8_to_f32(rw16[i][j], h[i][j][0], h[i][j][1]); else { h[i][j][0] = rw32[i][j][0]; h[i][j][1] = rw32[i][j][1]; }
                if constexpr (RIN == 2) { h[i][j][0] = h[i][j][0] * rmv[i] * gi[j][0]; h[i][j][1] = h[i][j][1] * rmv[i] * gi[j][1]; }
                s[i] += sumsq8(y[i][j][0], y[i][j][1]); } }
        asm volatile("" ::: "memory");
        if (it + 1 < nbat) EW_LOAD(it + 1);
#pragma unroll
        for (int o = 1; o < 64; o <<= 1)
#pragma unroll
            for (int i = 0; i < EB; ++i) s[i] += __shfl_xor(s[i], o);
#pragma unroll
        for (int i = 0; i < EB; ++i) { const float r = coef / sqrtf(s[i] * (1.f / DM) + EPS); s2[i] = 0.f;
#pragma unroll
            for (int j = 0; j < 2; ++j) { h[i][j][0] = h[i][j][0] + y[i][j][0] * r * g1[j][0]; h[i][j][1] = h[i][j][1] + y[i][j][1] * r * g1[j][1]; s2[i] += sumsq8(h[i][j][0], h[i][j][1]); }
            if constexpr (ROUT16) { char* ob = (char*)out + (size_t)(m0 + i) * (DM * 2);
#pragma unroll
                for (int j = 0; j < 2; ++j) *(v4u*)(ob + l16 + 1024 * j) = f32_to_bf8(h[i][j][0], h[i][j][1]);
            } else { char* ob = (char*)out + (size_t)(m0 + i) * (DM * 4);
#pragma unroll
                for (int j = 0; j < 2; ++j) { *(f32x4*)(ob + 2 * l16 + 2048 * j) = h[i][j][0]; *(f32x4*)(ob + 2 * l16 + 2048 * j + 16) = h[i][j][1]; } } }
        if constexpr (XNM == 2) {
#pragma unroll
            for (int o = 1; o < 64; o <<= 1)
#pragma unroll
                for (int i = 0; i < EB; ++i) s2[i] += __shfl_xor(s2[i], o);
            if (lane == 0) {
#pragma unroll
                for (int i = 0; i < EB; ++i) rsout[m0 + i] = 1.f / sqrtf(s2[i] * (1.f / DM) + EPS); }
        }
        if constexpr (HAS_XN) {
#pragma unroll
            for (int o = 1; o < 64; o <<= 1)
#pragma unroll
                for (int i = 0; i < EB; ++i) s2[i] += __shfl_xor(s2[i], o);
#pragma unroll
            for (int i = 0; i < EB; ++i) { const float r2 = 1.f / sqrtf(s2[i] * (1.f / DM) + EPS);
                char* xb = (char*)XN + (size_t)(m0 + i) * (DM * 2);
#pragma unroll
                for (int j = 0; j < 2; ++j) *(v4u*)(xb + l16 + 1024 * j) = f32_to_bf8(h[i][j][0] * r2 * g2[j][0], h[i][j][1] * r2 * g2[j][1]); }
        }
        if constexpr (GATES) { if ((it & 7) == 7 || it + 1 == nbat) {
            const int it0 = it & ~7;
            VM_WAIT();
            int ln = lane; asm volatile("" : "+v"(ln));
            const int qa = ln & 15; int ita = it0 + (qa >> 1); ita = ita < nbat ? ita : it0;
            const bf16* arow = (const bf16*)out + (size_t)(EW_ROW0(ita) + (qa & 1)) * DM + 8 * (ln >> 4);
            const LAS bf16* brow = (const LAS bf16*)F.lds + (ln & 15) * WGP + 8 * (ln >> 4);
            f32x4 acc = {0.f, 0.f, 0.f, 0.f};
#pragma unroll 16
            for (int kk = 0; kk < 32; ++kk) { const bf16x8 a = *(const bf16x8*)(arow + 32 * kk), b = *(const LAS bf16x8*)(brow + 32 * kk);
                acc = __builtin_amdgcn_mfma_f32_16x16x32_bf16(a, b, acc, 0, 0, 0); }
            const int n = ln & 15; const float* bp = (n < 4) ? F.A->in[11] + n : (n < 8) ? F.A->in[12] + (n - 4) : F.A->in[14] + (n - 8); const float bias = *bp;
#pragma unroll
            for (int r = 0; r < 4; ++r) { const int q = 4 * (ln >> 4) + r, itq = it0 + (q >> 1);
                if (itq < nbat) { const int grow = EW_ROW0(itq) + (q & 1); ((float*)(F.ws + WS_GATES))[(size_t)grow * 16 + n] = acc[r] * rsout[grow] + bias; } }
        } }
    }
#undef EW_ROW0
#undef EW_LOAD
}
typedef float f32x16 __attribute__((ext_vector_type(16)));
#define MFMA32(a, b, c) __builtin_amdgcn_mfma_f32_32x32x16_bf16(a, b, c, 0, 0, 0)
__device__ __forceinline__ int crow16(int r, int hi) { return (r & 3) + 8 * (r >> 2) + 4 * hi; }
__device__ __forceinline__ float log_sigmoid_f(float x) { return fminf(x, 0.f) - log1pf(expf(-fabsf(x))); }
__device__ __forceinline__ float wave_incl_scan_add(float v, int lane) {
#pragma unroll
    for (int o = 1; o < 64; o <<= 1) { const float t = __shfl_up(v, o); if (lane >= o) v += t; }
    return v;
}
__device__ __forceinline__ float wave_incl_scan_max(float v, int lane) {
#pragma unroll
    for (int o = 1; o < 64; o <<= 1) { const float t = __shfl_up(v, o); if (lane >= o) v = fmaxf(v, t); }
    return v;
}
__device__ __forceinline__ int swap23(int s) { return (s & ~12) | ((s & 4) << 1) | ((s & 8) >> 1); }
constexpr int LP = 72;

struct M1In { v4u xq[4], xk[4]; v4u v0, v1; float g0, g1; };
__device__ __forceinline__ void m1_load(Frame& F, int u, M1In& R) {
    const Tc tc = get_tc(); const int tid = tc.tid, lane = tc.lane, wave = tc.wave;
    const int h = u & 3, c = (u >> 2) & 63, b = u >> 8, tok0 = b * SEQ + c * CH, tt = tid >> 3, cg = tid & 7;
    unsigned char* ws = F.ws;
    const bf16* mqk = (const bf16*)(ws + WS_SEG0);
#pragma unroll
    for (int j = 0; j < 4; ++j) { const int ts = c * CH + tt - 3 + j;
        R.xq[j] = (v4u){0u, 0u, 0u, 0u}; R.xk[j] = (v4u){0u, 0u, 0u, 0u};
        if (ts >= 0 && (j == 3 || (tt & 7) < 3 - j)) { const bf16* rp = mqk + (size_t)(b * SEQ + ts) * 512 + 64 * h + 8 * cg; R.xq[j] = *(const v4u*)rp; R.xk[j] = *(const v4u*)(rp + 256); } }
    const bf16* mv = (const bf16*)(ws + WS_SEG0 + 32 * MiB) + (size_t)(tok0 + tt) * 512 + 128 * h + 16 * cg;
    R.v0 = *(const v4u*)mv; R.v1 = *(const v4u*)(mv + 8);
    const float* gr = (const float*)(ws + WS_GATES) + (size_t)(tok0 + lane) * 16;
    R.g0 = 0.f; R.g1 = 0.f;
    if (wave == 0) { R.g0 = gr[h]; R.g1 = gr[4 + h]; } else if (wave <= 2) { R.g0 = gr[8 + 2 * h + (wave - 1)]; }
}
__device__ __forceinline__ void m1_phase(Frame& F) {
    constexpr int NU = BATCH * NCH * MH;
    int u = F.vcu; if (u >= NU) return;
    unsigned char* ws = F.ws; LAS unsigned char* L = F.lds;
    LAS bf16* LKT = (LAS bf16*)(L);
    LAS bf16* LVT = (LAS bf16*)(L + 64 * LP * 2);
    LAS float* LW = (LAS float*)(L + 64 * LP * 2 + 128 * LP * 2);
    M1In R; m1_load(F, u, R);
    f32x4 cwv[2][4][2]; f32x4 cbv[2][2]; int hcur = -1;
#pragma unroll 1
    for (; u < NU; u += F.G) {
        const Tc tc = get_tc(); const int tid = tc.tid, lane = tc.lane, wave = tc.wave;
        const int h = u & 3, c = (u >> 2) & 63, b = u >> 8, tok0 = b * SEQ + c * CH, uidx = (b * MH + h) * NCH + c, tt = tid >> 3, cg = tid & 7;
        if (h != hcur) { hcur = h; const float* cw = F.A->in[9]; const float* cb = F.A->in[10];
#pragma unroll
            for (int part = 0; part < 2; ++part) { const int ch0 = part * 256 + 64 * h + 8 * cg; cbv[part][0] = *(const f32x4*)(cb + ch0); cbv[part][1] = *(const f32x4*)(cb + ch0 + 4);
#pragma unroll
                for (int j = 0; j < 4; ++j) { cwv[part][j][0] = *(const f32x4*)(cw + j * 512 + ch0); cwv[part][j][1] = *(const f32x4*)(cw + j * 512 + ch0 + 4); } } }
        if (wave == 0) {
            const float ig = R.g0, lf = log_sigmoid_f(R.g1);
            const float bs = wave_incl_scan_add(lf, lane), a = ig - bs, amax = wave_max(a);
            ((float*)(ws + WS_MA))[(size_t)(b * MH + h) * SEQ + c * CH + lane] = a;
            ((float*)(ws + WS_MB))[(size_t)(b * MH + h) * SEQ + c * CH + lane] = bs;
            LW[lane] = __expf(a - amax);
            if (lane == 63) { float* sc = (float*)(ws + WS_MSC); sc[uidx] = amax; sc[BATCH * MH * NCH + uidx] = bs; }
        } else if (wave <= 2) {
            const int fh = 2 * h + (wave - 1);
            const float lf = log_sigmoid_f(R.g0) * LOG2E;
            const float cs = wave_incl_scan_add(lf, lane);
            ((float*)(ws + WS_FCS))[(size_t)(b * FH + fh) * SEQ + c * CH + lane] = cs;
            if (lane == 63) ((float*)(ws + WS_FCT))[(b * FH + fh) * NCH + c] = cs;
        }
#pragma unroll
        for (int j = 0; j < 3; ++j) { const int d = 8 * (3 - j); const bool take = (tt & 7) >= 3 - j;
            v4u sq, sk; sq.x = __shfl_up(R.xq[3].x, d); sq.y = __shfl_up(R.xq[3].y, d); sq.z = __shfl_up(R.xq[3].z, d); sq.w = __shfl_up(R.xq[3].w, d);
            sk.x = __shfl_up(R.xk[3].x, d); sk.y = __shfl_up(R.xk[3].y, d); sk.z = __shfl_up(R.xk[3].z, d); sk.w = __shfl_up(R.xk[3].w, d);
            if (take) { R.xq[j] = sq; R.xk[j] = sk; } }
        v4u wq, wk;
        {
            float q[8], k[8];
#pragma unroll
            for (int part = 0; part < 2; ++part) {
                float accv[8];
#pragma unroll
                for (int e = 0; e < 8; ++e) accv[e] = cbv[part][e >> 2][e & 3];
#pragma unroll
                for (int j = 0; j < 4; ++j) {
                    const v4u w = part ? R.xk[j] : R.xq[j];
                    const f32x4 w0 = cwv[part][j][0], w1 = cwv[part][j][1];
                    accv[0] += w0.x * pg8::bf_lo(w.x); accv[1] += w0.y * pg8::bf_hi(w.x); accv[2] += w0.z * pg8::bf_lo(w.y); accv[3] += w0.w * pg8::bf_hi(w.y);
                    accv[4] += w1.x * pg8::bf_lo(w.z); accv[5] += w1.y * pg8::bf_hi(w.z); accv[6] += w1.z * pg8::bf_lo(w.w); accv[7] += w1.w * pg8::bf_hi(w.w);
                }
#pragma unroll
                for (int e = 0; e < 8; ++e) { const float sv = accv[e] * pg8::sigmoid_f(accv[e]); if (part == 0) q[e] = sv; else k[e] = sv * 0.125f; }
            }
            bf16* qk = (bf16*)(ws + WS_QK) + (size_t)(tok0 + tt) * 512;
            wq.x = pk2(q[0], q[1]); wq.y = pk2(q[2], q[3]); wq.z = pk2(q[4], q[5]); wq.w = pk2(q[6], q[7]);
            wk.x = pk2(k[0], k[1]); wk.y = pk2(k[2], k[3]); wk.z = pk2(k[4], k[5]); wk.w = pk2(k[6], k[7]);
            *(v4u*)(qk + 64 * h + 8 * cg) = wq; *(v4u*)(qk + 256 + 64 * h + 8 * cg) = wk;
        }
        LDS_WAIT(); __syncthreads();
        {
            const float wgt = LW[tt]; const int pos = swap23(tt);
            const unsigned kw[4] = {wk.x, wk.y, wk.z, wk.w};
#pragma unroll
            for (int e = 0; e < 8; ++e) { const float kv = (e & 1) ? pg8::bf_hi(kw[e >> 1]) : pg8::bf_lo(kw[e >> 1]); LKT[(8 * cg + e) * LP + pos] = (bf16)f2bf(kv * wgt); }
            const unsigned vw[8] = {R.v0.x, R.v0.y, R.v0.z, R.v0.w, R.v1.x, R.v1.y, R.v1.z, R.v1.w};
#pragma unroll
            for (int e = 0; e < 16; ++e) LVT[(16 * cg + e) * LP + pos] = (bf16)((e & 1) ? (vw[e >> 1] >> 16) : (vw[e >> 1] & 0xffffu));
        }
        LDS_WAIT(); __syncthreads();
        if (u + F.G < NU) m1_load(F, u + F.G, R);
        {
            const int r = lane & 31, hi = lane >> 5, dvt = wave >> 1, dkt = wave & 1;
            f32x16 acc = {};
#pragma unroll
            for (int ks = 0; ks < 4; ++ks) {
                const bf16x8 av = *(const LAS bf16x8*)(LVT + (32 * dvt + r) * LP + 16 * ks + 8 * hi);
                const bf16x8 bk = *(const LAS bf16x8*)(LKT + (32 * dkt + r) * LP + 16 * ks + 8 * hi);
                acc = MFMA32(av, bk, acc);
            }
            bf16* dst = (bf16*)(ws + WS_CST) + (size_t)uidx * (MDV * MDK) + 32 * dkt + r;
#pragma unroll
            for (int rg = 0; rg < 16; ++rg) dst[(size_t)(32 * dvt + crow16(rg, hi)) * MDK] = (bf16)f2bf(acc[rg]);
            if (wave == 0) {
                float sacc = 0.f;
#pragma unroll
                for (int j = 0; j < 8; ++j) { const v4u w = *(const LAS v4u*)(LKT + lane * LP + 8 * j);
                    sacc += (pg8::bf_lo(w.x) + pg8::bf_hi(w.x)) + (pg8::bf_lo(w.y) + pg8::bf_hi(w.y)) + (pg8::bf_lo(w.z) + pg8::bf_hi(w.z)) + (pg8::bf_lo(w.w) + pg8::bf_hi(w.w)); }
                ((float*)(ws + WS_MDN))[(size_t)uidx * 64 + lane] = sacc;
            }
        }
        LDS_WAIT();
    }
    __syncthreads();
}

__device__ __forceinline__ void m2_phase(Frame& F) {
    unsigned char* ws = F.ws; const Tc tc = get_tc(); const int tid = tc.tid;
    const float* sc = (const float*)(ws + WS_MSC); float* mstv = (float*)(ws + WS_MSC) + 2 * BATCH * MH * NCH;
    for (int job = F.vcu; job < BATCH * MH * 8; job += F.G) {
        const int bh = job >> 3, part = job & 7;
        unsigned* cst = (unsigned*)(ws + WS_CST) + (size_t)bh * NCH * (MDV * MDK / 2) + part * 512 + tid;
        float* dn = (float*)(ws + WS_MDN) + (size_t)bh * NCH * 64 + tid;
        float c0 = 0.f, c1 = 0.f, nn = 0.f, mst = 0.f;
        const bool do_n = (part == 0 && tid < 64), do_m = (part == 1 && tid == 0);
        unsigned wv[NCH]; float dv[NCH];
#pragma unroll
        for (int c = 0; c < NCH; ++c) { wv[c] = cst[(size_t)c * (MDV * MDK / 2)]; dv[c] = do_n ? dn[c * 64] : 0.f; }
#pragma unroll
        for (int c = 0; c < NCH; ++c) {
            const float amax = sc[bh * NCH + c], blast = sc[BATCH * MH * NCH + bh * NCH + c];
            const float mu = fmaxf(mst, amax), d1 = __expf(mst - mu), d2 = __expf(amax - mu);
            if (do_m) mstv[bh * NCH + c] = mst;
            const unsigned w = wv[c];
            c0 = d1 * c0 + d2 * pg8::bf_lo(w); c1 = d1 * c1 + d2 * pg8::bf_hi(w);
            cst[(size_t)c * (MDV * MDK / 2)] = pk2(c0, c1);
            if (do_n) { nn = d1 * nn + d2 * dv[c]; dn[c * 64] = nn; }
            mst = blast + mu;
        }
    }
    const int gw = F.vcu * NWAVES + tc.wave;
    if (gw < BATCH * FH) {
        const float tot = ((const float*)(ws + WS_FCT))[gw * NCH + tc.lane];
        const float incl = wave_incl_scan_add(tot, tc.lane), excl = incl - tot;
        float* cs = (float*)(ws + WS_FCS) + (size_t)gw * SEQ;
        float cv[NCH];
#pragma unroll
        for (int c = 0; c < NCH; ++c) cv[c] = cs[c * CH + tc.lane];
#pragma unroll
        for (int c = 0; c < NCH; ++c) cs[c * CH + tc.lane] = cv[c] + __shfl(excl, c);
    }
}

struct M3In { v4u q, k, v0, v1, c0, c1, o0, o1; float a, bs, mst, np; };
__device__ __forceinline__ void m3_load(Frame& F, int u, M3In& R) {
    const Tc tc = get_tc(); const int tid = tc.tid, lane = tc.lane, wave = tc.wave;
    const int h = u & 3, c = (u >> 2) & 63, b = u >> 8, tok0 = b * SEQ + c * CH, uidx = (b * MH + h) * NCH + c, tt = tid >> 3, cg = tid & 7;
    unsigned char* ws = F.ws;
    const bf16* qk = (const bf16*)(ws + WS_QK) + (size_t)(tok0 + tt) * 512;
    R.q = *(const v4u*)(qk + 64 * h + 8 * cg); R.k = *(const v4u*)(qk + 256 + 64 * h + 8 * cg);
    const bf16* mv = (const bf16*)(ws + WS_SEG0 + 32 * MiB) + (size_t)(tok0 + tt) * 512 + 128 * h + 16 * cg;
    R.v0 = *(const v4u*)mv; R.v1 = *(const v4u*)(mv + 8);
    const bf16* mo = (const bf16*)(ws + WS_SEG0 + 64 * MiB) + (size_t)(tok0 + tt) * 512 + 128 * h + 16 * cg;
    R.o0 = *(const v4u*)mo; R.o1 = *(const v4u*)(mo + 8);
    const int dv = tid >> 2, c16 = (tid & 3) * 16;
    R.c0 = (v4u){0u, 0u, 0u, 0u}; R.c1 = (v4u){0u, 0u, 0u, 0u};
    if (c > 0) { const bf16* cp = (const bf16*)(ws + WS_CST) + (size_t)(uidx - 1) * (MDV * MDK) + dv * MDK + c16; R.c0 = *(const v4u*)cp; R.c1 = *(const v4u*)(cp + 8); }
    R.a = 0.f; R.bs = 0.f; R.mst = 0.f; R.np = 0.f;
    if (wave == 0) {
        R.a = ((const float*)(ws + WS_MA))[(size_t)(b * MH + h) * SEQ + c * CH + lane];
        R.bs = ((const float*)(ws + WS_MB))[(size_t)(b * MH + h) * SEQ + c * CH + lane];
        R.mst = ((const float*)(ws + WS_MSC))[2 * BATCH * MH * NCH + uidx];
        R.np = (c > 0) ? ((const float*)(ws + WS_MDN))[(size_t)(uidx - 1) * 64 + lane] : 0.f;
    }
}
#ifndef M3_DYNAMIC
#define M3_DYNAMIC 1
#endif
__device__ __forceinline__ void m3_phase(Frame& F, int reps) {
    constexpr int NU = BATCH * NCH * MH;
    unsigned char* ws = F.ws; LAS unsigned char* L = F.lds;
    LAS bf16* LQ = (LAS bf16*)(L);
    LAS bf16* LK = (LAS bf16*)(L + 9216);
    LAS bf16* LVT = (LAS bf16*)(L + 18432);
    LAS bf16* LCT = (LAS bf16*)(L + 36864);
    LAS float* LH = (LAS float*)(L + 55296);
    LAS float* LSC = (LAS float*)(L + 89088);
    const bool dyn = (M3_DYNAMIC != 0) && reps == 1 && F.G * 8 == NU;
    volatile LAS unsigned* qslot = F.MISC + 40;
    unsigned* qctr = (unsigned*)(F.ctl + CW_M3Q);
    for (int rp = 0; rp < reps; ++rp) {
    int u = F.vcu; if (u >= NU) return;
    int un = u + F.G;
    M3In R; m3_load(F, u, R);
    f32x4 gnv[4]; int hcur = -1;
#pragma unroll 1
    for (; u < NU; ) {
        const Tc tc = get_tc(); const int tid = tc.tid, lane = tc.lane, wave = tc.wave;
        unsigned qa = 0u; if (dyn && tid == 0) qa = __hip_atomic_fetch_add(qctr, 1u, RLX_AGENT);
        const int h = u & 3, c = (u >> 2) & 63, b = u >> 8, tok0 = b * SEQ + c * CH, tt = tid >> 3, cg = tid & 7;
        if (h != hcur) { hcur = h; const float* gp = F.A->in[13] + 128 * h + 16 * cg;
#pragma unroll
            for (int j = 0; j < 4; ++j) gnv[j] = *(const f32x4*)(gp + 4 * j); }
        LAS float* LWS = (LAS float*)(L + 89088 + 2048) + wave * 64;
        const v4u mo0 = R.o0, mo1 = R.o1;
        {
            *(LAS v4u*)(LQ + tt * LP + 8 * cg) = R.q; *(LAS v4u*)(LK + tt * LP + 8 * cg) = R.k;
            const unsigned vw[8] = {R.v0.x, R.v0.y, R.v0.z, R.v0.w, R.v1.x, R.v1.y, R.v1.z, R.v1.w}; const int pos = swap23(tt);
#pragma unroll
            for (int e = 0; e < 16; ++e) LVT[(16 * cg + e) * LP + pos] = (bf16)((e & 1) ? (vw[e >> 1] >> 16) : (vw[e >> 1] & 0xffffu));
            const int dv = tid >> 2, c16 = (tid & 3) * 16;
            *(LAS v4u*)(LCT + dv * LP + c16) = R.c0; *(LAS v4u*)(LCT + dv * LP + c16 + 8) = R.c1;
            if (wave == 0) {
                const float mu = fmaxf(R.mst, wave_incl_scan_max(R.a, lane));
                LSC[lane] = R.a; LSC[64 + lane] = mu; LSC[128 + lane] = __expf(R.mst - mu); LSC[192 + lane] = __expf(-(R.bs + mu)); LSC[256 + lane] = R.np;
            }
        }
        LDS_WAIT(); __syncthreads();
        if (un < NU) m3_load(F, un, R);
        {
            const int r = lane & 31, hi = lane >> 5, ti = wave >> 2, dvj = wave & 3;
            const int t = 32 * ti + r;
            const float mu_t = LSC[64 + t], inter_t = LSC[128 + t], emt_t = LSC[192 + t];
            float qn = 0.f;
#pragma unroll
            for (int j = 0; j < 4; ++j) { const v4u w = *(const LAS v4u*)(LQ + t * LP + 32 * hi + 8 * j); const f32x4 n0 = *(const LAS f32x4*)(LSC + 256 + 32 * hi + 8 * j), n1 = *(const LAS f32x4*)(LSC + 256 + 32 * hi + 8 * j + 4);
                qn += pg8::bf_lo(w.x) * n0.x + pg8::bf_hi(w.x) * n0.y + pg8::bf_lo(w.y) * n0.z + pg8::bf_hi(w.y) * n0.w + pg8::bf_lo(w.z) * n1.x + pg8::bf_hi(w.z) * n1.y + pg8::bf_lo(w.w) * n1.z + pg8::bf_hi(w.w) * n1.w; }
            qn += __shfl_xor(qn, 32);
            bf16x8 qf[4];
#pragma unroll
            for (int ks = 0; ks < 4; ++ks) qf[ks] = *(const LAS bf16x8*)(LQ + t * LP + 16 * ks + 8 * hi);
            f32x16 z1 = {}, z2 = {}; float den = 0.f;
#pragma unroll
            for (int si = 0; si < 2; ++si) {
                if (si <= ti) {
                    f32x16 x = {};
#pragma unroll
                    for (int ks = 0; ks < 4; ++ks) { const bf16x8 kf = *(const LAS bf16x8*)(LK + (32 * si + r) * LP + 16 * ks + 8 * hi); x = MFMA32(kf, qf[ks], x); }
#pragma unroll
                    for (int g = 0; g < 4; ++g) { const f32x4 av = *(const LAS f32x4*)(LSC + 32 * si + 8 * g + 4 * hi);
#pragma unroll
                        for (int e = 0; e < 4; ++e) { const int sidx = 32 * si + 8 * g + 4 * hi + e; const float w = (sidx <= t) ? __expf(fminf(av[e] - mu_t, 0.f)) : 0.f; const float pp = x[4 * g + e] * w; x[4 * g + e] = pp; den += pp; } }
#pragma unroll
                    for (int k2 = 0; k2 < 2; ++k2) {
                        v4u pw; pw.x = pk2(x[8 * k2 + 0], x[8 * k2 + 1]); pw.y = pk2(x[8 * k2 + 2], x[8 * k2 + 3]); pw.z = pk2(x[8 * k2 + 4], x[8 * k2 + 5]); pw.w = pk2(x[8 * k2 + 6], x[8 * k2 + 7]);
                        const bf16x8 vf = *(const LAS bf16x8*)(LVT + (32 * dvj + r) * LP + 32 * si + 16 * k2 + 8 * hi);
                        z1 = MFMA32(__builtin_bit_cast(bf16x8, pw), vf, z1);
                    }
                }
            }
#pragma unroll
            for (int ks = 0; ks < 4; ++ks) { const bf16x8 cf = *(const LAS bf16x8*)(LCT + (32 * dvj + r) * LP + 16 * ks + 8 * hi); z2 = MFMA32(qf[ks], cf, z2); }
            den += __shfl_xor(den, 32);
            den += inter_t * qn;
            const float rden = 1.0f / fmaxf(fabsf(den), emt_t);
            if (hi == 0) { LWS[r] = inter_t; LWS[32 + r] = rden; }
            LDS_WAIT();
#pragma unroll
            for (int g = 0; g < 4; ++g) { const f32x4 iv = *(const LAS f32x4*)(LWS + 8 * g + 4 * hi), rv = *(const LAS f32x4*)(LWS + 32 + 8 * g + 4 * hi);
#pragma unroll
                for (int e = 0; e < 4; ++e) LH[(32 * ti + 8 * g + 4 * hi + e) * 132 + 32 * dvj + r] = (z1[4 * g + e] + iv[e] * z2[4 * g + e]) * rv[e]; }
        }
        if (dyn && tid == 0) qslot[0] = 2u * (unsigned)F.G + qa;
        LDS_WAIT(); __syncthreads();
        const int un2 = dyn ? __builtin_amdgcn_readfirstlane((int)qslot[0]) : un + F.G;
        {
            float v[16]; float sm = 0.f;
#pragma unroll
            for (int j = 0; j < 4; ++j) { const f32x4 x = *(const LAS f32x4*)(LH + tt * 132 + 16 * cg + 4 * j); v[4 * j] = x.x; v[4 * j + 1] = x.y; v[4 * j + 2] = x.z; v[4 * j + 3] = x.w; sm += (x.x + x.y) + (x.z + x.w); }
            sm += __shfl_xor(sm, 1); sm += __shfl_xor(sm, 2); sm += __shfl_xor(sm, 4);
            const float mean = sm * (1.f / MDV); float q = 0.f;
#pragma unroll
            for (int e = 0; e < 16; ++e) { v[e] -= mean; q += v[e] * v[e]; }
            q += __shfl_xor(q, 1); q += __shfl_xor(q, 2); q += __shfl_xor(q, 4);
            const float rstd = 1.0f / sqrtf(q * (1.f / MDV) + EPS);
            const float gn[16] = {gnv[0].x, gnv[0].y, gnv[0].z, gnv[0].w, gnv[1].x, gnv[1].y, gnv[1].z, gnv[1].w, gnv[2].x, gnv[2].y, gnv[2].z, gnv[2].w, gnv[3].x, gnv[3].y, gnv[3].z, gnv[3].w};
            const unsigned ow[8] = {mo0.x, mo0.y, mo0.z, mo0.w, mo1.x, mo1.y, mo1.z, mo1.w};
            unsigned res[8];
#pragma unroll
            for (int e = 0; e < 8; ++e) { const float y0 = v[2 * e] * rstd * gn[2 * e] * pg8::bf_lo(ow[e]), y1 = v[2 * e + 1] * rstd * gn[2 * e + 1] * pg8::bf_hi(ow[e]); res[e] = pk2(y0, y1); }
            bf16* ya = (bf16*)(ws + WS_XN) + (size_t)(tok0 + tt) * 1024 + 128 * h + 16 * cg;
            *(v4u*)ya = (v4u){res[0], res[1], res[2], res[3]}; *(v4u*)(ya + 8) = (v4u){res[4], res[5], res[6], res[7]};
        }
        LDS_WAIT();
        u = un; un = un2;
    }
    __syncthreads();
    }
}
#ifndef MK_N_LAUNCHES
#define MK_N_LAUNCHES 1
#endif
constexpr int NPHASE = 16;
#ifndef FOX_MARGIN
#define FOX_MARGIN 32.0f
#endif
#ifndef ALIGN2
#define ALIGN2 true
#endif
#ifndef FOX_THR
#define FOX_THR 24
#endif
#ifndef REV2
#define REV2 0
#endif

__device__ __forceinline__ void p7_mixer(Frame& F) {
    unsigned char* ws = F.ws;
    const fox_body::bf16* FQ = (const fox_body::bf16*)(ws + WS_SEG0 + 96 * MiB);
    const fox_body::bf16* FK = (const fox_body::bf16*)(ws + WS_SEG0 + 128 * MiB);
    const fox_body::bf16* FV = (const fox_body::bf16*)(ws + WS_SEG0 + 160 * MiB);
    fox_body::bf16* YB = (fox_body::bf16*)(ws + WS_XN);
#ifndef DUP_FOX
#define DUP_FOX 0
#endif
#ifndef DUP_M3
#define DUP_M3 0
#endif
#ifndef NO_FOX
    for (int rf_ = 0; rf_ <= DUP_FOX; ++rf_)
    for (int job = F.vcu; job < BATCH * 32; job += F.G) {
        const int b = job >> 5, r = job & 31, f = r & 3, j = r >> 2;
        int t0s[4];
        { const Tc tc = get_tc();
#pragma unroll
          for (int i = 0; i < 4; ++i) { const int fh = (i & 1) ? 7 - f : f, qb = (i & 2) ? 15 - j : j; const int bh = b * FH + fh;
            const unsigned* nr = (const unsigned*)(F.ctl + CW_NRM) + bh * 4;
            const float xb = 1.02f * (sqrtf(__uint_as_float(nr[0]) * __uint_as_float(nr[2])) + sqrtf(__uint_as_float(nr[1]) * __uint_as_float(nr[3])));
            t0s[i] = fox_body::fox_t0((const float*)(ws + WS_FCS) + (size_t)bh * SEQ, qb, 2.0f * xb + FOX_MARGIN, tc.lane); } }
        const int t0a = t0s[0], t0b = t0s[1], t0c = t0s[2], t0d = t0s[3];
#pragma unroll 1
        for (int i = 0; i < 4; ++i) { const int fh = (i & 1) ? 7 - f : f, qb = (i & 2) ? 15 - j : j; const int bh = b * FH + fh;
            const float* cs = (const float*)(ws + WS_FCS) + (size_t)bh * SEQ;
            fox_body::attn_unit<FOX_THR>(b, fh, qb, FQ, FK, FV, YB, 512 + 64 * fh, cs, (i == 0) ? t0a : (i == 1) ? t0b : (i == 2) ? t0c : t0d, (char*)F.lds); }
    }
#endif
    __syncthreads();
#ifndef NO_M3
    m3_phase(F, 1 + DUP_M3);
#endif
}

__global__ void __launch_bounds__(NWAVES * 64, 2) mega_fwd(Args args) {
    extern __shared__ __attribute__((aligned(16))) unsigned char lds[];
    Frame F;
    F.lds = (LAS unsigned char*)lds;
    F.MISC = (volatile LAS unsigned*)(F.lds + MISC_OFF);
    F.G = gridDim.x; { const int bx = blockIdx.x; F.vcu = (F.G % 8 == 0) ? (bx % 8) * (F.G / 8) + bx / 8 : bx; }
    F.ws = args.ws; F.out = args.out;
    F.A = &args;
    F.ctl = (gu32*)(F.ws + WS_CTL);
    for (int u = threadIdx.x; u < (LDS_BYTES - LDSCTL_OFF) / 4; u += NWAVES * 64) ((LAS unsigned*)(F.lds + LDSCTL_OFF))[u] = 0u;
    __syncthreads();
    const int lo = args.ph_lo, hi = args.ph_hi;
    const bool use_bar = (hi - lo) > 1;
    XcdBarrier bar; bar.bar = (unsigned*)(F.ctl + CW_BAR); bar.x = 0; bar.st = nullptr;
    if (use_bar) bar = xcd_barrier_post((unsigned*)(F.ctl + CW_BAR), F.MISC + 8);
#ifndef PHMASK
#define PHMASK 0xffff
#endif
#define IN(k) (((PHMASK >> (k)) & 1) && lo <= (k) && (k) < hi)
#ifndef DUP_PHASE
#define DUP_PHASE -1
#endif
#ifndef DUP_N
#define DUP_N 1
#endif
#define REPS(k) (((k) == DUP_PHASE) ? 1 + DUP_N : 1)
#ifndef XBAR
#define XBAR 0
#endif
#define SEAM(k) do { if ((IN(k) && IN((k) + 1)) || rep_ + 1 < REPS(k)) { xcd_barrier(bar); for (int xb_ = 0; xb_ < XBAR; ++xb_) xcd_barrier(bar); } } while (0)
    unsigned char* ws = F.ws;
    bf16* XN = (bf16*)(ws + WS_XN); bf16* Y = (bf16*)(ws + WS_Y); bf16* H = (bf16*)(ws + WS_H);
    const int cid = (int)blockIdx.x;

#ifdef CLK_PHASE
    unsigned long long ck_t0 = 0, ck_r0 = 0;
#define CKB(k) do { if ((k) == CLK_PHASE && blockIdx.x == 0 && threadIdx.x == 0) { ck_t0 = __builtin_amdgcn_s_memtime(); ck_r0 = __builtin_amdgcn_s_memrealtime(); } } while (0)
#define CKE(k) do { if ((k) == CLK_PHASE && blockIdx.x == 0 && threadIdx.x == 0) { const unsigned long long t1 = __builtin_amdgcn_s_memtime(), r1 = __builtin_amdgcn_s_memrealtime(); \
        const float v = (CLK_MODE == 0) ? (float)(t1 - ck_t0) / (float)(r1 - ck_r0) : (CLK_MODE == 1) ? (float)(r1 - ck_r0) * 0.01f * CLK_SCALE : (float)CLK_SCALE; __hip_atomic_store((float*)(F.ctl + CW_DBG), CLK_Q * floorf(v / CLK_Q + 0.5f), RLX_AGENT); } } while (0)
#else
#define CKB(k) do {} while (0)
#define CKE(k) do {} while (0)
#endif
    if (IN(0)) for (int rep_ = 0; rep_ < REPS(0); ++rep_) { CKB(0); p0_prologue(F); CKE(0); SEAM(0); }
    if (IN(1)) for (int rep_ = 0; rep_ < REPS(1); ++rep_) { CKB(1);
        pg8::Gemm g{XN, (const bf16*)(ws + WS_W1GU), DM, DM, DM, 256, 256}; pg8::StaticOrder S; S.init(TOK, 2 * DFF, F.G, cid);
        pg8::EpiSwiGLU E{(const float*)(ws + WS_RMS), H};
        pg8::gemm_phase<pg8::EpiSwiGLU, pg8::StaticOrder, true>(F.lds + RING_OFF, g, S, E); CKE(1); SEAM(1); }
    if (IN(2)) for (int rep_ = 0; rep_ < REPS(2); ++rep_) { CKB(2);
        pg8::Gemm g{H, (const bf16*)(ws + WS_W1D), 128, 128, DFF, (size_t)TOK * 256, (size_t)DM * 256}; pg8::StaticOrder S; S.init(TOK, DM, F.G, cid);
        pg8::EpiBf16 E{Y, DM};
        pg8::gemm_phase<pg8::EpiBf16, pg8::StaticOrder, ALIGN2>(F.lds + RING_OFF, g, S, E); CKE(2); SEAM(2); }
    if (IN(3)) for (int rep_ = 0; rep_ < REPS(3); ++rep_) { CKB(3); ew_phase<2, true, 1, true>(F, Y, XN, F.out, 0.5f, args.in[6], nullptr, nullptr, nullptr, nullptr, (float*)(ws + WS_RMS));     CKE(3); SEAM(3); }
    if (IN(4)) for (int rep_ = 0; rep_ < REPS(4); ++rep_) { CKB(4);
        pg8::Gemm g{(const bf16*)F.out, (const bf16*)(ws + WS_WIN), DM, DM, DM, 256, 256}; pg8::StaticOrder S; S.init(TOK, NWIN, F.G, cid);
        pg8::EpiWin E{(const float*)(ws + WS_RMS), (bf16*)(ws + WS_SEG0), (bf16*)(ws + WS_GA), (bf16*)(ws + WS_GB), args.in[15], QC2, (unsigned*)(F.ctl + CW_NRM)};
        pg8::gemm_phase<pg8::EpiWin, pg8::StaticOrder, true>(F.lds + RING_OFF, g, S, E); CKE(4); SEAM(4); }
    if (IN(5)) for (int rep_ = 0; rep_ < REPS(5); ++rep_) { CKB(5); m1_phase(F); CKE(5); SEAM(5); }
    if (IN(6)) for (int rep_ = 0; rep_ < REPS(6); ++rep_) { CKB(6); m2_phase(F); CKE(6); SEAM(6); }
    if (IN(7)) for (int rep_ = 0; rep_ < REPS(7); ++rep_) { CKB(7); p7_mixer(F); CKE(7); SEAM(7); }
    if (IN(8)) for (int rep_ = 0; rep_ < REPS(8); ++rep_) { CKB(8);
        pg8::Gemm g{XN, (const bf16*)(ws + WS_WAB), DM, DM, DM, 256, 256}; pg8::StaticOrder S; S.init(TOK, DM, F.G, cid);
        pg8::EpiMerge E{Y, (const bf16*)(ws + WS_GA), (const bf16*)(ws + WS_GB)};
        pg8::gemm_phase<pg8::EpiMerge, pg8::StaticOrder, ALIGN2>(F.lds + RING_OFF, g, S, E); CKE(8); SEAM(8); }
    if (IN(9)) for (int rep_ = 0; rep_ < REPS(9); ++rep_) { CKB(9);
        pg8::Gemm g{Y, (const bf16*)(ws + WS_WOUT), DM, DM, DM, 256, 256}; pg8::StaticOrder S; S.init(TOK, DM, F.G, cid);
        pg8::EpiBf16 E{XN, DM};
        pg8::gemm_phase<pg8::EpiBf16, pg8::StaticOrder, ALIGN2>(F.lds + RING_OFF, g, S, E); CKE(9); SEAM(9); }
    if (IN(10)) for (int rep_ = 0; rep_ < REPS(10); ++rep_) { CKB(10); ew_phase<2, false, 1, true>(F, XN, F.out, F.out, 1.0f, args.in[19], nullptr, nullptr, nullptr, nullptr, (float*)(ws + WS_RMS));     CKE(10); SEAM(10); }
    if (IN(11)) for (int rep_ = 0; rep_ < REPS(11); ++rep_) { CKB(11);
        pg8::Gemm g{(const bf16*)F.out, (const bf16*)(ws + WS_W2GU), DM, DM, DM, 256, 256}; pg8::StaticOrder S; S.init(TOK, 2 * DFF, F.G, cid);
        pg8::EpiSwiGLU E{(const float*)(ws + WS_RMS), H};
        pg8::gemm_phase<pg8::EpiSwiGLU, pg8::StaticOrder, true>(F.lds + RING_OFF, g, S, E); CKE(11); SEAM(11); }
    if (IN(12)) for (int rep_ = 0; rep_ < REPS(12); ++rep_) { CKB(12);
        pg8::Gemm g{H, (const bf16*)(ws + WS_W2D), 128, 128, DFF, (size_t)TOK * 256, (size_t)DM * 256}; pg8::StaticOrder S; S.init(TOK, DM, F.G, cid);
        pg8::EpiBf16 E{XN, DM};
        pg8::gemm_phase<pg8::EpiBf16, pg8::StaticOrder, ALIGN2>(F.lds + RING_OFF, g, S, E); CKE(12); SEAM(12); }
    if (IN(13)) for (int rep_ = 0; rep_ < REPS(13); ++rep_) { CKB(13);
        ew_phase<2, false, 1, true>(F, XN, F.out, H, 0.5f, args.in[24], nullptr, nullptr, nullptr, nullptr, (float*)(ws + WS_RMS));
        const Tc tc = get_tc(); const int gw = F.vcu * NWAVES + tc.wave, NGW = F.G * NWAVES; bf16* PB = (bf16*)(ws + WS_PB);
#pragma unroll 4
        for (int m2 = 2 * gw; m2 < TOK; m2 += 2 * NGW) { const int m = m2 + (tc.lane >> 5), c8 = 8 * (tc.lane & 31);
            const float* pr = args.in[1] + (size_t)m * 256 + c8; const f32x4 a = *(const f32x4*)pr, b = *(const f32x4*)(pr + 4);
            *(v4u*)(PB + (size_t)m * 256 + c8) = f32_to_bf8(a, b); }
        CKE(13); SEAM(13); }
    if (IN(14)) for (int rep_ = 0; rep_ < REPS(14); ++rep_) { CKB(14);
        { pg8::Gemm g{(const bf16*)(ws + WS_PB), (const bf16*)(ws + WS_WPP), 256, 256, 256, 256, 256}; pg8::StaticOrder S; S.init(TOK, DM, F.G, cid);
          pg8::EpiBf16 E{(bf16*)(ws + WS_EMB), DM};
          pg8::gemm_phase<pg8::EpiBf16, pg8::StaticOrder, ALIGN2>(F.lds + RING_OFF, g, S, E); }
        VM_WAIT(); __syncthreads();
        { pg8::Gemm g{H, (const bf16*)(ws + WS_WPG), DM, DM, DM, 256, 256}; pg8::StaticOrder S; S.init(TOK, DM, F.G, cid);
          pg8::EpiPle E{(const float*)(ws + WS_RMS), XN, (const bf16*)(ws + WS_EMB), args.in[27]};
          pg8::gemm_phase<pg8::EpiPle, pg8::StaticOrder, ALIGN2>(F.lds + RING_OFF, g, S, E); }
        CKE(14); SEAM(14); }
    if (IN(15)) for (int rep_ = 0; rep_ < REPS(15); ++rep_) { ew_phase<0, false, 1, false>(F, XN, H, F.out, 1.0f, args.in[29], nullptr, nullptr);
#ifdef CLK_PHASE
        { xcd_barrier(bar); const float dv = __hip_atomic_load((float*)(F.ctl + CW_DBG), RLX_AGENT); const Tc tc = get_tc(); const int gw = F.vcu * NWAVES + tc.wave, NGW = F.G * NWAVES;
          for (int m = gw; m < TOK; m += NGW) { GAS f32x4* o = (GAS f32x4*)(F.out + (size_t)m * DM) + tc.lane;
#pragma unroll
              for (int j = 0; j < 4; ++j) { f32x4 v = o[64 * j]; v = v + dv; o[64 * j] = v; } } }
#endif
    }
#ifdef EWP_PROBE
    for (int rp = 0; rp < EWP_PROBE; ++rp) { xcd_barrier(bar);
        ew_phase<1, false, 1, true>(F, XN, H, (bf16*)(ws + WS_H + 64 * MiB), 1.0f, args.in[19], args.in[20], (bf16*)(ws + WS_H + 128 * MiB)); }
#endif
#ifdef COPY_PROBE
    for (int rp = 0; rp < COPY_PROBE; ++rp) { xcd_barrier(bar);
        const Tc tc = get_tc(); const size_t nvec = (size_t)128 * MiB / 16; const size_t gtid = (size_t)(F.vcu * NWAVES + tc.wave) * 64 + tc.lane, gsz = (size_t)F.G * NWAVES * 64;
        const v4u* src = (const v4u*)(ws + WS_H + 192 * MiB); v4u* dst = (v4u*)(ws + WS_H + 64 * MiB);
        for (size_t i = gtid; i < nvec; i += gsz * COPY_U) { v4u t[COPY_U];
#pragma unroll
            for (int j = 0; j < COPY_U; ++j) t[j] = src[i + j * gsz];
#pragma unroll
            for (int j = 0; j < COPY_U; ++j) dst[i + j * gsz] = t[j]; } }
#endif
#undef IN
#undef SEAM
}

extern "C" void kernel_launch(void* const* d_in, const int* in_sizes, int n_in, void* d_out, int out_size, void* d_ws, size_t ws_size, hipStream_t stream) {
    static int grid = 0;
    if (grid == 0) {
        if (n_in != 30 || in_sizes[0] != TOK * DM || out_size != TOK * DM || ws_size < WS_END) { fprintf(stderr, "kernel_launch: unexpected shapes (n_in %d, in0 %d, out %d, ws %zu); nothing launched\n", n_in, n_in > 0 ? in_sizes[0] : -1, out_size, ws_size); grid = -1; return; }
        int dev = 0, cus = 0, per_cu = 0;
        if (hipGetDevice(&dev) != hipSuccess || hipDeviceGetAttribute(&cus, hipDeviceAttributeMultiprocessorCount, dev) != hipSuccess) { grid = -1; return; }
        if (hipFuncSetAttribute((const void*)mega_fwd, hipFuncAttributeMaxDynamicSharedMemorySize, LDS_BYTES) != hipSuccess) { fprintf(stderr, "kernel_launch: hipFuncSetAttribute failed\n"); grid = -1; return; }
        if (hipOccupancyMaxActiveBlocksPerMultiprocessor(&per_cu, (const void*)mega_fwd, NWAVES * 64, LDS_BYTES) != hipSuccess || per_cu < 1) { fprintf(stderr, "kernel_launch: occupancy query reports %d\n", per_cu); }
        (void)hipGetLastError();
        grid = cus;
        if (grid != 256) fprintf(stderr, "kernel_launch: %d CUs (built for 256)\n", grid);
    }
    if (grid < 0) return;
    hipMemsetAsync((char*)d_ws + WS_CTL, 0, CTL_ZERO_BYTES, stream);
    Args a{};
    for (int i = 0; i < 30; ++i) a.in[i] = (const float*)d_in[i];
    a.out = (float*)d_out; a.ws = (unsigned char*)d_ws;
#if MK_N_LAUNCHES == 1
    a.ph_lo = 0; a.ph_hi = NPHASE;
    hipLaunchKernelGGL(mega_fwd, dim3(grid), dim3(NWAVES * 64), LDS_BYTES, stream, a);
#else
    for (int p = 0; p < NPHASE; ++p) { a.ph_lo = p; a.ph_hi = p + 1; hipLaunchKernelGGL(mega_fwd, dim3(grid), dim3(NWAVES * 64), LDS_BYTES, stream, a); }
#endif
}
```

```cpp
#include <hip/hip_runtime.h>
#include <hip/hip_bf16.h>
#include <cstdio>
#include <cstdint>
#include <cmath>
namespace pg8 {
#define PG8_LAS __attribute__((address_space(3)))
typedef unsigned short bf16_t;
typedef short bf16x8 __attribute__((ext_vector_type(8)));
typedef float f32x4 __attribute__((ext_vector_type(4)));
typedef unsigned u32x4 __attribute__((ext_vector_type(4)));
constexpr int BM = 256, BK = 64, HALF = 128, HTB = HALF * BK * 2  , STAGE_BYTES = 8 * HTB, NXCD = 8, WGM = 4;

__host__ __device__ __forceinline__ int lds_byte(int r, int c) { const int st = (r >> 4) * 2 + (c >> 5), rr = r & 15, cc = c & 31, ob = rr * 64 + cc * 2; return st * 1024 + (ob ^ (((ob >> 9) & 1) << 5)); }
__host__ __device__ __forceinline__ void stage_rc(int b, int& R, int& C) { const int st = b / 1024, sb = b % 1024, swz = sb ^ (((sb >> 9) & 1) << 5); R = (st >> 1) * 16 + swz / 64; C = (st & 1) * 32 + (swz % 64) / 2; }
__host__ __device__ __forceinline__ int perm32(int rho) { const int n = rho >> 4, i = rho & 15; return 8 * (i >> 2) + 4 * n + (i & 3); }

struct Unit { int pm, pn; };
struct Gemm { const bf16_t* A; const bf16_t* Bt; int lda, ldb, K; size_t bstepA, bstepB; int tmid = 0; };

struct StaticOrder {
    int nM, nN, nwg, G, c, rev, xr;
    __host__ __device__ void init(int M, int N, int G_, int c_, int rev_ = 0, int xr_ = 1) { nM = M / BM; nN = N / BM; nwg = nM * nN; G = G_; c = c_; rev = rev_; xr = xr_; }
    __host__ __device__ bool next(int i, Unit& u) const {
        if (rev) { if (i >= rev) return false; i = rev - 1 - i; }
        const long L = (long)i * G + c; if (L >= nwg) return false;
        int wgid = (int)L; if (xr) { const int q = nwg / NXCD, r = nwg % NXCD, xcd = wgid % NXCD, off = wgid / NXCD; wgid = (xcd < r ? xcd * (q + 1) : r * (q + 1) + (xcd - r) * q) + off; }
        const int nig = WGM * nN, gid = wgid / nig, fm = gid * WGM, gsz = (nM - fm) < WGM ? (nM - fm) : WGM;
        u.pm = fm + ((wgid % nig) % gsz); u.pn = (wgid % nig) / gsz; return true;
    }
};

typedef float f32x2_t __attribute__((ext_vector_type(2))); typedef __bf16 bf16x2_t __attribute__((ext_vector_type(2)));
__device__ __forceinline__ unsigned cvt_pk_bf16(float lo, float hi) { f32x2_t v = {lo, hi}; bf16x2_t b = __builtin_convertvector(v, bf16x2_t); return __builtin_bit_cast(unsigned, b); }
__device__ __forceinline__ float bf_lo(unsigned w) { return __uint_as_float(w << 16); }
__device__ __forceinline__ float bf_hi(unsigned w) { return __uint_as_float(w & 0xffff0000u); }
__device__ __forceinline__ float sigmoid_f(float x) { return __builtin_amdgcn_rcpf(1.0f + __builtin_amdgcn_exp2f(-1.4426950408889634f * x)); }

template <class Epi, class Sched, bool ALIGN_EPI = false>
__device__ __forceinline__ void gemm_phase(PG8_LAS unsigned char* lds, const Gemm g, const Sched& S, const Epi& E) {
    int tid_ = threadIdx.x; asm volatile("" : "+v"(tid_));
    const int tid = tid_, wid = __builtin_amdgcn_readfirstlane(tid >> 6), lane = tid & 63, wr = wid >> 2, wc = wid & 3, fr = lane & 15, fq = lane >> 4;
    const int K = g.K, nt = K / BK;
    unsigned voffA[2], voffB[2];
#pragma unroll
    for (int i = 0; i < 2; ++i) { int R, C; stage_rc(tid * 16 + i * 8192, R, C); const int Rb = Epi::PERM ? ((R & ~31) + perm32(R & 31)) : R;
        voffA[i] = (unsigned)(R * g.lda + C) * 2u; voffB[i] = (unsigned)(Rb * g.ldb + C) * 2u; }
    const size_t kstep = (size_t)(BK * 2);
    const size_t bstepA = g.bstepA, bstepB = g.bstepB;
    const size_t hstepA = (size_t)HALF * g.lda * 2, hstepB = (size_t)HALF * g.ldb * 2;
    const size_t tstepA = 2 * hstepA, tstepB = 2 * hstepB;
    const unsigned ldsw = (unsigned)wid * 1024u;
    const int aoff = lds_byte(wr * 64 + fr, fq * 8), boff = lds_byte(wc * 32 + fr, fq * 8);
#define PG8_SA(b, h) (((b) * 2 + (h)) * HTB)
#define PG8_SB(b, h) ((4 + (b) * 2 + (h)) * HTB)
#define PG8_STAGE(bufoff, gbase, voff) do { _Pragma("unroll") for (int _i = 0; _i < 2; ++_i) \
        __builtin_amdgcn_global_load_lds((const unsigned*)((const char*)(gbase) + (voff)[_i]), (PG8_LAS unsigned*)(lds + (bufoff) + ldsw + _i * 8192), 16, 0, 0); } while (0)
#define PG8_LDA(dst, b, h) do { _Pragma("unroll") for (int m = 0; m < 4; ++m) _Pragma("unroll") for (int k = 0; k < 2; ++k) dst[m][k] = *(const PG8_LAS bf16x8*)(lds + PG8_SA(b, h) + aoff + m * 2048 + k * 1024); } while (0)
#define PG8_LDB(dst, b, h) do { _Pragma("unroll") for (int n = 0; n < 2; ++n) _Pragma("unroll") for (int k = 0; k < 2; ++k) dst[n][k] = *(const PG8_LAS bf16x8*)(lds + PG8_SB(b, h) + boff + n * 2048 + k * 1024); } while (0)
#define PG8_MMA(ai, bj, At, Bt) do { __builtin_amdgcn_s_setprio(1); _Pragma("unroll") for (int m = 0; m < 4; ++m) _Pragma("unroll") for (int n = 0; n < 2; ++n) _Pragma("unroll") for (int k = 0; k < 2; ++k) \
        acc[ai][bj][m][n] = __builtin_amdgcn_mfma_f32_16x16x32_bf16(Bt[n][k], At[m][k], acc[ai][bj][m][n], 0, 0, 0); __builtin_amdgcn_s_setprio(0); } while (0)
#define PG8_WAIT_V(n) asm volatile("s_waitcnt vmcnt(" #n ")" ::: "memory")
#define PG8_WAIT_L(n) asm volatile("s_waitcnt lgkmcnt(" #n ")" ::: "memory")
#define PG8_BAR __builtin_amdgcn_s_barrier()
#define PG8_SCHED __builtin_amdgcn_sched_barrier(0)
    Unit cur, nxt; int ui = 0;
    if (!S.next(0, cur)) return;
    f32x4 acc[2][2][4][2];
#pragma unroll
    for (int a = 0; a < 2; ++a)
#pragma unroll
        for (int b = 0; b < 2; ++b)
#pragma unroll
            for (int m = 0; m < 4; ++m)
#pragma unroll
                for (int n = 0; n < 2; ++n) acc[a][b][m][n] = (f32x4){0.f, 0.f, 0.f, 0.f};
    bf16x8 At[4][2], B0[2][2], B1[2][2];
    unsigned gbk[Epi::MID ? 32 : 1];
    PG8_LAS float* const lrs = (PG8_LAS float*)(lds + STAGE_BYTES + 1024);
    const char* cA = (const char*)g.A + (size_t)cur.pm * tstepA; const char* cB = (const char*)g.Bt + (size_t)cur.pn * tstepB;
    PG8_STAGE(PG8_SB(0, 0), cB, voffB); PG8_STAGE(PG8_SB(0, 1), cB + hstepB, voffB); PG8_STAGE(PG8_SA(0, 0), cA, voffA); PG8_STAGE(PG8_SA(0, 1), cA + hstepA, voffA);
    if (wr == 1) PG8_BAR;
    PG8_WAIT_V(2); PG8_BAR;
    PG8_STAGE(PG8_SB(1, 0), cB + kstep, voffB); PG8_STAGE(PG8_SA(1, 0), cA + kstep, voffA); PG8_STAGE(PG8_SB(1, 1), cB + hstepB + kstep, voffB);
    PG8_WAIT_V(6); PG8_BAR;
    for (;;) {
        const bool has_next = S.next(ui + 1, nxt);
        const char* nA = has_next ? (const char*)g.A + (size_t)nxt.pm * tstepA : cA; const char* nB = has_next ? (const char*)g.Bt + (size_t)nxt.pn * tstepB : cB;
        const char* pA = cA; const char* pB = cB;
        if constexpr (Epi::RS) { E.unit_dma(cur, wid, lane, lrs + 512 + (ui & 1) * 256);
            if (wid == 0)
            __builtin_amdgcn_global_load_lds((const unsigned*)(E.rs + (size_t)cur.pm * BM + lane * 4), (PG8_LAS unsigned*)(lrs + (ui & 1) * 256), 16, 0, 0); }
        for (int t = 0; t < nt; t += 2) {
            const bool last = (t == nt - 2);
            if constexpr (Epi::MID) { if (t == (g.tmid ? g.tmid : (nt >> 1))) { if constexpr (Epi::RS) E.mid(acc, gbk, lrs + (ui & 1) * 256, cur, wr, wc, fr, fq); else E.mid(acc, gbk, cur, wr, wc, fr, fq); } }
            const char* a1 = pA + kstep;
            const char* a2 = last ? nA : pA + bstepA; const char* b2 = last ? nB : pB + bstepB;
            const char* a3 = a2 + kstep; const char* b3 = b2 + kstep;
            pA = a2; pB = b2;
            PG8_LDB(B0, 0, 0); PG8_LDB(B1, 0, 1); PG8_SCHED; PG8_LDA(At, 0, 0); PG8_STAGE(PG8_SA(1, 1), a1 + hstepA, voffA);
            PG8_WAIT_V(8); PG8_WAIT_L(0); PG8_BAR; PG8_MMA(0, 0, At, B0); PG8_MMA(0, 1, At, B1); PG8_BAR; PG8_SCHED;
            PG8_LDA(At, 0, 1); PG8_STAGE(PG8_SB(0, 0), b2, voffB); PG8_STAGE(PG8_SB(0, 1), b2 + hstepB, voffB); PG8_STAGE(PG8_SA(0, 0), a2, voffA);
            PG8_WAIT_V(8); PG8_WAIT_L(0); PG8_BAR; PG8_MMA(1, 0, At, B0); PG8_MMA(1, 1, At, B1); PG8_BAR; PG8_SCHED;
            PG8_LDB(B0, 1, 0); PG8_LDB(B1, 1, 1); PG8_SCHED; PG8_LDA(At, 1, 0); PG8_STAGE(PG8_SA(0, 1), a2 + hstepA, voffA);
            PG8_WAIT_V(8); PG8_WAIT_L(0); PG8_BAR; PG8_MMA(0, 0, At, B0); PG8_MMA(0, 1, At, B1); PG8_BAR; PG8_SCHED;
            PG8_LDA(At, 1, 1); PG8_STAGE(PG8_SB(1, 0), b3, voffB); PG8_STAGE(PG8_SB(1, 1), b3 + hstepB, voffB); PG8_STAGE(PG8_SA(1, 0), a3, voffA);
            PG8_WAIT_V(8); PG8_WAIT_L(0); PG8_BAR; PG8_MMA(1, 0, At, B0); PG8_MMA(1, 1, At, B1); PG8_BAR; PG8_SCHED;
        }
        if constexpr (ALIGN_EPI) { if (wr == 0) PG8_BAR; }
        if constexpr (Epi::RS && Epi::MID) E(acc, gbk, lrs + (ui & 1) * 256, cur, wr, wc, fr, fq); else if constexpr (Epi::RS) E(acc, lrs + (ui & 1) * 256, cur, wr, wc, fr, fq); else if constexpr (Epi::MID) E(acc, gbk, cur, wr, wc, fr, fq); else E(acc, cur, wr, wc, fr, fq);
#ifdef DUP_EPI
        if (DUP_EPI == Epi::ID) { asm volatile("" ::: "memory"); if constexpr (Epi::RS) E(acc, lrs + (ui & 1) * 256, cur, wr, wc, fr, fq); else E(acc, cur, wr, wc, fr, fq); }
#endif
        if (!has_next) break;
#pragma unroll
        for (int a = 0; a < 2; ++a)
#pragma unroll
            for (int b = 0; b < 2; ++b)
#pragma unroll
                for (int m = 0; m < 4; ++m)
#pragma unroll
                    for (int n = 0; n < 2; ++n) acc[a][b][m][n] = (f32x4){0.f, 0.f, 0.f, 0.f};
        cur = nxt; cA = nA; cB = nB; ++ui;
        if constexpr (ALIGN_EPI) { if (wr == 1) PG8_BAR; }
    }
    PG8_WAIT_V(0);
    if constexpr (!ALIGN_EPI) { if (wr == 0) PG8_BAR; }
    PG8_BAR;
#undef PG8_SA
#undef PG8_SB
#undef PG8_STAGE
#undef PG8_LDA
#undef PG8_LDB
#undef PG8_MMA
#undef PG8_WAIT_V
#undef PG8_WAIT_L
#undef PG8_BAR
#undef PG8_SCHED
}
}
namespace pg8 {
struct EpiBf16 {
    static constexpr bool RS = false; static constexpr int ID = 0; static constexpr bool PERM = true, MID = false;
    bf16_t* O; int ldc;
    __device__ __forceinline__ void operator()(const f32x4 (&acc)[2][2][4][2], const Unit& u, int wr, int wc, int fr, int fq) const {
        const int row0 = u.pm * BM + wr * 64 + fr, col0 = u.pn * BM + wc * 32 + 8 * fq;
#pragma unroll
        for (int ai = 0; ai < 2; ++ai)
#pragma unroll
            for (int m = 0; m < 4; ++m) { bf16_t* rowp = O + (size_t)(row0 + ai * HALF + m * 16) * ldc + col0;
#pragma unroll
                for (int bj = 0; bj < 2; ++bj) { const f32x4 v0 = acc[ai][bj][m][0], v1 = acc[ai][bj][m][1];
                    u32x4 w; w.x = cvt_pk_bf16(v0[0], v0[1]); w.y = cvt_pk_bf16(v0[2], v0[3]); w.z = cvt_pk_bf16(v1[0], v1[1]); w.w = cvt_pk_bf16(v1[2], v1[3]);
                    *(u32x4*)(rowp + bj * HALF) = w; } }
    }
};
struct EpiSwiGLU {
    static constexpr bool RS = true; static constexpr int ID = 1; static constexpr bool PERM = true, MID = false;
    const float* rs;
    bf16_t* O;
    __device__ __forceinline__ void unit_dma(const Unit&, int, int, PG8_LAS float*) const {}
    __device__ __forceinline__ void operator()(const f32x4 (&acc)[2][2][4][2], const PG8_LAS float* lrs, const Unit& u, int wr, int wc, int fr, int fq) const {
        const int row0 = u.pm * BM + wr * 64 + fr, col0 = wc * 32 + 8 * fq;
        bf16_t* Ob = O + (size_t)u.pn * ((size_t)4096 * HALF);
#pragma unroll
        for (int ai = 0; ai < 2; ++ai)
#pragma unroll
            for (int m = 0; m < 4; ++m) { bf16_t* rowp = Ob + (size_t)(row0 + ai * HALF + m * 16) * HALF + col0; const float r = lrs[ai * HALF + wr * 64 + m * 16 + fr];
                typedef float f32x2 __attribute__((ext_vector_type(2)));
                f32x2 h2[4];
#pragma unroll
                for (int n = 0; n < 2; ++n)
#pragma unroll
                    for (int e2 = 0; e2 < 2; ++e2) { const f32x2 a = (f32x2){acc[ai][0][m][n][2 * e2], acc[ai][0][m][n][2 * e2 + 1]} * r, b = (f32x2){acc[ai][1][m][n][2 * e2], acc[ai][1][m][n][2 * e2 + 1]} * r;
                        f32x2 ex; ex.x = __builtin_amdgcn_exp2f(a.x); ex.y = __builtin_amdgcn_exp2f(a.y);
                        const f32x2 d = ex + 1.0f; f32x2 r; r.x = __builtin_amdgcn_rcpf(d.x); r.y = __builtin_amdgcn_rcpf(d.y);
                        h2[n * 2 + e2] = (a * b) * r; }
                u32x4 w; w.x = cvt_pk_bf16(h2[0].x, h2[0].y); w.y = cvt_pk_bf16(h2[1].x, h2[1].y); w.z = cvt_pk_bf16(h2[2].x, h2[2].y); w.w = cvt_pk_bf16(h2[3].x, h2[3].y);
                *(u32x4*)rowp = w; }
    }
};
struct EpiWin {
    static constexpr bool RS = true; static constexpr int ID = 2; static constexpr bool PERM = true, MID = false;
    const float* rs;
    bf16_t* seg0; bf16_t* rho; bf16_t* gb; const float* bgate; float qscale; unsigned* nrm;
    __device__ __forceinline__ void unit_dma(const Unit& u, int wid, int lane, PG8_LAS float* dst) const {
        if (wid == 1 && u.pn >= 12) __builtin_amdgcn_global_load_lds((const unsigned*)(bgate + ((lane >> 5) ? 1024 : 0) + (u.pn - 12) * HALF + 4 * (lane & 31)), (PG8_LAS unsigned*)dst, 16, 0, 0); }
    __device__ __forceinline__ void operator()(const f32x4 (&acc_)[2][2][4][2], const PG8_LAS float* lrs, const Unit& u, int wr, int wc, int fr, int fq) const {
        const int pn = u.pn; const int row0 = u.pm * BM + wr * 64 + fr;
        f32x4 acc[2][2][4][2];
#pragma unroll
        for (int ai = 0; ai < 2; ++ai)
#pragma unroll
            for (int m = 0; m < 4; ++m) { const float r = lrs[ai * HALF + wr * 64 + m * 16 + fr];
#pragma unroll
                for (int bj = 0; bj < 2; ++bj) { acc[ai][bj][m][0] = acc_[ai][bj][m][0] * r; acc[ai][bj][m][1] = acc_[ai][bj][m][1] * r; } }
        if (pn >= 6 && pn < 10) {
            const float sc = (pn < 8) ? qscale : 1.0f;
#pragma unroll
            for (int bj = 0; bj < 2; ++bj) { float mx = 0.f;
#pragma unroll
                for (int ai = 0; ai < 2; ++ai)
#pragma unroll
                    for (int m = 0; m < 4; ++m) { const f32x4 a = acc[ai][bj][m][0] * sc, b = acc[ai][bj][m][1] * sc;
                        float q = (a[0] * a[0] + a[1] * a[1]) + (a[2] * a[2] + a[3] * a[3]) + (b[0] * b[0] + b[1] * b[1]) + (b[2] * b[2] + b[3] * b[3]);
                        q += __shfl_xor(q, 16); q += __shfl_xor(q, 32); mx = fmaxf(mx, q); }
                mx = fmaxf(mx, __shfl_xor(mx, 1)); mx = fmaxf(mx, __shfl_xor(mx, 2)); mx = fmaxf(mx, __shfl_xor(mx, 4)); mx = fmaxf(mx, __shfl_xor(mx, 8));
                if (fr == 0 && fq == 0) { const int fh = 4 * (pn & 1) + 2 * bj + (wc >> 1), b = u.pm >> 4;
                    atomicMax(nrm + ((b * 8 + fh) * 4 + ((pn >= 8) ? 2 : 0) + (wc & 1)), __float_as_uint(mx)); } }
        }
        typedef float f32x2 __attribute__((ext_vector_type(2)));
        if (pn < 12) {
            const int sg = pn >> 1; bf16_t* dst = seg0 + (size_t)sg * (size_t)(2u << 20);
            const int col0 = (pn & 1) * 256 + wc * 32 + 8 * fq;
            if (sg == 2) {
#pragma unroll
                for (int ai = 0; ai < 2; ++ai)
#pragma unroll
                    for (int m = 0; m < 4; ++m) { unsigned char* rowp = (unsigned char*)dst + (size_t)(row0 + ai * HALF + m * 16) * 512 + col0;
#pragma unroll
                        for (int bj = 0; bj < 2; ++bj) { unsigned w[2] = {0u, 0u};
#pragma unroll
                            for (int n = 0; n < 2; ++n)
#pragma unroll
                                for (int e = 0; e < 4; ++e) { const float g_ = __builtin_amdgcn_rcpf(1.0f + __builtin_amdgcn_exp2f(acc[ai][bj][m][n][e])); w[n] = __builtin_amdgcn_cvt_pk_u8_f32(g_ * 255.0f, (unsigned)e, w[n]); }
                            typedef unsigned u32x2_ __attribute__((ext_vector_type(2)));
                            *(u32x2_*)(rowp + bj * HALF) = (u32x2_){w[0], w[1]}; } }
            } else {
                const float sc = (sg == 3) ? qscale : 1.0f;
#pragma unroll
                for (int ai = 0; ai < 2; ++ai)
#pragma unroll
                    for (int m = 0; m < 4; ++m) { bf16_t* rowp = dst + (size_t)(row0 + ai * HALF + m * 16) * 512 + col0;
#pragma unroll
                        for (int bj = 0; bj < 2; ++bj) { const f32x4 v0 = acc[ai][bj][m][0] * sc, v1 = acc[ai][bj][m][1] * sc;
                            u32x4 w; w.x = cvt_pk_bf16(v0[0], v0[1]); w.y = cvt_pk_bf16(v0[2], v0[3]); w.z = cvt_pk_bf16(v1[0], v1[1]); w.w = cvt_pk_bf16(v1[2], v1[3]);
                            *(u32x4*)(rowp + bj * HALF) = w; } }
            }
        } else {
            const int col0 = (pn - 12) * HALF + wc * 32 + 8 * fq;
            f32x2 ba[4], bb[4]; const PG8_LAS float* lb = lrs + 512 + wc * 32 + 8 * fq;
#pragma unroll
            for (int q = 0; q < 4; ++q) { const f32x2 x = *(const PG8_LAS f32x2*)(lb + 2 * q), y = *(const PG8_LAS f32x2*)(lb + 128 + 2 * q); ba[q] = x * -1.4426950408889634f; bb[q] = y * -1.4426950408889634f; }
#pragma unroll
            for (int ai = 0; ai < 2; ++ai)
#pragma unroll
                for (int m = 0; m < 4; ++m) { const size_t off = (size_t)(row0 + ai * HALF + m * 16) * 1024 + col0;
                    unsigned wr_[4], wg_[4];
#pragma unroll
                    for (int q = 0; q < 4; ++q) { const int n = q >> 1, e = 2 * (q & 1);
                        const f32x2 a = __builtin_elementwise_min((f32x2){acc[ai][0][m][n][e], acc[ai][0][m][n][e + 1]} + ba[q], (f32x2){80.f, 80.f}), b = __builtin_elementwise_min((f32x2){acc[ai][1][m][n][e], acc[ai][1][m][n][e + 1]} + bb[q], (f32x2){80.f, 80.f});
                        f32x2 ea, eb; ea.x = __builtin_amdgcn_exp2f(a.x); ea.y = __builtin_amdgcn_exp2f(a.y); eb.x = __builtin_amdgcn_exp2f(b.x); eb.y = __builtin_amdgcn_exp2f(b.y);
                        const f32x2 da = ea + 1.0f, db = eb + 1.0f; f32x2 ra, rb; ra.x = __builtin_amdgcn_rcpf(da.x); ra.y = __builtin_amdgcn_rcpf(da.y); rb.x = __builtin_amdgcn_rcpf(db.x); rb.y = __builtin_amdgcn_rcpf(db.y);
                        unsigned w_ = __builtin_amdgcn_cvt_pk_u8_f32(ra.x * 255.0f, 0u, 0u); w_ = __builtin_amdgcn_cvt_pk_u8_f32(fmaxf(rb.x * 255.0f, 1.0f), 1u, w_);
                        w_ = __builtin_amdgcn_cvt_pk_u8_f32(ra.y * 255.0f, 2u, w_); w_ = __builtin_amdgcn_cvt_pk_u8_f32(fmaxf(rb.y * 255.0f, 1.0f), 3u, w_); wr_[q] = w_; (void)wg_; (void)db; }
                    *(u32x4*)(rho + off) = (u32x4){wr_[0], wr_[1], wr_[2], wr_[3]}; }
        }
    }
};
struct EpiMerge {
    static constexpr bool RS = false; static constexpr int ID = 3; static constexpr bool PERM = true, MID = true;
    bf16_t* O; const bf16_t* rho; const bf16_t* gb;
    __device__ __forceinline__ void mid(f32x4 (&acc)[2][2][4][2], unsigned (&gbk)[32], const Unit& u, int wr, int wc, int fr, int fq) const {
        asm volatile("" : "+v"(fr), "+v"(fq));
        const unsigned base = (unsigned)((u.pm * BM + wr * 64 + fr) * 1024 + u.pn * BM + wc * 32 + 8 * fq) * 2u;
        const char* rb = (const char*)rho;
#pragma unroll
        for (int ai = 0; ai < 2; ++ai) { u32x4 a[4][2];
#pragma unroll
            for (int m = 0; m < 4; ++m)
#pragma unroll
                for (int bj = 0; bj < 2; ++bj) a[m][bj] = *(const u32x4*)(rb + base + (unsigned)((ai * HALF + m * 16) * 1024) * 2u + bj * HALF * 2);
#pragma unroll
            for (int m = 0; m < 4; ++m)
#pragma unroll
                for (int bj = 0; bj < 2; ++bj) { const u32x4 w = a[m][bj]; const unsigned d4[4] = {w.x, w.y, w.z, w.w}; float rh[8];
#pragma unroll
                    for (int q = 0; q < 4; ++q) { const unsigned d = d4[q];
                        rh[2 * q] = (float)(d & 0xffu) * __builtin_amdgcn_rcpf((float)((d >> 8) & 0xffu)); rh[2 * q + 1] = (float)((d >> 16) & 0xffu) * __builtin_amdgcn_rcpf((float)(d >> 24)); }
                    acc[ai][bj][m][0] = acc[ai][bj][m][0] * (f32x4){rh[0], rh[1], rh[2], rh[3]};
                    acc[ai][bj][m][1] = acc[ai][bj][m][1] * (f32x4){rh[4], rh[5], rh[6], rh[7]};
                    gbk[((ai * 4 + m) * 2 + bj) * 2 + 0] = __builtin_amdgcn_perm(w.y, w.x, 0x07050301u);
                    gbk[((ai * 4 + m) * 2 + bj) * 2 + 1] = __builtin_amdgcn_perm(w.w, w.z, 0x07050301u); }
            asm volatile("" ::: "memory"); }
    }
    __device__ __forceinline__ void operator()(const f32x4 (&acc)[2][2][4][2], const unsigned (&gbk)[32], const Unit& u, int wr, int wc, int fr, int fq) const {
        asm volatile("" : "+v"(fr), "+v"(fq));
        const unsigned base = (unsigned)((u.pm * BM + wr * 64 + fr) * 1024 + u.pn * BM + wc * 32 + 8 * fq) * 2u;
        char* Ob = (char*)O; constexpr float S = 1.0f / 255.0f;
#pragma unroll
        for (int ai = 0; ai < 2; ++ai) {
#pragma unroll
            for (int m = 0; m < 4; ++m)
#pragma unroll
                for (int bj = 0; bj < 2; ++bj) { const unsigned g0 = gbk[((ai * 4 + m) * 2 + bj) * 2 + 0], g1 = gbk[((ai * 4 + m) * 2 + bj) * 2 + 1]; const f32x4 v0 = acc[ai][bj][m][0], v1 = acc[ai][bj][m][1];
                    u32x4 w; w.x = cvt_pk_bf16(v0[0] * ((float)(g0 & 0xffu) * S), v0[1] * ((float)((g0 >> 8) & 0xffu) * S)); w.y = cvt_pk_bf16(v0[2] * ((float)((g0 >> 16) & 0xffu) * S), v0[3] * ((float)(g0 >> 24) * S));
                    w.z = cvt_pk_bf16(v1[0] * ((float)(g1 & 0xffu) * S), v1[1] * ((float)((g1 >> 8) & 0xffu) * S)); w.w = cvt_pk_bf16(v1[2] * ((float)((g1 >> 16) & 0xffu) * S), v1[3] * ((float)(g1 >> 24) * S));
                    *(u32x4*)(Ob + base + (unsigned)((ai * HALF + m * 16) * 1024) * 2u + bj * HALF * 2) = w; }
            asm volatile("" ::: "memory"); }
    }
};
struct EpiPle2 {
    static constexpr bool RS = true; static constexpr int ID = 5; static constexpr bool PERM = true, MID = true;
    const float* rs; bf16_t* O; const float* bias;
    __device__ __forceinline__ void unit_dma(const Unit&, int, int, PG8_LAS float*) const {}
    __device__ __forceinline__ void mid(f32x4 (&acc)[2][2][4][2], unsigned (&gbk)[32], const PG8_LAS float* lrs, const Unit& u, int wr, int wc, int fr, int fq) const {
        asm volatile("" : "+v"(fq), "+v"(fr));
        const int col0 = u.pn * BM + wc * 32 + 8 * fq;
#pragma unroll
        for (int bj = 0; bj < 2; ++bj)
#pragma unroll
            for (int n = 0; n < 2; ++n) { const f32x4 bvv = *(const f32x4*)(bias + col0 + bj * HALF + 4 * n);
#pragma unroll
                for (int ai = 0; ai < 2; ++ai)
#pragma unroll
                    for (int m = 0; m < 4; ++m) { const float r = lrs[ai * HALF + wr * 64 + m * 16 + fr];
                        const f32x4 v = acc[ai][bj][m][n] * r + bvv; unsigned w = 0u;
#pragma unroll
                        for (int e = 0; e < 4; ++e) w = __builtin_amdgcn_cvt_pk_u8_f32(sigmoid_f(v[e]) * 255.0f, (unsigned)e, w);
                        gbk[((ai * 4 + m) * 2 + bj) * 2 + n] = w; acc[ai][bj][m][n] = (f32x4){0.f, 0.f, 0.f, 0.f}; }
                asm volatile("" ::: "memory"); }
    }
    __device__ __forceinline__ void operator()(const f32x4 (&acc)[2][2][4][2], const unsigned (&gbk)[32], const PG8_LAS float*, const Unit& u, int wr, int wc, int fr, int fq) const {
        asm volatile("" : "+v"(fr), "+v"(fq));
        const unsigned base = (unsigned)((u.pm * BM + wr * 64 + fr) * 1024 + u.pn * BM + wc * 32 + 8 * fq) * 2u;
        char* Ob = (char*)O; constexpr float S = 1.0f / 255.0f;
#pragma unroll
        for (int ai = 0; ai < 2; ++ai) {
#pragma unroll
            for (int m = 0; m < 4; ++m)
#pragma unroll
                for (int bj = 0; bj < 2; ++bj) { const unsigned g0 = gbk[((ai * 4 + m) * 2 + bj) * 2 + 0], g1 = gbk[((ai * 4 + m) * 2 + bj) * 2 + 1]; const f32x4 v0 = acc[ai][bj][m][0], v1 = acc[ai][bj][m][1];
                    u32x4 w; w.x = cvt_pk_bf16(v0[0] * ((float)(g0 & 0xffu) * S), v0[1] * ((float)((g0 >> 8) & 0xffu) * S)); w.y = cvt_pk_bf16(v0[2] * ((float)((g0 >> 16) & 0xffu) * S), v0[3] * ((float)(g0 >> 24) * S));
                    w.z = cvt_pk_bf16(v1[0] * ((float)(g1 & 0xffu) * S), v1[1] * ((float)((g1 >> 8) & 0xffu) * S)); w.w = cvt_pk_bf16(v1[2] * ((float)((g1 >> 16) & 0xffu) * S), v1[3] * ((float)(g1 >> 24) * S));
                    *(u32x4*)(Ob + base + (unsigned)((ai * HALF + m * 16) * 1024) * 2u + bj * HALF * 2) = w; }
            asm volatile("" ::: "memory"); }
    }
};
struct EpiPle {
    static constexpr bool RS = true; static constexpr int ID = 4; static constexpr bool PERM = true, MID = false;
    const float* rs; bf16_t* O; const bf16_t* emb; const float* bias;
    __device__ __forceinline__ void unit_dma(const Unit&, int, int, PG8_LAS float*) const {}
    __device__ __forceinline__ void operator()(const f32x4 (&acc)[2][2][4][2], const PG8_LAS float* lrs, const Unit& u, int wr, int wc, int fr, int fq) const {
        float pre[8];
#pragma unroll
        for (int q = 0; q < 8; ++q) pre[q] = lrs[(q >> 2) * HALF + wr * 64 + (q & 3) * 16 + fr];
        asm volatile("" : "+v"(fr), "+v"(fq));
        const int col0 = u.pn * BM + wc * 32 + 8 * fq;
        const unsigned base = (unsigned)((u.pm * BM + wr * 64 + fr) * 1024 + col0) * 2u;
        const char* eb = (const char*)emb; char* Ob = (char*)O;
        f32x4 bv[2][2];
#pragma unroll
        for (int bj = 0; bj < 2; ++bj)
#pragma unroll
            for (int n = 0; n < 2; ++n) bv[bj][n] = *(const f32x4*)(bias + col0 + bj * HALF + 4 * n);
#pragma unroll
        for (int ai = 0; ai < 2; ++ai) { u32x4 a[4][2];
#pragma unroll
            for (int m = 0; m < 4; ++m)
#pragma unroll
                for (int bj = 0; bj < 2; ++bj) a[m][bj] = *(const u32x4*)(eb + base + (unsigned)((ai * HALF + m * 16) * 1024) * 2u + bj * HALF * 2);
#pragma unroll
            for (int m = 0; m < 4; ++m)
#pragma unroll
                for (int bj = 0; bj < 2; ++bj) { const u32x4 b = a[m][bj]; const float r = pre[ai * 4 + m];
                    const f32x4 v0 = acc[ai][bj][m][0] * r + bv[bj][0], v1 = acc[ai][bj][m][1] * r + bv[bj][1];
                    u32x4 w; w.x = cvt_pk_bf16(sigmoid_f(v0[0]) * bf_lo(b.x), sigmoid_f(v0[1]) * bf_hi(b.x)); w.y = cvt_pk_bf16(sigmoid_f(v0[2]) * bf_lo(b.y), sigmoid_f(v0[3]) * bf_hi(b.y));
                    w.z = cvt_pk_bf16(sigmoid_f(v1[0]) * bf_lo(b.z), sigmoid_f(v1[1]) * bf_hi(b.z)); w.w = cvt_pk_bf16(sigmoid_f(v1[2]) * bf_lo(b.w), sigmoid_f(v1[3]) * bf_hi(b.w));
                    *(u32x4*)(Ob + base + (unsigned)((ai * HALF + m * 16) * 1024) * 2u + bj * HALF * 2) = w; }
            asm volatile("" ::: "memory"); }
    }
};
}
#ifndef FOX_CMMA
#define FOX_CMMA 1
#endif
#ifndef FOX_SREF
#define FOX_SREF 1
#endif
namespace fox_body {
#define FLAS __attribute__((address_space(3)))
using bf16=__hip_bfloat16;
using bf16x8=__attribute__((ext_vector_type(8)))short;
using s16x4=__attribute__((ext_vector_type(4)))short;
using f32x16=__attribute__((ext_vector_type(16)))float;
using u32x4=__attribute__((ext_vector_type(4)))unsigned;
constexpr int BATCH=8,NHEAD=8,SEQ=4096,D=64,DM=512,DMO=1024;
constexpr int NW=8,QBLK=32,QB=QBLK*NW,KVBLK=64,NQB=SEQ/QB;
__device__ __forceinline__ int crow(int r,int hi){return (r&3)+8*(r>>2)+4*hi;}
#define SBAR() __builtin_amdgcn_sched_barrier(0)
__device__ __forceinline__ void cmask(f32x16&p0,f32x16&p1,int jb,int qrel,int hi){
  const float NEG=-INFINITY; int kb=64*jb+4*hi;
  #pragma unroll
  for(int r=0;r<16;++r){int kv=kb+(r&3)+8*(r>>2); if(kv>qrel)p0[r]=NEG; if(kv+32>qrel)p1[r]=NEG;}
}

constexpr int NSLOT=3, SLOTB=8192;
constexpr int LDS_K=0, LDS_V=NSLOT*SLOTB, LDS_WS=2*NSLOT*SLOTB, LDS_OST=LDS_WS+NW*64*4, LDS_CS=LDS_OST+NW*4096, LDS_BYTES=LDS_CS+SEQ*4;
constexpr float C2=0.125f*1.4426950408889634f; typedef float f32x4 __attribute__((ext_vector_type(4)));
__device__ __forceinline__ void glds16(const void*gsrc,unsigned lds_dst){unsigned keep;
  asm volatile("s_mov_b32 %0, m0\n\ts_mov_b32 m0, %2\n\ts_nop 0\n\tglobal_load_lds_dwordx4 %1, off\n\ts_mov_b32 m0, %0":"=&s"(keep):"v"(gsrc),"s"(lds_dst):"memory");}
__device__ __forceinline__ float max3f(float a,float b,float c){float r;asm("v_max3_f32 %0, %1, %2, %3":"=v"(r):"v"(a),"v"(b),"v"(c));return r;}
__device__ __forceinline__ float max2f(float a,float b){float r;asm("v_max_f32_e32 %0, %1, %2":"=v"(r):"v"(a),"v"(b));return r;}
__device__ __forceinline__ float fadd_s(float a,float b){float r;asm("v_add_f32_e32 %0, %1, %2":"=v"(r):"v"(a),"v"(b));return r;}
__device__ __forceinline__ float fsub_s(float a,float b){float r;asm("v_sub_f32_e32 %0, %1, %2":"=v"(r):"v"(a),"v"(b));return r;}
typedef float f32x2_t __attribute__((ext_vector_type(2))); typedef __bf16 bf16x2_t __attribute__((ext_vector_type(2)));
__device__ __forceinline__ unsigned cvtpk_s(float lo,float hi){f32x2_t v={lo,hi};bf16x2_t b=__builtin_convertvector(v,bf16x2_t);return __builtin_bit_cast(unsigned,b);}
#define WAIT_BAR(N) asm volatile("s_waitcnt vmcnt(" #N ") lgkmcnt(0)\n\ts_barrier":::"memory")

__device__ __forceinline__ void qkt(f32x16&p0,f32x16&p1,const char*Kslot,const bf16x8*qr,int r32,int hi){
  const char*kb=Kslot+hi*1024+r32*16;
  #pragma unroll
  for(int d0=0;d0<4;++d0){
    const bf16x8 b0=*reinterpret_cast<const bf16x8*>(kb+d0*2048);
    const bf16x8 b1=*reinterpret_cast<const bf16x8*>(kb+d0*2048+512);
    p0=__builtin_amdgcn_mfma_f32_32x32x16_bf16(b0,qr[d0],p0,0,0,0);p1=__builtin_amdgcn_mfma_f32_32x32x16_bf16(b1,qr[d0],p1,0,0,0);}
}
typedef __attribute__((address_space(3))) const char* lds_cptr;
typedef short v4i16_t __attribute__((ext_vector_type(4)));
__device__ __forceinline__ void kload8(bf16x8*kf,lds_cptr kp){
  kf[0]=*(const __attribute__((address_space(3))) bf16x8*)(kp);      kf[1]=*(const __attribute__((address_space(3))) bf16x8*)(kp+512);
  kf[2]=*(const __attribute__((address_space(3))) bf16x8*)(kp+2048); kf[3]=*(const __attribute__((address_space(3))) bf16x8*)(kp+2560);
  kf[4]=*(const __attribute__((address_space(3))) bf16x8*)(kp+4096); kf[5]=*(const __attribute__((address_space(3))) bf16x8*)(kp+4608);
  kf[6]=*(const __attribute__((address_space(3))) bf16x8*)(kp+6144); kf[7]=*(const __attribute__((address_space(3))) bf16x8*)(kp+6656);
}
__device__ __forceinline__ void kload2(bf16x8*kf,lds_cptr kp,int j){ kf[2*j]=*(const __attribute__((address_space(3))) bf16x8*)(kp+j*2048); kf[2*j+1]=*(const __attribute__((address_space(3))) bf16x8*)(kp+j*2048+512); }
__device__ __forceinline__ s16x4 vtr(lds_cptr p){ return __builtin_bit_cast(s16x4,__builtin_amdgcn_ds_read_tr16_b64_v4i16((__attribute__((address_space(3))) v4i16_t*)p)); }
__device__ __forceinline__ float rowmax(const f32x16&p0,const f32x16&p1){
  float a=max3f(p0[0],p0[1],p1[0]),b=max3f(p0[2],p0[3],p1[1]);a=max3f(a,p1[2],p1[3]);
  #pragma unroll
  for(int r=4;r<16;r+=4){a=max3f(a,p0[r],p0[r+1]);b=max3f(b,p0[r+2],p0[r+3]);a=max3f(a,p1[r],p1[r+1]);b=max3f(b,p1[r+2],p1[r+3]);}
  const float m=max2f(a,b);
  auto rr=__builtin_amdgcn_permlane32_swap(__float_as_uint(m),__float_as_uint(m),false,false);
  return max2f(__uint_as_float(rr[0]),__uint_as_float(rr[1]));
}
__device__ __forceinline__ void pv(f32x16*o,int vb,bf16x8 pa0,bf16x8 pa1,bf16x8 pa2,bf16x8 pa3){
  #pragma unroll
  for(int d0=0;d0<2;++d0){s16x4 lo[4],hi[4];
    #pragma unroll
    for(int ks=0;ks<4;++ks){
      asm volatile("ds_read_b64_tr_b16 %0,%1 offset:%c2":"=&v"(lo[ks]):"v"(vb),"i"(d0*4096+ks*1024):"memory");
      asm volatile("ds_read_b64_tr_b16 %0,%1 offset:%c2":"=&v"(hi[ks]):"v"(vb),"i"(d0*4096+ks*1024+512):"memory");}
    asm volatile("s_waitcnt lgkmcnt(0)":::"memory");SBAR();
    #define PK(k) (bf16x8){lo[k][0],lo[k][1],lo[k][2],lo[k][3],hi[k][0],hi[k][1],hi[k][2],hi[k][3]}
    o[d0]=__builtin_amdgcn_mfma_f32_32x32x16_bf16(pa0,PK(0),o[d0],0,0,0);
    o[d0]=__builtin_amdgcn_mfma_f32_32x32x16_bf16(pa1,PK(1),o[d0],0,0,0);
    o[d0]=__builtin_amdgcn_mfma_f32_32x32x16_bf16(pa2,PK(2),o[d0],0,0,0);
    o[d0]=__builtin_amdgcn_mfma_f32_32x32x16_bf16(pa3,PK(3),o[d0],0,0,0);
    #undef PK
  }
}

__device__ __forceinline__ int fox_t0(const float*cs,int qb,float thr,int lane){ const int q0=qb*QB, nt_=(q0+QB)/KVBLK; const float c0_=cs[q0]; const float cv_=cs[(lane<nt_?lane:nt_-1)*KVBLK+KVBLK-1];
  const unsigned long long bm_=__ballot(lane<nt_ && (cv_-c0_)<=thr); int f_=bm_? (int)__builtin_ctzll(bm_):0; f_&=~1; return __builtin_amdgcn_readfirstlane(f_<nt_-4?f_:nt_-4); }
#ifndef ATTN_STORE16
#define ATTN_STORE16(p,v) (*(u32x4*)(p)=(v))
#endif
template<int THRL> __device__ __forceinline__ void attn_unit(int b,int h,int qb,const bf16*Q,const bf16*__restrict__ K,const bf16*__restrict__ V,bf16*O,int ocol,const float*cs,int t0,char*shm,float xbnd,bool pre,const bf16*nK,const bf16*nV){
  int tid_=threadIdx.x; asm volatile("":"+v"(tid_));
  const int tid=tid_,lane=tid&63,r32=lane&31,hi=lane>>5; const int wid=__builtin_amdgcn_readfirstlane(tid>>6);
  const long rowbase=(long)b*SEQ; const int q0=qb*QB;
  const bf16*Qw=Q+(rowbase+q0+wid*QBLK)*DM+h*D;
  const bf16*Kh=K+(rowbase+(long)t0*KVBLK)*DM+h*D,*Vh=V+(rowbase+(long)t0*KVBLK)*DM+h*D;
  const unsigned lds0=(unsigned)(uintptr_t)shm;
  float*wsf=(float*)(shm+LDS_WS)+wid*64;
  const bf16*ksrc=Kh+(long)lane*DM+wid*8;
  const bf16*vsrc=Vh+(long)(16*(wid&3)+(lane>>2))*DM+(wid>>2)*32+(lane&3)*8;
  const unsigned kdst=lds0+LDS_K+wid*1024, vdst=lds0+LDS_V+wid*1024;
  #define DMA_K(t,slot) glds16(ksrc+(long)(t)*KVBLK*DM,(unsigned)__builtin_amdgcn_readfirstlane(kdst+(slot)))
  #define DMA_V(t,slot) glds16(vsrc+(long)(t)*KVBLK*DM,(unsigned)__builtin_amdgcn_readfirstlane(vdst+(slot)))
  const int vb0=(int)(lds0+LDS_V)+((lane>>4)&1)*32+(lane&3)*8+(4*hi+((lane&15)>>2))*64;
  const char*Kbase=shm+LDS_K; bf16x8 kf[8];
  const lds_cptr shm3=(lds_cptr)shm; const lds_cptr kp0=shm3+LDS_K+hi*1024+r32*16; const lds_cptr vp0=shm3+LDS_V+((lane>>4)&1)*32+(lane&3)*8+(4*hi+((lane&15)>>2))*64;
  const int NT=(q0+QB)/KVBLK-t0;
  if(!pre){DMA_K(0,0);DMA_V(0,0);DMA_K(1,SLOTB);}
  bf16x8 qr[4];
  #pragma unroll
  for(int d0=0;d0<4;++d0)qr[d0]=*reinterpret_cast<const bf16x8*>(&Qw[(long)r32*DM+d0*16+hi*8]);
  constexpr bool CMMA=(FOX_SREF!=0)&&(FOX_CMMA!=0); const float csq0=CMMA?cs[q0]:0.f;
  bf16x8 konef,qxf;
  { typedef unsigned u4_ __attribute__((ext_vector_type(4))); u4_ ko_={0u,0u,0u,0u},qx_={0u,0u,0u,0u};
    if(CMMA){ const float R_=(cs[q0+wid*QBLK+r32]-csq0)-xbnd; const unsigned h_=__float_as_uint(R_)&0xffff0000u; const float r1_=R_-__uint_as_float(h_); const unsigned m_=__float_as_uint(r1_)&0xffff0000u;
      const float r2_=r1_-__uint_as_float(m_); const unsigned l_=__float_as_uint(r2_)&0xffff0000u;
      if(hi==0){ ko_[0]=0x3F803F80u; ko_[1]=0x00003F80u; qx_[0]=(h_>>16)|m_; qx_[1]=(l_>>16); } }
    konef=__builtin_bit_cast(bf16x8,ko_); qxf=__builtin_bit_cast(bf16x8,qx_); }
  { FLAS float*csw=(FLAS float*)((FLAS char*)shm+LDS_CS); for(int i=tid*4;i<q0+QB-t0*KVBLK;i+=NW*64*4){ f32x4 v=*(const f32x4*)(cs+t0*KVBLK+i); if(CMMA){ v=csq0-v; } *(FLAS f32x4*)(csw+i)=v; } }
  const FLAS float*csl=(const FLAS float*)((FLAS char*)shm+LDS_CS)+4*hi;
  float mhat=0.f,l_reg=0.f,nmh=0.f;f32x16 o[2];o[0]=f32x16{};o[1]=f32x16{};
  constexpr bool SREF=(FOX_SREF!=0);
  if(SREF){ mhat=xbnd-cs[q0+wid*QBLK+r32]; nmh=-mhat; }
  const int qrel=wid*QBLK+r32;
  #define CMASK(P0,P1,t) do{int jb_=(t)-(NT-4); if(jb_>=0)cmask(P0,P1,jb_,qrel,hi);}while(0)
  #define CINIT_SUB(P0,P1,t) do{ const FLAS float*cb_=csl+(t)*64; _Pragma("unroll") for(int g_=0;g_<4;++g_){ const f32x4 b0_=*(const FLAS f32x4*)(cb_+8*g_), b1_=*(const FLAS f32x4*)(cb_+32+8*g_); \
      { float q0_,q1_,q2_,q3_,q4_,q5_,q6_,q7_;   \
        asm("v_sub_f32 %0, %8, %9\n\tv_sub_f32 %1, %8, %10\n\tv_sub_f32 %2, %8, %11\n\tv_sub_f32 %3, %8, %12\n\tv_sub_f32 %4, %8, %13\n\tv_sub_f32 %5, %8, %14\n\tv_sub_f32 %6, %8, %15\n\tv_sub_f32 %7, %8, %16\n\ts_nop 1" \
            : "=&v"(q0_),"=&v"(q1_),"=&v"(q2_),"=&v"(q3_),"=&v"(q4_),"=&v"(q5_),"=&v"(q6_),"=&v"(q7_) : "v"(nmh),"v"(b0_[0]),"v"(b0_[1]),"v"(b0_[2]),"v"(b0_[3]),"v"(b1_[0]),"v"(b1_[1]),"v"(b1_[2]),"v"(b1_[3])); \
        P0[4*g_]=q0_; P0[4*g_+1]=q1_; P0[4*g_+2]=q2_; P0[4*g_+3]=q3_; P1[4*g_]=q4_; P1[4*g_+1]=q5_; P1[4*g_+2]=q6_; P1[4*g_+3]=q7_; } } }while(0)
  #define CINIT(P0,P1,t) do{ if(CMMA){ const FLAS float*cb_=csl+(t)*64; _Pragma("unroll") for(int g_=0;g_<4;++g_){ const f32x4 b0_=*(const FLAS f32x4*)(cb_+8*g_), b1_=*(const FLAS f32x4*)(cb_+32+8*g_); \
        P0[4*g_]=b0_[0]; P0[4*g_+1]=b0_[1]; P0[4*g_+2]=b0_[2]; P0[4*g_+3]=b0_[3]; P1[4*g_]=b1_[0]; P1[4*g_+1]=b1_[1]; P1[4*g_+2]=b1_[2]; P1[4*g_+3]=b1_[3]; } \
      P0=__builtin_amdgcn_mfma_f32_32x32x16_bf16(konef,qxf,P0,0,0,0); P1=__builtin_amdgcn_mfma_f32_32x32x16_bf16(konef,qxf,P1,0,0,0); } else CINIT_SUB(P0,P1,t); }while(0)
  bool resc=false;
  #define START(P0,P1) do{ resc=false; \
    if(!SREF){ const float rm=rowmax(P0,P1); const float dl=rm; mhat=fadd_s(mhat,dl); \
      _Pragma("unroll") for(int r=0;r<16;++r){P0[r]=fsub_s(P0[r],dl);P1[r]=fsub_s(P1[r],dl);} \
      nmh=-mhat; } \
    _Pragma("unroll") for(int r=0;r<16;++r)P0[r]=__builtin_amdgcn_exp2f(P0[r]); }while(0)
  #define RESC() do{ if(resc){ asm volatile("s_waitcnt lgkmcnt(0)":::"memory"); \
      _Pragma("unroll") for(int d_=0;d_<2;++d_) _Pragma("unroll") for(int r=0;r<16;++r)o[d_][r]*=wsf[crow(r,hi)]; } }while(0)
  f32x16 pA0,pA1,pB0,pB1;
  int sl_prev=0,sl_cur=0,sl_next=SLOTB;
  #define ROT() do{sl_prev=sl_cur;sl_cur=sl_next;sl_next=(sl_next==(NSLOT-1)*SLOTB)?0:sl_next+SLOTB;}while(0)
  DMA_K(2,2*SLOTB);
  WAIT_BAR(3);
  CINIT(pA0,pA1,0); qkt(pA0,pA1,Kbase,qr,r32,hi);asm volatile("s_nop 15\n\ts_nop 7":"+v"(pA0),"+v"(pA1));CMASK(pA0,pA1,0);
  START(pA0,pA1);
  _Pragma("unroll") for(int r=0;r<16;++r)pA1[r]=__builtin_amdgcn_exp2f(pA1[r]);
  WAIT_BAR(0);
  DMA_K(3,0);DMA_V(1,SLOTB);
  ROT();
  kload8(kf,kp0+sl_cur);
  WAIT_BAR(2);
  s16x4 vlo[8],vhi[8]; u32x4 pw0,pw1,pw2,pw3;
  #define PKW(P,B) cvtpk_s(P[B],P[B+1])
  #define PAF(k) __builtin_bit_cast(bf16x8,pw##k)
  #define VFR(i) (bf16x8){vlo[i][0],vlo[i][1],vlo[i][2],vlo[i][3],vhi[i][0],vhi[i][1],vhi[i][2],vhi[i][3]}
  #define PIN(x) asm volatile("":"+v"(x))
  #define MX3(a,b,c) __builtin_fmaxf(__builtin_fmaxf((a),(b)),(c))
  #define GAPA(MF,A0,A1,A2,A3,W0,W1,PW) do{ MF; sacc+=A0; sacc+=A1; sacc+=A2; sacc+=A3; PIN(sacc); W0; W1; PIN(PW); SBAR(); }while(0)
  #define EX(v) __builtin_amdgcn_exp2f(v)
  #define GAPB(MF,X,B) do{ MF; X[B]=EX(X[B]); X[B+1]=EX(X[B+1]); X[B+2]=EX(X[B+2]); X[B+3]=EX(X[B+3]); PIN(X); SBAR(); }while(0)
  #define VRD(i) do{ vlo[i]=vtr(vp_+(((i)>>2)*4096+((i)&3)*1024)); vhi[i]=vtr(vp_+(((i)>>2)*4096+((i)&3)*1024+512)); }while(0)
  #define KRD(G,j) do{ if(G){ kload2(kf,kp0+sl_next,j); SBAR(); } }while(0)
  #define STEP(C0,C1,P0,P1,t,GK,GV,GL) do{ SBAR(); CINIT(C0,C1,t); SBAR(); \
    const lds_cptr vp_=vp0+sl_prev; \
    VRD(0); SBAR(); float sacc=(P0[0]+P0[1]); \
    GAPA(C0=__builtin_amdgcn_mfma_f32_32x32x16_bf16(kf[0],qr[0],C0,0,0,0), P0[2],P0[3],P0[4],P0[5],     pw0[0]=PKW(P0,0), pw0[1]=PKW(P0,2), pw0); \
    VRD(4); SBAR(); GAPA(C1=__builtin_amdgcn_mfma_f32_32x32x16_bf16(kf[1],qr[0],C1,0,0,0), P0[6],P0[7],P0[8],P0[9],     pw0[2]=PKW(P0,4), pw0[3]=PKW(P0,6), pw0); \
    VRD(1); SBAR(); GAPA(C0=__builtin_amdgcn_mfma_f32_32x32x16_bf16(kf[2],qr[1],C0,0,0,0),   P0[10],P0[11],P0[12],P0[13], pw1[0]=PKW(P0,8), pw1[1]=PKW(P0,10), pw1); \
    VRD(5); SBAR(); GAPA(C1=__builtin_amdgcn_mfma_f32_32x32x16_bf16(kf[3],qr[1],C1,0,0,0),   P0[14],P0[15],P1[0],P1[1],   pw1[2]=PKW(P0,12),pw1[3]=PKW(P0,14), pw1); \
    VRD(2); SBAR(); GAPA(C0=__builtin_amdgcn_mfma_f32_32x32x16_bf16(kf[4],qr[2],C0,0,0,0),   P1[2],P1[3],P1[4],P1[5],     pw2[0]=PKW(P1,0), pw2[1]=PKW(P1,2), pw2); \
    VRD(6); SBAR(); GAPA(C1=__builtin_amdgcn_mfma_f32_32x32x16_bf16(kf[5],qr[2],C1,0,0,0),   P1[6],P1[7],P1[8],P1[9],     pw2[2]=PKW(P1,4), pw2[3]=PKW(P1,6), pw2); \
    VRD(3); SBAR(); GAPA(C0=__builtin_amdgcn_mfma_f32_32x32x16_bf16(kf[6],qr[3],C0,0,0,0),   P1[10],P1[11],P1[12],P1[13], pw3[0]=PKW(P1,8), pw3[1]=PKW(P1,10), pw3); \
    VRD(7); SBAR(); GAPA(C1=__builtin_amdgcn_mfma_f32_32x32x16_bf16(kf[7],qr[3],C1,0,0,0),   P1[14],P1[15],0.f,0.f,       pw3[2]=PKW(P1,12),pw3[3]=PKW(P1,14), pw3); \
    l_reg+=sacc; \
    if(GK){DMA_K((t)+3,sl_cur);} if(GV){DMA_V((t)+1,sl_next);} \
    CMASK(C0,C1,t); \
    { float a=MX3(C0[0],C0[1],C1[0]),b=MX3(C0[2],C0[3],C1[1]); a=MX3(a,C1[2],C1[3]); \
      _Pragma("unroll") for(int r=4;r<16;r+=4){a=MX3(a,C0[r],C0[r+1]);b=MX3(b,C0[r+2],C0[r+3]);a=MX3(a,C1[r],C1[r+1]);b=MX3(b,C1[r+2],C1[r+3]);} \
      float rm=__builtin_fmaxf(a,b); { auto rr=__builtin_amdgcn_permlane32_swap(__float_as_uint(rm),__float_as_uint(rm),false,false); rm=__builtin_fmaxf(__uint_as_float(rr[0]),__uint_as_float(rr[1])); } \
      resc=false; \
      if(!SREF && __builtin_expect(__any(rm>(float)THRL),0)){ const float dl=__builtin_fmaxf(rm,0.f); mhat+=dl; \
        _Pragma("unroll") for(int r=0;r<16;++r){C0[r]-=dl;C1[r]-=dl;} \
        nmh=-mhat; \
        const float f=__builtin_amdgcn_exp2f(-dl); l_reg*=f; if(hi==0)wsf[r32]=f; resc=true; } } \
    SBAR(); \
    GAPB(o[0]=__builtin_amdgcn_mfma_f32_32x32x16_bf16(PAF(0),VFR(0),o[0],0,0,0), C0,0); \
    GAPB(o[1]=__builtin_amdgcn_mfma_f32_32x32x16_bf16(PAF(0),VFR(4),o[1],0,0,0), C0,4); \
    KRD(GL,0); GAPB(o[0]=__builtin_amdgcn_mfma_f32_32x32x16_bf16(PAF(1),VFR(1),o[0],0,0,0), C0,8); \
    KRD(GL,1); GAPB(o[1]=__builtin_amdgcn_mfma_f32_32x32x16_bf16(PAF(1),VFR(5),o[1],0,0,0), C0,12); \
    KRD(GL,2); GAPB(o[0]=__builtin_amdgcn_mfma_f32_32x32x16_bf16(PAF(2),VFR(2),o[0],0,0,0), C1,0); \
    KRD(GL,3); GAPB(o[1]=__builtin_amdgcn_mfma_f32_32x32x16_bf16(PAF(2),VFR(6),o[1],0,0,0), C1,4); \
    GAPB(o[0]=__builtin_amdgcn_mfma_f32_32x32x16_bf16(PAF(3),VFR(3),o[0],0,0,0), C1,8); \
    GAPB(o[1]=__builtin_amdgcn_mfma_f32_32x32x16_bf16(PAF(3),VFR(7),o[1],0,0,0), C1,12); \
    }while(0)
  int t=1;
  #undef CMASK
  #define CMASK(P0,P1,t) do{}while(0)
  for(;t+5<NT;t+=2){
    STEP(pB0,pB1,pA0,pA1,t,true,true,true);     WAIT_BAR(2); RESC(); ROT();
    STEP(pA0,pA1,pB0,pB1,t+1,true,true,true);   WAIT_BAR(2); RESC(); ROT();
  }
  #undef CMASK
  #define CMASK(P0,P1,t) do{int jb_=(t)-(NT-4); if(jb_>=0)cmask(P0,P1,jb_,qrel,hi);}while(0)
  #define ENDW(tt) do{ if((tt)+3<NT){WAIT_BAR(2);} else if((tt)+2<NT){WAIT_BAR(1);} else {WAIT_BAR(0);} }while(0)
  for(;t+1<NT;t+=2){
    STEP(pB0,pB1,pA0,pA1,t,(t+3<NT),(t+1<NT),(t+1<NT));       ENDW(t);   RESC(); ROT();
    STEP(pA0,pA1,pB0,pB1,t+1,(t+4<NT),(t+2<NT),(t+2<NT));     ENDW(t+1); RESC(); ROT();
  }
  STEP(pB0,pB1,pA0,pA1,NT-1,false,false,false); RESC();
  { float sacc=pB0[0]+pB0[1]; _Pragma("unroll") for(int r=2;r<16;++r)sacc+=pB0[r]; _Pragma("unroll") for(int r=0;r<16;++r)sacc+=pB1[r]; l_reg+=sacc;
    pw0=(u32x4){PKW(pB0,0),PKW(pB0,2),PKW(pB0,4),PKW(pB0,6)};pw1=(u32x4){PKW(pB0,8),PKW(pB0,10),PKW(pB0,12),PKW(pB0,14)};pw2=(u32x4){PKW(pB1,0),PKW(pB1,2),PKW(pB1,4),PKW(pB1,6)};pw3=(u32x4){PKW(pB1,8),PKW(pB1,10),PKW(pB1,12),PKW(pB1,14)};
    SBAR(); pv(o,vb0+sl_cur,PAF(0),PAF(1),PAF(2),PAF(3)); }
  #undef PKW
  #undef PAF
  #undef VFR
  #undef PIN
  #undef MX3
  #undef GAPA
  #undef GAPB
  #undef EX
  #undef VRD
  #undef KRD
  #undef STEP
  #undef ENDW
  if(nK){ asm volatile("s_waitcnt lgkmcnt(0)\n\ts_barrier":::"memory");
    const bf16*nks=nK+(long)lane*DM+wid*8; const bf16*nvs=nV+(long)(16*(wid&3)+(lane>>2))*DM+(wid>>2)*32+(lane&3)*8;
    glds16(nks,(unsigned)__builtin_amdgcn_readfirstlane(kdst)); glds16(nvs,(unsigned)__builtin_amdgcn_readfirstlane(vdst)); glds16(nks+(long)KVBLK*DM,(unsigned)__builtin_amdgcn_readfirstlane(kdst+SLOTB)); }
  {auto rr=__builtin_amdgcn_permlane32_swap(__float_as_uint(l_reg),__float_as_uint(l_reg),false,false);l_reg=__uint_as_float(rr[0])+__uint_as_float(rr[1]);}
  if(hi==0)wsf[32+r32]=l_reg;asm volatile("s_waitcnt lgkmcnt(0)":::"memory");
  float rli[16];
  #pragma unroll
  for(int r=0;r<16;++r)rli[r]=__builtin_amdgcn_rcpf(wsf[32+crow(r,hi)]);
  bf16*Ow=O+(rowbase+q0+wid*QBLK)*DMO+ocol;
  { bf16*stg=(bf16*)(shm+LDS_OST)+wid*2048;
    #pragma unroll
    for(int r=0;r<16;++r){const int orow=crow(r,hi);
      #pragma unroll
      for(int d0=0;d0<2;++d0)stg[orow*64+d0*32+r32]=__float2bfloat16(o[d0][r]*rli[r]);}
    asm volatile("s_waitcnt lgkmcnt(0)":::"memory");
    #pragma unroll
    for(int i=0;i<4;++i){const int row=i*8+(lane>>3),ch=lane&7; const u32x4 v=*(const u32x4*)(stg+row*64+ch*8); ATTN_STORE16(Ow+(long)row*DMO+ch*8,v);} }
  asm volatile("s_waitcnt lgkmcnt(0)\n\ts_barrier":::"memory");
  #undef DMA_K
  #undef DMA_V
  #undef CMASK
  #undef CINIT
  #undef CINIT_SUB
  #undef START
  #undef RESC
  #undef ROT
}
constexpr int ATTN_LDS_BYTES=LDS_BYTES;
#undef SBAR
#undef WAIT_BAR
#undef FLAS
}
constexpr int NWAVES = 8;
constexpr int NTEAM = 8, BATCH = 1, SEQ = 4096, DM = 1024, DFF = 2816, TOK = BATCH * SEQ, TOKALL = NTEAM * SEQ;
constexpr int NWIN = 5120;
constexpr int MH = 4, MDK = 64, MDV = 128, FH = 8, FD = 64, CH = 64, NCH = SEQ / CH;
constexpr float EPS = 1e-6f;
constexpr float LOG2E = 1.4426950408889634f;
constexpr float QC2 = 0.125f * LOG2E;

constexpr size_t MiB = 1u << 20;
constexpr size_t WS_CTL = 0, CTL_ZERO_BYTES = 65536;
constexpr size_t AMiB = MiB / 8;
constexpr size_t WS_TEAM0 = 54 * MiB, WS_TEAM_STRIDE = 458 * AMiB;
constexpr size_t WS_W1GU = 2 * MiB;
constexpr size_t WS_W1D = 13 * MiB;
constexpr size_t WS_W2GU = 19 * MiB;
constexpr size_t WS_W2D = 30 * MiB;
constexpr size_t WS_WIN = 36 * MiB;
constexpr size_t WS_WAB = 47 * MiB;
constexpr size_t WS_WOUT = 49 * MiB;
constexpr size_t WS_WPG = 51 * MiB;
constexpr int PLE_LD = DM + 256;
constexpr size_t WS_WPP = 53 * MiB;
constexpr size_t WS_GATES = 0 * AMiB;
constexpr size_t WS_MA = 2 * AMiB;
constexpr size_t WS_MB = 2 * AMiB + 64 * 1024;
constexpr size_t WS_MSC = 3 * AMiB;
constexpr size_t WS_MDN = 3 * AMiB + 32 * 1024;
constexpr size_t WS_FCS = 4 * AMiB;
constexpr size_t WS_FCT = 5 * AMiB;
constexpr size_t WS_RMS = 6 * AMiB;
constexpr size_t WS_XN = 10 * AMiB;
constexpr size_t WS_Y = 74 * AMiB;
constexpr size_t WS_R = 138 * AMiB;
constexpr size_t WS_H = WS_R;
constexpr size_t WS_PB = WS_R + 176 * AMiB;
constexpr size_t WS_EMB = WS_R + 192 * AMiB;
constexpr size_t WS_SEG0 = WS_R;
constexpr size_t WS_GA = WS_R + 192 * AMiB, WS_GB = WS_R + 256 * AMiB;
constexpr size_t WS_QK = WS_Y;
constexpr size_t WS_CST = WS_Y + 32 * AMiB;
constexpr size_t WS_END = 512 * MiB;
constexpr int CW_TMO = 0, CW_CODE = 1, CW_DBG = 64, CW_XOK = 128, CW_BAR = 4096;
constexpr int CW_TEAM0 = 8192, CW_TEAM_STRIDE = 512;
constexpr int CW_NRM = 0, CW_M3Q = 64, CW_TBC = 128, CW_TBG = 192;
static_assert((CW_BAR + 3456) <= CW_TEAM0 && (CW_TEAM0 + NTEAM * CW_TEAM_STRIDE) * 4 <= (int)CTL_ZERO_BYTES, "control words inside the per-call memset");

constexpr int RING_OFF = 0, RING_BYTES = 131072;
constexpr int LDSCTL_OFF = RING_BYTES, MISC_OFF = LDSCTL_OFF + 320;
constexpr int LDS_BYTES = 147456;

#define GAS __attribute__((address_space(1)))
#define LAS __attribute__((address_space(3)))
typedef unsigned short bf16;
typedef unsigned v4u __attribute__((ext_vector_type(4)));
typedef unsigned v2u __attribute__((ext_vector_type(2)));
typedef float f32x4 __attribute__((ext_vector_type(4)));
typedef short bf16x8 __attribute__((ext_vector_type(8)));
typedef GAS unsigned gu32;
#define RLX_AGENT __ATOMIC_RELAXED, __HIP_MEMORY_SCOPE_AGENT
#define LDS_WAIT() asm volatile("s_waitcnt lgkmcnt(0)" ::: "memory")
#define VM_WAIT() asm volatile("s_waitcnt vmcnt(0)" ::: "memory")
#ifndef HW_CVT
#define HW_CVT 1
#endif
#if HW_CVT
__device__ __forceinline__ unsigned pk2(float lo, float hi) { return pg8::cvt_pk_bf16(lo, hi); }
__device__ __forceinline__ unsigned f2bf(float f) { return pg8::cvt_pk_bf16(f, f) & 0xffffu; }
#else
__device__ __forceinline__ unsigned f2bf(float f) { unsigned u = __builtin_bit_cast(unsigned, f); return (u + 0x7fffu + ((u >> 16) & 1u)) >> 16; }
__device__ __forceinline__ unsigned pk2(float lo, float hi) { return f2bf(lo) | (f2bf(hi) << 16); }
#endif
__device__ __forceinline__ float bf2f(unsigned short h) { return __uint_as_float(((unsigned)h) << 16); }

#define XB_TMO      128
#define XB_XCNT(j)  (256  + 64 * (j))
#define XB_XSUB(j)  (1280 + 64 * (j))
#define XB_XGEN(j)  (2304 + 64 * (j))
#define XB_TOP      3328
#define XB_TOPGEN   3392
#define XCD_BAR_WORDS 3456
#define XB_SPIN_CAP (1u << 20)
__device__ __forceinline__ unsigned xb_ld(unsigned* p)              { return __hip_atomic_load(p, __ATOMIC_RELAXED, __HIP_MEMORY_SCOPE_AGENT); }
__device__ __forceinline__ unsigned xb_add(unsigned* p, unsigned v) { return __hip_atomic_fetch_add(p, v, __ATOMIC_RELAXED, __HIP_MEMORY_SCOPE_AGENT); }
__device__ __forceinline__ unsigned xb_xcc_id() { return (unsigned)__builtin_amdgcn_s_getreg((3 << 11) | 20) & 0xFu; }
#define XB_SPIN(cond, bar) do { unsigned _sp = 0; while (cond) { __builtin_amdgcn_s_sleep(1); \
    if ((++_sp & 255u) == 0u) { if (xb_ld(&(bar)[XB_TMO])) break; if (_sp > XB_SPIN_CAP) { atomicAdd(&(bar)[XB_TMO], 1u); break; } } } } while (0)
struct XcdBarrier { unsigned* bar; unsigned x; volatile LAS unsigned* st; };
__device__ __forceinline__ XcdBarrier xcd_barrier_post(unsigned* bar, volatile LAS unsigned* st) {
    XcdBarrier b; b.bar = bar; b.x = xb_xcc_id(); b.st = st;
    if (threadIdx.x == 0) (void)xb_add(&bar[XB_XCNT(b.x)], 1u);
    return b;
}
__device__ __forceinline__ void xcd_barrier_complete(unsigned* bar, unsigned x, unsigned& nloc, unsigned& nx) {
    const unsigned G = gridDim.x * gridDim.y * gridDim.z;
    unsigned sum, cnt, mine, sp = 0u;
    for (;;) {
        sum = 0u; cnt = 0u; mine = 0u;
#pragma unroll
        for (unsigned j = 0; j < 16; ++j) { const unsigned c = xb_ld(&bar[XB_XCNT(j)]); sum += c; cnt += (c > 0u) ? 1u : 0u; mine = (j == x) ? c : mine; }
        if (sum == G) break;
        __builtin_amdgcn_s_sleep(1);
        if ((++sp & 255u) == 0u) { if (xb_ld(&bar[XB_TMO])) break; if (sp > XB_SPIN_CAP) { atomicAdd(&bar[XB_TMO], 1u); break; } }
    }
    nloc = mine > 0u ? mine : 1u; nx = cnt > 0u ? cnt : 1u;
}
__device__ __forceinline__ void xcd_barrier(const XcdBarrier& b) {
    asm volatile("s_waitcnt vmcnt(0)" ::: "memory");
    __syncthreads();
    if (threadIdx.x == 0) {
        unsigned* bar = b.bar;
        __builtin_amdgcn_s_waitcnt(0);
        unsigned nloc = b.st[0], nx = b.st[1];
        if (nloc == 0u) { xcd_barrier_complete(bar, b.x, nloc, nx); b.st[0] = nloc; b.st[1] = nx; }
        const unsigned old = xb_add(&bar[XB_XSUB(b.x)], 1u);
        const unsigned gen = old / nloc;
        if (old + 1u == (gen + 1u) * nloc) {
            __builtin_amdgcn_fence(__ATOMIC_RELEASE, "agent");
            asm volatile("s_waitcnt vmcnt(0)" ::: "memory");
            const unsigned og = xb_add(&bar[XB_TOP], 1u);
            const unsigned tg = og / nx;
            if (og + 1u == (tg + 1u) * nx) xb_add(&bar[XB_TOPGEN], 1u);
            else XB_SPIN(xb_ld(&bar[XB_TOPGEN]) == tg, bar);
            __builtin_amdgcn_fence(__ATOMIC_ACQUIRE, "agent");
            xb_add(&bar[XB_XGEN(b.x)], 1u);
            asm volatile("s_waitcnt vmcnt(0)" ::: "memory");
        } else {
            XB_SPIN(xb_ld(&bar[XB_XGEN(b.x)]) == gen, bar);
            __builtin_amdgcn_fence(__ATOMIC_ACQUIRE, "agent");
            asm volatile("s_waitcnt vmcnt(0)" ::: "memory");
        }
    }
    __syncthreads();
}

__device__ __forceinline__ void team_barrier(unsigned* tctl, unsigned* gbar, unsigned nmem, int fast, unsigned& k) {
    asm volatile("s_waitcnt vmcnt(0)" ::: "memory");
    __syncthreads();
    k += 1u;
    if (threadIdx.x == 0) {
        __builtin_amdgcn_s_waitcnt(0);
        if (fast) {
            asm volatile("buffer_inv sc1" ::: "memory");
            __hip_atomic_fetch_add(&tctl[CW_TBC], 1u, __ATOMIC_RELAXED, __HIP_MEMORY_SCOPE_AGENT);
            XB_SPIN(xb_ld(&tctl[CW_TBC]) < k * nmem, gbar);
            asm volatile("s_waitcnt vmcnt(0)" ::: "memory");
        } else {
            __builtin_amdgcn_fence(__ATOMIC_RELEASE, "agent"); asm volatile("s_waitcnt vmcnt(0)" ::: "memory");
            __hip_atomic_fetch_add(&tctl[CW_TBC], 1u, __ATOMIC_RELAXED, __HIP_MEMORY_SCOPE_AGENT);
            XB_SPIN(xb_ld(&tctl[CW_TBC]) < k * nmem, gbar);
            __builtin_amdgcn_fence(__ATOMIC_ACQUIRE, "agent");
            asm volatile("s_waitcnt vmcnt(0)" ::: "memory");
        }
    }
    __syncthreads();
}

struct Args { const float* in[30]; float* out; unsigned char* ws; int ph_lo, ph_hi; };
static_assert(sizeof(Args) == 32 * 8 + 8, "Args has no padding");
struct Frame {
    LAS unsigned char* lds;
    volatile LAS unsigned* MISC;
    gu32* ctl;
    gu32* gctl;
    int vcu, G;
    int dupi;
    int gv, GG, team, fast;
    unsigned char* ws;
    unsigned char* wg;
    const Args* A;
    const float* x; const float* p;
    float* out;
};
struct Tc { int tid, lane, wave; };
__device__ __forceinline__ Tc get_tc() { int t = threadIdx.x; asm volatile("" : "+v"(t)); Tc c; c.tid = t; c.lane = t & 63; c.wave = __builtin_amdgcn_readfirstlane(t >> 6); return c; }
template <int CTRL, int ROWMASK = 0xF> __device__ __forceinline__ float dppf(float old, float v) { return __int_as_float(__builtin_amdgcn_update_dpp(__float_as_int(old), __float_as_int(v), CTRL, ROWMASK, 0xF, false)); }
constexpr int DPP_XOR1 = 0xB1, DPP_XOR2 = 0x4E, DPP_HMIRROR = 0x141, DPP_MIRROR = 0x140, DPP_BCAST15 = 0x142, DPP_BCAST31 = 0x143;
__device__ __forceinline__ float rl(float v, int l) { return __int_as_float(__builtin_amdgcn_readlane(__float_as_int(v), l)); }
__device__ __forceinline__ float wave_sum(float v) {
    v += dppf<DPP_XOR1>(v, v); v += dppf<DPP_XOR2>(v, v); v += dppf<DPP_HMIRROR>(v, v); v += dppf<DPP_MIRROR>(v, v);
    return (rl(v, 0) + rl(v, 16)) + (rl(v, 32) + rl(v, 48));
}
__device__ __forceinline__ float wave_max(float v) {
    v = fmaxf(v, dppf<DPP_XOR1>(v, v)); v = fmaxf(v, dppf<DPP_XOR2>(v, v)); v = fmaxf(v, dppf<DPP_HMIRROR>(v, v)); v = fmaxf(v, dppf<DPP_MIRROR>(v, v));
    return fmaxf(fmaxf(rl(v, 0), rl(v, 16)), fmaxf(rl(v, 32), rl(v, 48)));
}
__device__ __forceinline__ float half_sum(float v) { const auto rr = __builtin_amdgcn_permlane32_swap(__float_as_uint(v), __float_as_uint(v), false, false); return __uint_as_float(rr[0]) + __uint_as_float(rr[1]); }

constexpr int ER = 4;
__device__ __forceinline__ void bf8_to_f32(const v4u w, f32x4& a, f32x4& b) {
    a.x = __uint_as_float(w.x << 16); a.y = __uint_as_float(w.x & 0xffff0000u); a.z = __uint_as_float(w.y << 16); a.w = __uint_as_float(w.y & 0xffff0000u);
    b.x = __uint_as_float(w.z << 16); b.y = __uint_as_float(w.z & 0xffff0000u); b.z = __uint_as_float(w.w << 16); b.w = __uint_as_float(w.w & 0xffff0000u); }
__device__ __forceinline__ v4u f32_to_bf8(const f32x4 a, const f32x4 b) { v4u w; w.x = pk2(a.x, a.y); w.y = pk2(a.z, a.w); w.z = pk2(b.x, b.y); w.w = pk2(b.z, b.w); return w; }
__device__ __forceinline__ float sumsq8(const f32x4 a, const f32x4 b) { return ((a.x * a.x + a.y * a.y) + (a.z * a.z + a.w * a.w)) + ((b.x * b.x + b.y * b.y) + (b.z * b.z + b.w * b.w)); }
__device__ __forceinline__ void xpose_item(const float* W, const float* gk, float wsc, int Nsrc, int k0, int srccol, int srcvec, bf16* WT, int ldd, int drow0, int dcol0, LAS float* scr, int lane) {
    if (srcvec >= 0) {
        f32x4 t[8];
#pragma unroll
        for (int i = 0; i < 8; ++i) t[i] = *(const f32x4*)(W + (size_t)(k0 + 8 * i + (lane >> 3)) * Nsrc + srcvec + 4 * (lane & 7));
#pragma unroll
        for (int i = 0; i < 8; ++i) { LAS float* d = scr + (8 * i + (lane >> 3)) * 33 + 4 * (lane & 7); const float wv = gk ? wsc * gk[k0 + 8 * i + (lane >> 3)] : wsc; d[0] = t[i].x * wv; d[1] = t[i].y * wv; d[2] = t[i].z * wv; d[3] = t[i].w * wv; }
    } else {
#pragma unroll 8
        for (int i = 0; i < 32; ++i) { const int kk = 2 * i + (lane >> 5); const float wv = gk ? wsc * gk[k0 + kk] : wsc; scr[kk * 33 + (lane & 31)] = (srccol >= 0) ? W[(size_t)(k0 + kk) * Nsrc + srccol] * wv : 0.f; }
    }
    LDS_WAIT(); asm volatile("" ::: "memory");
    const int c = lane & 7;
#pragma unroll
    for (int j = 0; j < 4; ++j) { const int n = (lane >> 3) + 8 * j; const LAS float* s = scr + (8 * c) * 33 + n;
        v4u o; o.x = pk2(s[0 * 33], s[1 * 33]); o.y = pk2(s[2 * 33], s[3 * 33]); o.z = pk2(s[4 * 33], s[5 * 33]); o.w = pk2(s[6 * 33], s[7 * 33]);
        *(GAS v4u*)(WT + (size_t)(drow0 + n) * ldd + dcol0 + 8 * c) = o; }
    LDS_WAIT(); asm volatile("" ::: "memory");
}
__device__ __forceinline__ void rms_row_to_bf16(int lane, const float* xrow, const float* g, bf16* orow) {
    const GAS f32x4* xr = (const GAS f32x4*)xrow + lane; const GAS f32x4* gr = (const GAS f32x4*)g + lane;
    f32x4 v[4]; float s = 0.f;
#pragma unroll
    for (int j = 0; j < 4; ++j) { v[j] = xr[64 * j]; s += (v[j].x * v[j].x + v[j].y * v[j].y) + (v[j].z * v[j].z + v[j].w * v[j].w); }
    const float r = 1.f / sqrtf(wave_sum(s) * (1.f / DM) + EPS);
    GAS v2u* o8 = (GAS v2u*)orow + lane;
#pragma unroll
    for (int j = 0; j < 4; ++j) { const f32x4 gg = gr[64 * j]; v2u w; w.x = pk2(v[j].x * r * gg.x, v[j].y * r * gg.y); w.y = pk2(v[j].z * r * gg.z, v[j].w * r * gg.w); o8[64 * j] = w; }
}
__device__ __forceinline__ void p0_prologue(Frame& F) {
    const Tc tc = get_tc();
    LAS float* scr = (LAS float*)(F.lds + RING_OFF + tc.wave * 16384);
    const int gw = F.vcu * NWAVES + tc.wave, NGW = F.G * NWAVES; const int lane = tc.lane, l31 = lane & 31;
    const int gwg = tc.wave * F.GG + F.gv, NGWG = F.GG * NWAVES;
    unsigned char* ws = F.wg;
    constexpr int I0 = 2816, I1 = 1408, I4 = 2688, I5 = 256, I6 = 512, I8 = 128;
    constexpr int NITEMS = 2 * (I0 + I1) + I4 + 2 * I5 + 2 * I6 + I8;
    for (int it = gwg; it < NITEMS; it += NGWG) {
        int r = it;
        if (r < 2 * (I0 + I1)) {
            const int l2 = r >= (I0 + I1); if (l2) r -= (I0 + I1);
            if (r < I0) {
                const int kb = r / 176, g = r % 176, j = g >> 3, sub = g & 7;
                const float* W = l2 ? ((sub >> 2) ? F.A->in[22] : F.A->in[21]) : ((sub >> 2) ? F.A->in[4] : F.A->in[3]);
                xpose_item(W, l2 ? F.A->in[20] : F.A->in[2], (sub >> 2) ? -0.6931471805599453f : -LOG2E, DFF, 64 * kb,
                           128 * j + 32 * (sub & 3) + l31, 128 * j + 32 * (sub & 3), (bf16*)(ws + (l2 ? WS_W2GU : WS_W1GU)), DM, 32 * g, 64 * kb, scr, lane);
            } else { r -= I0;
                const int kb = r / 32, g = r % 32;
                xpose_item(l2 ? F.A->in[23] : F.A->in[5], nullptr, 1.0f, DM, 64 * kb, 32 * g + l31, 32 * g, (bf16*)(ws + (l2 ? WS_W2D : WS_W1D)) + (size_t)(kb >> 1) * (DM * 128), 128, 32 * g, 64 * (kb & 1), scr, lane);
            }
            continue;
        }
        r -= 2 * (I0 + I1);
        if (r < I4) {
            const int kb = r / 168, g = r % 168, r0 = 32 * g; int sc;
            if (r0 < 1536) sc = r0 + l31; else if (r0 < 3072) sc = r0 + 8 + l31;
            else if (r0 < 5120) { const int tj = (r0 - 3072) >> 8, wi = (r0 - 3072) & 255; sc = ((wi < 128) ? 3088 + 128 * tj + wi : 4112 + 128 * tj + (wi - 128)) + l31; }
            else if (r0 == 5120) sc = (l31 < 8) ? 1536 + l31 : (l31 < 16) ? 3080 + (l31 - 8) : -1; else sc = -1;
            const int sv = (r0 < 5120) ? sc - l31 : -1;
            const float wsc = ((r0 >= 1024 && r0 < 1536) || (r0 >= 3072 && r0 < 5120)) ? -LOG2E : 1.0f;
            xpose_item(F.A->in[8], F.A->in[7], wsc, 5136, 64 * kb, sc, sv, (bf16*)(ws + WS_WIN), DM, r0, 64 * kb, scr, lane);
            continue;
        }
        r -= I4;
        if (r < 2 * I5) { const int hb = r >= I5; if (hb) r -= I5; const int kb = r / 32, g = r % 32;
            xpose_item(hb ? F.A->in[17] : F.A->in[16], nullptr, 1.0f, DM, 64 * kb, 32 * g + l31, 32 * g, (bf16*)(ws + WS_WAB), DM, 32 * g, 512 * hb + 64 * kb, scr, lane); continue; }
        r -= 2 * I5;
        if (r < 2 * I6) { const int hb = r >= I6; if (hb) r -= I6; const int kb = r / 32, g = r % 32;
            xpose_item(hb ? F.A->in[26] : F.A->in[18], hb ? F.A->in[25] : nullptr, 1.0f,     DM, 64 * kb, 32 * g + l31, 32 * g, (bf16*)(ws + (hb ? WS_WPG : WS_WOUT)), hb ? PLE_LD : DM, 32 * g, 64 * kb, scr, lane); continue; }
        r -= 2 * I6;
        { const int kb = r / 32, g = r % 32;
            xpose_item(F.A->in[28], nullptr, 1.0f, DM, 64 * kb, 32 * g + l31, 32 * g, (bf16*)(ws + WS_WPG), PLE_LD, 32 * g, DM + 64 * kb, scr, lane); }
    }
    ws = F.ws;
    bf16* XN = (bf16*)(ws + WS_XN);
    {
        for (int m0 = gw; m0 < TOK; m0 += ER * NGW) {
            f32x4 v[ER][2][2]; float sq[ER];
#pragma unroll
            for (int i = 0; i < ER; ++i) { const int m = (m0 + i * NGW < TOK) ? m0 + i * NGW : m0; const float* xr = F.x + (size_t)m * DM + 8 * lane;
#pragma unroll
                for (int j = 0; j < 2; ++j) { v[i][j][0] = *(const f32x4*)(xr + 512 * j); v[i][j][1] = *(const f32x4*)(xr + 512 * j + 4); } }
#pragma unroll
            for (int i = 0; i < ER; ++i) sq[i] = sumsq8(v[i][0][0], v[i][0][1]) + sumsq8(v[i][1][0], v[i][1][1]);
#pragma unroll
            for (int i = 0; i < ER; ++i) sq[i] = wave_sum(sq[i]);
#pragma unroll
            for (int i = 0; i < ER; ++i) if (m0 + i * NGW < TOK) { bf16* orow = XN + (size_t)(m0 + i * NGW) * DM + 8 * lane;
                if (lane == 0) ((float*)(ws + WS_RMS))[m0 + i * NGW] = 1.f / sqrtf(sq[i] * (1.f / DM) + EPS);
#pragma unroll
                for (int j = 0; j < 2; ++j) *(v4u*)(orow + 512 * j) = f32_to_bf8(v[i][j][0], v[i][j][1]); }
        }
    }
}

constexpr int EB = 2;
template <int XNM, bool GATES, int RIN, bool ROUT16>
__device__ __forceinline__ void ew_phase(Frame& F, const bf16* Y, const void* res, void* out, float coef, const float* gpost, const float* gpre, bf16* XN, const float* gin = nullptr, const float* rms = nullptr, float* rsout = nullptr, int rpitch = DM * 2, int opitch = DM * 2) {
    constexpr bool RIN16 = (RIN != 0); constexpr bool HAS_XN = (XNM == 1);
    const Tc tc = get_tc(); const int lane = tc.lane;
    const int gw = F.vcu * NWAVES + tc.wave, NGW = F.G * NWAVES;
    const int nbat = (TOK / EB - gw + NGW - 1) / NGW;
    v4u ywA[EB][2], ywB[EB][2]; v4u rwA[EB][2], rwB[EB][2]; f32x4 r3A[EB][2][2], r3B[EB][2][2]; float rmA[EB], rmB[EB];
    constexpr int WGP = 1032;
    if constexpr (GATES) {
        LAS bf16* LWG = (LAS bf16*)F.lds;
        for (int i = tc.tid; i < 16 * 128; i += NWAVES * 64) { const int r = i >> 7, c8 = (i & 127) * 8;
            *(LAS v4u*)(LWG + r * WGP + c8) = *(const v4u*)((const bf16*)(F.wg + WS_WIN) + (size_t)(5120 + r) * DM + c8); }
        LDS_WAIT(); __syncthreads();
    }
#ifndef EW_DESC
#define EW_DESC 1
#endif
#ifndef EW_DEPTH
#define EW_DEPTH 2
#endif
#define EW_ROW0(it) (EB * (gw + (EW_DESC ? (nbat - 1 - (it)) : (it)) * NGW))
#define EW_LOADS(it, yw, rw16, rw32, rmv) do { unsigned l16_ = (unsigned)lane * 16u; asm volatile("" : "+v"(l16_)); const int mb_ = EW_ROW0(it); \
        _Pragma("unroll") for (int i = 0; i < EB; ++i) { const char* yb_ = (const char*)Y + (size_t)(mb_ + i) * (DM * 2); \
            if constexpr (RIN == 2) rmv[i] = rms[mb_ + i]; \
            if constexpr (RIN16) { const char* rb_ = (const char*)res + (size_t)(mb_ + i) * rpitch; \
                _Pragma("unroll") for (int j = 0; j < 2; ++j) { yw[i][j] = *(const v4u*)(yb_ + l16_ + 1024 * j); rw16[i][j] = *(const v4u*)(rb_ + l16_ + 1024 * j); } } \
            else { const char* rb_ = (const char*)res + (size_t)(mb_ + i) * (DM * 4); \
                _Pragma("unroll") for (int j = 0; j < 2; ++j) { yw[i][j] = *(const v4u*)(yb_ + l16_ + 1024 * j); rw32[i][j][0] = *(const f32x4*)(rb_ + 2 * l16_ + 2048 * j); rw32[i][j][1] = *(const f32x4*)(rb_ + 2 * l16_ + 2048 * j + 16); } } } } while (0)
    f32x4 g1[2][2], g2[2][2], gi[2][2];
    { const unsigned lg = (unsigned)lane * 32u;
#pragma unroll
      for (int j = 0; j < 2; ++j)
#pragma unroll
        for (int q = 0; q < 2; ++q) { g1[j][q] = *(const f32x4*)((const char*)gpost + lg + 2048 * j + 16 * q);
            if constexpr (XNM == 1) g2[j][q] = *(const f32x4*)((const char*)gpre + lg + 2048 * j + 16 * q);
            if constexpr (RIN == 2) { const f32x4 g = *(const f32x4*)((const char*)gin + lg + 2048 * j + 16 * q); gi[j][q] = (f32x4){__builtin_amdgcn_rcpf(g.x), __builtin_amdgcn_rcpf(g.y), __builtin_amdgcn_rcpf(g.z), __builtin_amdgcn_rcpf(g.w)}; } } }
    auto body = [&](const int it, v4u (&yw)[EB][2], v4u (&rw16)[EB][2], f32x4 (&rw32)[EB][2][2], float (&rmv)[EB]) {
        const int m0 = EW_ROW0(it);
        unsigned l16 = (unsigned)lane * 16u; asm volatile("" : "+v"(l16));
        f32x4 y[EB][2][2], h[EB][2][2]; float s[EB], s2[EB];
#pragma unroll
        for (int i = 0; i < EB; ++i) { s[i] = 0.f;
#pragma unroll
            for (int j = 0; j < 2; ++j) { bf8_to_f32(yw[i][j], y[i][j][0], y[i][j][1]);
                if constexpr (RIN16) bf8_to_f32(rw16[i][j], h[i][j][0], h[i][j][1]); else { h[i][j][0] = rw32[i][j][0]; h[i][j][1] = rw32[i][j][1]; }
                if constexpr (RIN == 2) { h[i][j][0] = h[i][j][0] * rmv[i] * gi[j][0]; h[i][j][1] = h[i][j][1] * rmv[i] * gi[j][1]; }
                s[i] += sumsq8(y[i][j][0], y[i][j][1]); } }
        asm volatile("" ::: "memory");
        if (it + EW_DEPTH < nbat) EW_LOADS(it + EW_DEPTH, yw, rw16, rw32, rmv);
#pragma unroll
        for (int i = 0; i < EB; ++i) s[i] = wave_sum(s[i]);
#pragma unroll
        for (int i = 0; i < EB; ++i) { const float r = coef / sqrtf(s[i] * (1.f / DM) + EPS); s2[i] = 0.f;
#pragma unroll
            for (int j = 0; j < 2; ++j) { h[i][j][0] = h[i][j][0] + y[i][j][0] * r * g1[j][0]; h[i][j][1] = h[i][j][1] + y[i][j][1] * r * g1[j][1]; s2[i] += sumsq8(h[i][j][0], h[i][j][1]); }
            if constexpr (ROUT16) { char* ob = (char*)out + (size_t)(m0 + i) * opitch;
#pragma unroll
                for (int j = 0; j < 2; ++j) *(v4u*)(ob + l16 + 1024 * j) = f32_to_bf8(h[i][j][0], h[i][j][1]);
            } else { char* ob = (char*)out + (size_t)(m0 + i) * (DM * 4);
#pragma unroll
                for (int j = 0; j < 2; ++j) { *(f32x4*)(ob + 2 * l16 + 2048 * j) = h[i][j][0]; *(f32x4*)(ob + 2 * l16 + 2048 * j + 16) = h[i][j][1]; } } }
        if constexpr (XNM == 2) {
#pragma unroll
            for (int i = 0; i < EB; ++i) s2[i] = wave_sum(s2[i]);
            if (lane == 0) {
#pragma unroll
                for (int i = 0; i < EB; ++i) rsout[m0 + i] = 1.f / sqrtf(s2[i] * (1.f / DM) + EPS); }
        }
        if constexpr (HAS_XN) {
#pragma unroll
            for (int i = 0; i < EB; ++i) s2[i] = wave_sum(s2[i]);
#pragma unroll
            for (int i = 0; i < EB; ++i) { const float r2 = 1.f / sqrtf(s2[i] * (1.f / DM) + EPS);
                char* xb = (char*)XN + (size_t)(m0 + i) * (DM * 2);
#pragma unroll
                for (int j = 0; j < 2; ++j) *(v4u*)(xb + l16 + 1024 * j) = f32_to_bf8(h[i][j][0] * r2 * g2[j][0], h[i][j][1] * r2 * g2[j][1]); }
        }
        if constexpr (GATES) { if ((it & 7) == 7 || it + 1 == nbat) {
            const int it0 = it & ~7;
            VM_WAIT();
            int ln = lane; asm volatile("" : "+v"(ln));
            const int qa = ln & 15; int ita = it0 + (qa >> 1); ita = ita < nbat ? ita : it0;
            const bf16* arow = (const bf16*)out + (size_t)(EW_ROW0(ita) + (qa & 1)) * DM + 8 * (ln >> 4);
            const LAS bf16* brow = (const LAS bf16*)F.lds + (ln & 15) * WGP + 8 * (ln >> 4);
            f32x4 acc = {0.f, 0.f, 0.f, 0.f};
#pragma unroll 16
            for (int kk = 0; kk < 32; ++kk) { const bf16x8 a = *(const bf16x8*)(arow + 32 * kk), b = *(const LAS bf16x8*)(brow + 32 * kk);
                acc = __builtin_amdgcn_mfma_f32_16x16x32_bf16(a, b, acc, 0, 0, 0); }
            const int n = ln & 15; const float* bp = (n < 4) ? F.A->in[11] + n : (n < 8) ? F.A->in[12] + (n - 4) : F.A->in[14] + (n - 8); const float bias = *bp;
#pragma unroll
            for (int r = 0; r < 4; ++r) { const int q = 4 * (ln >> 4) + r, itq = it0 + (q >> 1);
                if (itq < nbat) { const int grow = EW_ROW0(itq) + (q & 1); ((float*)(F.ws + WS_GATES))[(size_t)grow * 16 + n] = acc[r] * rsout[grow] + bias; } }
        } }
    };
    if (nbat > 0) EW_LOADS(0, ywA, rwA, r3A, rmA);
    if (EW_DEPTH == 2) { if (nbat > 1) EW_LOADS(1, ywB, rwB, r3B, rmB);
#pragma unroll 1
        for (int it = 0; it < nbat; it += 2) { body(it, ywA, rwA, r3A, rmA); if (it + 1 < nbat) body(it + 1, ywB, rwB, r3B, rmB); }
    } else {
#pragma unroll 1
        for (int it = 0; it < nbat; ++it) body(it, ywA, rwA, r3A, rmA); }
#undef EW_ROW0
#undef EW_LOADS
}
#ifndef M1_SWZ
#define M1_SWZ 1
#endif
#ifndef M1_SKIP
#define M1_SKIP 0
#endif
#ifndef M1_STAGE
#define M1_STAGE 1
#endif
typedef float f32x16 __attribute__((ext_vector_type(16)));
#define MFMA32(a, b, c) __builtin_amdgcn_mfma_f32_32x32x16_bf16(a, b, c, 0, 0, 0)
__device__ __forceinline__ int crow16(int r, int hi) { return (r & 3) + 8 * (r >> 2) + 4 * hi; }
#ifndef FAST_LSIG
#define FAST_LSIG 1
#endif
__device__ __forceinline__ float log_sigmoid_f(float x) { return FAST_LSIG ? fminf(x, 0.f) - __logf(1.0f + __expf(-fabsf(x))) : fminf(x, 0.f) - log1pf(expf(-fabsf(x))); }
__device__ __forceinline__ float wave_incl_scan_add(float v, int) {
    v += dppf<0x111>(0.f, v); v += dppf<0x112>(0.f, v); v += dppf<0x114>(0.f, v); v += dppf<0x118>(0.f, v);
    v += dppf<DPP_BCAST15, 0xA>(0.f, v); v += dppf<DPP_BCAST31, 0xC>(0.f, v);
    return v;
}
__device__ __forceinline__ float wave_incl_scan_max(float v, int) {
    v = fmaxf(v, dppf<0x111>(v, v)); v = fmaxf(v, dppf<0x112>(v, v)); v = fmaxf(v, dppf<0x114>(v, v)); v = fmaxf(v, dppf<0x118>(v, v));
    v = fmaxf(v, dppf<DPP_BCAST15, 0xA>(v, v)); v = fmaxf(v, dppf<DPP_BCAST31, 0xC>(v, v));
    return v;
}
__device__ __forceinline__ int swap23(int s) { return (s & ~12) | ((s & 4) << 1) | ((s & 8) >> 1); }
constexpr int LP = 72;

struct M1In { v4u xq[4], xk[4]; v4u v0, v1; float g0, g1; };
__device__ __forceinline__ void m1_load(Frame& F, int u, M1In& R) {
    const Tc tc = get_tc(); const int tid = tc.tid, lane = tc.lane, wave = tc.wave;
    const int h = u & 3, c = (u >> 2) & 63, b = u >> 8, tok0 = b * SEQ + c * CH, tt = tid >> 3, cg = tid & 7;
    unsigned char* ws = F.ws;
    const bf16* mqk = (const bf16*)(ws + WS_SEG0);
#pragma unroll
    for (int j = 0; j < 4; ++j) { const int ts = c * CH + tt - 3 + j;
        R.xq[j] = (v4u){0u, 0u, 0u, 0u}; R.xk[j] = (v4u){0u, 0u, 0u, 0u};
        if (ts >= 0 && (j == 3 || (tt & 7) < 3 - j)) { const bf16* rp = mqk + (size_t)(b * SEQ + ts) * 512 + 64 * h + 8 * cg; R.xq[j] = *(const v4u*)rp; R.xk[j] = *(const v4u*)(rp + 256); } }
    const bf16* mv = (const bf16*)(ws + WS_SEG0 + 32 * AMiB) + (size_t)(tok0 + tt) * 512 + 128 * h + 16 * cg;
    R.v0 = *(const v4u*)mv; R.v1 = *(const v4u*)(mv + 8);
    const float* gr = (const float*)(ws + WS_GATES) + (size_t)(tok0 + lane) * 16;
    R.g0 = 0.f; R.g1 = 0.f;
    if (wave == 0) { R.g0 = gr[h]; R.g1 = gr[4 + h]; } else if (wave <= 2) { R.g0 = gr[8 + 2 * h + (wave - 1)]; }
}
__device__ __forceinline__ void m1_phase(Frame& F) {
    constexpr int NU = BATCH * NCH * MH;
    int u = F.vcu; if (u >= NU) return;
    unsigned char* ws = F.ws; LAS unsigned char* L = F.lds;
    LAS bf16* LKT = (LAS bf16*)(L);
    LAS bf16* LVT = (LAS bf16*)(L + 64 * LP * 2);
    LAS float* LW = (LAS float*)(L + 64 * LP * 2 + 128 * LP * 2);
    LAS bf16* LDC = (LAS bf16*)(L + 32768);
    int uprev = -1;
#define M1_FLUSH(ui_) do { const int row_ = tid >> 2, q_ = tid & 3; const v4u a_ = *(const LAS v4u*)(LDC + row_ * LP + 16 * q_), b_ = *(const LAS v4u*)(LDC + row_ * LP + 16 * q_ + 8); \
        bf16* d_ = (bf16*)(ws + WS_CST) + (size_t)(ui_) * (MDV * MDK) + row_ * MDK + 16 * q_; *(v4u*)d_ = a_; *(v4u*)(d_ + 8) = b_; } while (0)
    M1In R; m1_load(F, u, R);
    f32x4 cwv[2][4][2]; f32x4 cbv[2][2]; int hcur = -1;
#pragma unroll 1
    for (; u < NU; u += F.G) {
        const Tc tc = get_tc(); const int tid = tc.tid, lane = tc.lane, wave = tc.wave;
        const int h = u & 3, c = (u >> 2) & 63, b = u >> 8, tok0 = b * SEQ + c * CH, uidx = (b * MH + h) * NCH + c, tt = tid >> 3, cg = tid & 7;
        if (h != hcur) { hcur = h; const float* cw = F.A->in[9]; const float* cb = F.A->in[10];
#pragma unroll
            for (int part = 0; part < 2; ++part) { const int ch0 = part * 256 + 64 * h + 8 * cg; cbv[part][0] = *(const f32x4*)(cb + ch0); cbv[part][1] = *(const f32x4*)(cb + ch0 + 4);
#pragma unroll
                for (int j = 0; j < 4; ++j) { cwv[part][j][0] = *(const f32x4*)(cw + j * 512 + ch0); cwv[part][j][1] = *(const f32x4*)(cw + j * 512 + ch0 + 4); } } }
        if (wave == 0) {
            const float ig = R.g0, lf = log_sigmoid_f(R.g1);
            const float bs = wave_incl_scan_add(lf, lane), a = ig - bs, amax = wave_max(a);
            ((float*)(ws + WS_MA))[(size_t)(b * MH + h) * SEQ + c * CH + lane] = a;
            ((float*)(ws + WS_MB))[(size_t)(b * MH + h) * SEQ + c * CH + lane] = bs;
            LW[lane] = __expf(a - amax);
            if (lane == 63) { float* sc = (float*)(ws + WS_MSC); sc[uidx] = amax; sc[BATCH * MH * NCH + uidx] = bs; }
        } else if (wave <= 2) {
            const int fh = 2 * h + (wave - 1);
            const float lf = log_sigmoid_f(R.g0) * LOG2E;
            const float cs = wave_incl_scan_add(lf, lane);
            ((float*)(ws + WS_FCS))[(size_t)(b * FH + fh) * SEQ + c * CH + lane] = cs;
            if (lane == 63) ((float*)(ws + WS_FCT))[(b * FH + fh) * NCH + c] = cs;
        }
#pragma unroll
        for (int j = 0; j < 3; ++j) { const int d = 8 * (3 - j); const bool take = (tt & 7) >= 3 - j;
            v4u sq, sk; sq.x = __shfl_up(R.xq[3].x, d); sq.y = __shfl_up(R.xq[3].y, d); sq.z = __shfl_up(R.xq[3].z, d); sq.w = __shfl_up(R.xq[3].w, d);
            sk.x = __shfl_up(R.xk[3].x, d); sk.y = __shfl_up(R.xk[3].y, d); sk.z = __shfl_up(R.xk[3].z, d); sk.w = __shfl_up(R.xk[3].w, d);
            if (take) { R.xq[j] = sq; R.xk[j] = sk; } }
        v4u wq, wk;
        {
            float q[8], k[8];
#pragma unroll
            for (int part = 0; part < 2; ++part) {
                float accv[8];
#pragma unroll
                for (int e = 0; e < 8; ++e) accv[e] = cbv[part][e >> 2][e & 3];
#pragma unroll
                for (int j = 0; j < 4; ++j) {
                    const v4u w = part ? R.xk[j] : R.xq[j];
                    const f32x4 w0 = cwv[part][j][0], w1 = cwv[part][j][1];
                    accv[0] += w0.x * pg8::bf_lo(w.x); accv[1] += w0.y * pg8::bf_hi(w.x); accv[2] += w0.z * pg8::bf_lo(w.y); accv[3] += w0.w * pg8::bf_hi(w.y);
                    accv[4] += w1.x * pg8::bf_lo(w.z); accv[5] += w1.y * pg8::bf_hi(w.z); accv[6] += w1.z * pg8::bf_lo(w.w); accv[7] += w1.w * pg8::bf_hi(w.w);
                }
#pragma unroll
                for (int e = 0; e < 8; ++e) { const float sv = accv[e] * pg8::sigmoid_f(accv[e]); if (part == 0) q[e] = sv; else k[e] = sv * 0.125f; }
            }
            bf16* qk = (bf16*)(ws + WS_QK) + (size_t)(tok0 + tt) * 512;
            wq.x = pk2(q[0], q[1]); wq.y = pk2(q[2], q[3]); wq.z = pk2(q[4], q[5]); wq.w = pk2(q[6], q[7]);
            wk.x = pk2(k[0], k[1]); wk.y = pk2(k[2], k[3]); wk.z = pk2(k[4], k[5]); wk.w = pk2(k[6], k[7]);
            *(v4u*)(qk + 64 * h + 8 * cg) = wq; *(v4u*)(qk + 256 + 64 * h + 8 * cg) = wk;
        }
        LDS_WAIT(); __syncthreads();
        if (M1_STAGE && uprev >= 0) M1_FLUSH(uprev);
        {
            const float wgt = LW[tt]; const int pos = swap23(tt);
            const int pcol = (((pos >> 3) ^ cg) << 3) + (pos & 7);
#if !M1_SWZ
#define pcol pos
#endif
            const unsigned kw[4] = {wk.x, wk.y, wk.z, wk.w};
#pragma unroll
            for (int e = 0; e < 8; ++e) { const float kv = (e & 1) ? pg8::bf_hi(kw[e >> 1]) : pg8::bf_lo(kw[e >> 1]); LKT[(8 * cg + e) * LP + pcol] = (bf16)f2bf(kv * wgt); }
            const unsigned vw[8] = {R.v0.x, R.v0.y, R.v0.z, R.v0.w, R.v1.x, R.v1.y, R.v1.z, R.v1.w};
#pragma unroll
            for (int e = 0; e < 16; ++e) LVT[(16 * cg + e) * LP + pcol] = (bf16)((e & 1) ? (vw[e >> 1] >> 16) : (vw[e >> 1] & 0xffffu));
#if !M1_SWZ
#undef pcol
#endif
        }
        LDS_WAIT(); __syncthreads();
        if (u + F.G < NU) m1_load(F, u + F.G, R);
        {
            const int r = lane & 31, hi = lane >> 5, dvt = wave >> 1, dkt = wave & 1;
            f32x16 acc = {};
#pragma unroll
            for (int ks = 0; ks < 4; ++ks) {
                const bf16x8 av = *(const LAS bf16x8*)(LVT + (32 * dvt + r) * LP + (((2 * ks + hi) ^ (M1_SWZ ? ((2 * dvt + (r >> 4)) & 7) : 0)) << 3));
                const bf16x8 bk = *(const LAS bf16x8*)(LKT + (32 * dkt + r) * LP + (((2 * ks + hi) ^ (M1_SWZ ? ((4 * dkt + (r >> 3)) & 7) : 0)) << 3));
                acc = MFMA32(av, bk, acc);
            }
            if (M1_STAGE) {
#pragma unroll
                for (int rg = 0; rg < 16; ++rg) LDC[(32 * dvt + crow16(rg, hi)) * LP + 32 * dkt + r] = (bf16)f2bf(acc[rg]);
                uprev = uidx;
            } else {
            bf16* dst = (bf16*)(ws + WS_CST) + (size_t)uidx * (MDV * MDK) + 32 * dkt + r;
#pragma unroll
            for (int rg = 0; rg < 16; ++rg) if (!(M1_SKIP & 1) || F.dupi == 0) dst[(size_t)(32 * dvt + crow16(rg, hi)) * MDK] = (bf16)f2bf(acc[rg]);
            }
            if (wave == 0) {
                float sacc = 0.f;
#pragma unroll
                for (int j = 0; j < 8; ++j) { const v4u w = *(const LAS v4u*)(LKT + lane * LP + 8 * j);
                    sacc += (pg8::bf_lo(w.x) + pg8::bf_hi(w.x)) + (pg8::bf_lo(w.y) + pg8::bf_hi(w.y)) + (pg8::bf_lo(w.z) + pg8::bf_hi(w.z)) + (pg8::bf_lo(w.w) + pg8::bf_hi(w.w)); }
                ((float*)(ws + WS_MDN))[(size_t)uidx * 64 + lane] = sacc;
            }
        }
        LDS_WAIT();
    }
    __syncthreads();
    if (M1_STAGE && uprev >= 0) { const Tc tc = get_tc(); const int tid = tc.tid; M1_FLUSH(uprev); }
#undef M1_FLUSH
}

__device__ __forceinline__ void m2_phase(Frame& F) {
    unsigned char* ws = F.ws; const Tc tc = get_tc(); const int tid = tc.tid;
    const float* sc = (const float*)(ws + WS_MSC); float* mstv = (float*)(ws + WS_MSC) + 2 * BATCH * MH * NCH;
    if (tid < 256) {
    for (int job = F.vcu; job < BATCH * MH * 8; job += F.G) {
        const int bh = job >> 3, part = job & 7;
        v2u* cst = (v2u*)((unsigned*)(ws + WS_CST) + (size_t)bh * NCH * (MDV * MDK / 2) + part * 512) + tid;
        float* dn = (float*)(ws + WS_MDN) + (size_t)bh * NCH * 64 + tid;
        float c0 = 0.f, c1 = 0.f, c2 = 0.f, c3 = 0.f, nn = 0.f, mst = 0.f;
        const bool do_n = (part == 0 && tid < 64), do_m = (part == 1 && tid == 0);
        v2u wv[NCH]; float dv[NCH];
        const float amaxv = sc[bh * NCH + tc.lane], blastv = sc[BATCH * MH * NCH + bh * NCH + tc.lane];
#pragma unroll
        for (int c = 0; c < NCH; ++c) { wv[c] = cst[(size_t)c * (MDV * MDK / 4)]; dv[c] = do_n ? dn[c * 64] : 0.f; }
#pragma unroll
        for (int c = 0; c < NCH; ++c) {
            const float amax = rl(amaxv, c), blast = rl(blastv, c);
            const float mu = fmaxf(mst, amax), d1 = __expf(mst - mu), d2 = __expf(amax - mu);
            if (do_m) mstv[bh * NCH + c] = mst;
            const v2u w = wv[c];
            c0 = d1 * c0 + d2 * pg8::bf_lo(w.x); c1 = d1 * c1 + d2 * pg8::bf_hi(w.x); c2 = d1 * c2 + d2 * pg8::bf_lo(w.y); c3 = d1 * c3 + d2 * pg8::bf_hi(w.y);
            cst[(size_t)c * (MDV * MDK / 4)] = (v2u){pk2(c0, c1), pk2(c2, c3)};
            if (do_n) { nn = d1 * nn + d2 * dv[c]; dn[c * 64] = nn; }
            mst = blast + mu;
        }
    }
    }
    if (F.vcu == 0 && tc.wave >= 4) {
#pragma unroll 1
        for (int gh = 2 * (tc.wave - 4); gh < 2 * (tc.wave - 4) + 2 && gh < BATCH * FH; ++gh) {
            const float tot = ((const float*)(ws + WS_FCT))[gh * NCH + tc.lane];
            const float incl = wave_incl_scan_add(tot, tc.lane), excl = incl - tot;
            float* cs = (float*)(ws + WS_FCS) + (size_t)gh * SEQ;
            float cv[NCH];
#pragma unroll
            for (int c = 0; c < NCH; ++c) cv[c] = cs[c * CH + tc.lane];
#pragma unroll
            for (int c = 0; c < NCH; ++c) cs[c * CH + tc.lane] = cv[c] + rl(excl, c);
        }
    }
}

#ifdef M1_SWZ_UNUSED
#endif
struct M3In { v4u q, k, v0, v1, c0, c1, o0; float a, bs, mst, np; };
__device__ __forceinline__ void m3_load(Frame& F, int u, M3In& R) {
    const Tc tc = get_tc(); const int tid = tc.tid, lane = tc.lane, wave = tc.wave;
    const int h = u & 3, c = (u >> 2) & 63, b = u >> 8, tok0 = b * SEQ + c * CH, uidx = (b * MH + h) * NCH + c, tt = tid >> 3, cg = tid & 7;
    unsigned char* ws = F.ws;
    const bf16* qk = (const bf16*)(ws + WS_QK) + (size_t)(tok0 + tt) * 512;
    R.q = *(const v4u*)(qk + 64 * h + 8 * cg); R.k = *(const v4u*)(qk + 256 + 64 * h + 8 * cg);
    const bf16* mv = (const bf16*)(ws + WS_SEG0 + 32 * AMiB) + (size_t)(tok0 + tt) * 512 + 128 * h + 16 * cg;
    R.v0 = *(const v4u*)mv; R.v1 = *(const v4u*)(mv + 8);
    const unsigned char* mo = (const unsigned char*)(ws + WS_SEG0 + 64 * AMiB) + (size_t)(tok0 + tt) * 512 + 128 * h + 16 * cg;
    R.o0 = *(const v4u*)mo;
    const int dv = tid >> 2, c16 = (tid & 3) * 16;
    R.c0 = (v4u){0u, 0u, 0u, 0u}; R.c1 = (v4u){0u, 0u, 0u, 0u};
    if (c > 0) { const bf16* cp = (const bf16*)(ws + WS_CST) + (size_t)(uidx - 1) * (MDV * MDK) + dv * MDK + c16; R.c0 = *(const v4u*)cp; R.c1 = *(const v4u*)(cp + 8); }
    R.a = 0.f; R.bs = 0.f; R.mst = 0.f; R.np = 0.f;
    if (wave == 0) {
        R.a = ((const float*)(ws + WS_MA))[(size_t)(b * MH + h) * SEQ + c * CH + lane];
        R.bs = ((const float*)(ws + WS_MB))[(size_t)(b * MH + h) * SEQ + c * CH + lane];
        R.mst = ((const float*)(ws + WS_MSC))[2 * BATCH * MH * NCH + uidx];
        R.np = (c > 0) ? ((const float*)(ws + WS_MDN))[(size_t)(uidx - 1) * 64 + lane] : 0.f;
    }
}
#ifndef M3_SKIP
#define M3_SKIP 0
#endif
#ifndef M3_DYNAMIC
#define M3_DYNAMIC 1
#endif
__device__ __forceinline__ void m3_phase(Frame& F, int reps) {
    constexpr int NU = BATCH * NCH * MH;
    unsigned char* ws = F.ws; LAS unsigned char* L = F.lds;
    LAS bf16* LQ = (LAS bf16*)(L);
    LAS bf16* LK = (LAS bf16*)(L + 9216);
    LAS bf16* LVT = (LAS bf16*)(L + 18432);
    LAS bf16* LCT = (LAS bf16*)(L + 36864);
    LAS float* LH = (LAS float*)(L + 55296);
    LAS float* LSC = (LAS float*)(L + 89088);
    const bool dyn = (M3_DYNAMIC != 0) && reps == 1 && F.G * 8 == NU;
    volatile LAS unsigned* qslot = F.MISC + 40;
    unsigned* qctr = (unsigned*)(F.ctl + CW_M3Q);
    for (int rp = 0; rp < reps; ++rp) {
    int u = F.vcu; if (u >= NU) return;
    int un = u + F.G;
    M3In R; m3_load(F, u, R);
    f32x4 gnv[4]; int hcur = -1;
#pragma unroll 1
    for (; u < NU; ) {
        const Tc tc = get_tc(); const int tid = tc.tid, lane = tc.lane, wave = tc.wave;
        unsigned qa = 0u; if (dyn && tid == 0) qa = __hip_atomic_fetch_add(qctr, 1u, RLX_AGENT);
        const int sk = (rp > 0) ? M3_SKIP : 0;
        const int h = u & 3, c = (u >> 2) & 63, b = u >> 8, tok0 = b * SEQ + c * CH, tt = tid >> 3, cg = tid & 7;
        if (h != hcur) { hcur = h; const float* gp = F.A->in[13] + 128 * h + 16 * cg;
#pragma unroll
            for (int j = 0; j < 4; ++j) gnv[j] = *(const f32x4*)(gp + 4 * j); }
        LAS float* LWS = (LAS float*)(L + 89088 + 2048) + wave * 64;
        const v4u mo0 = R.o0;
        {
            if (!(sk & 64)) { *(LAS v4u*)(LQ + tt * LP + 8 * cg) = R.q; *(LAS v4u*)(LK + tt * LP + 8 * cg) = R.k; }
            const unsigned vw[8] = {R.v0.x, R.v0.y, R.v0.z, R.v0.w, R.v1.x, R.v1.y, R.v1.z, R.v1.w}; const int pos = swap23(tt);
            const int pcol = (((pos >> 3) ^ cg) << 3) + (pos & 7);
#pragma unroll
            for (int e = 0; e < 16; ++e) if (!(sk & 1)) LVT[(16 * cg + e) * LP + pcol] = (bf16)((e & 1) ? (vw[e >> 1] >> 16) : (vw[e >> 1] & 0xffffu));
            const int dv = tid >> 2, c16 = (tid & 3) * 16;
            if (!(sk & 64)) { *(LAS v4u*)(LCT + dv * LP + c16) = R.c0; *(LAS v4u*)(LCT + dv * LP + c16 + 8) = R.c1; }
            if (wave == 0) {
                const float mu = fmaxf(R.mst, wave_incl_scan_max(R.a, lane));
                LSC[lane] = R.a; LSC[64 + lane] = mu; LSC[128 + lane] = __expf(R.mst - mu); LSC[192 + lane] = __expf(-(R.bs + mu)); LSC[256 + lane] = R.np;
            }
        }
        LDS_WAIT(); __syncthreads();
        if (un < NU && !(sk & 32)) m3_load(F, un, R);
        {
            const int r = lane & 31, hi = lane >> 5, ti = wave >> 2, dvj = wave & 3;
            const int t = 32 * ti + r;
            const float mu_t = LSC[64 + t], inter_t = LSC[128 + t], emt_t = LSC[192 + t];
            float qn = 0.f;
#pragma unroll
            for (int j = 0; j < 4; ++j) if (!(sk & 128)) { const v4u w = *(const LAS v4u*)(LQ + t * LP + 32 * hi + 8 * j); const f32x4 n0 = *(const LAS f32x4*)(LSC + 256 + 32 * hi + 8 * j), n1 = *(const LAS f32x4*)(LSC + 256 + 32 * hi + 8 * j + 4);
                qn += pg8::bf_lo(w.x) * n0.x + pg8::bf_hi(w.x) * n0.y + pg8::bf_lo(w.y) * n0.z + pg8::bf_hi(w.y) * n0.w + pg8::bf_lo(w.z) * n1.x + pg8::bf_hi(w.z) * n1.y + pg8::bf_lo(w.w) * n1.z + pg8::bf_hi(w.w) * n1.w; }
            qn = half_sum(qn);
            bf16x8 qf[4];
#pragma unroll
            for (int ks = 0; ks < 4; ++ks) qf[ks] = *(const LAS bf16x8*)(LQ + t * LP + 16 * ks + 8 * hi);
            f32x16 z1 = {}, z2 = {}; float den = 0.f;
#pragma unroll
            for (int si = 0; si < 2; ++si) {
                if (si <= ti && !(sk & 2)) {
                    f32x16 x = {};
#pragma unroll
                    for (int ks = 0; ks < 4; ++ks) { const bf16x8 kf = *(const LAS bf16x8*)(LK + (32 * si + r) * LP + 16 * ks + 8 * hi); x = MFMA32(kf, qf[ks], x); }
#pragma unroll
                    for (int g = 0; g < 4; ++g) { const f32x4 av = *(const LAS f32x4*)(LSC + 32 * si + 8 * g + 4 * hi);
#pragma unroll
                        for (int e = 0; e < 4; ++e) { const int sidx = 32 * si + 8 * g + 4 * hi + e; const float w = (sidx <= t) ? __expf(fminf(av[e] - mu_t, 0.f)) : 0.f; const float pp = x[4 * g + e] * w; x[4 * g + e] = pp; den += pp; } }
#pragma unroll
                    for (int k2 = 0; k2 < 2; ++k2) {
                        v4u pw; pw.x = pk2(x[8 * k2 + 0], x[8 * k2 + 1]); pw.y = pk2(x[8 * k2 + 2], x[8 * k2 + 3]); pw.z = pk2(x[8 * k2 + 4], x[8 * k2 + 5]); pw.w = pk2(x[8 * k2 + 6], x[8 * k2 + 7]);
                        const bf16x8 vf = *(const LAS bf16x8*)(LVT + (32 * dvj + r) * LP + (((4 * si + 2 * k2 + hi) ^ ((2 * dvj + (r >> 4)) & 7)) << 3));
                        z1 = MFMA32(__builtin_bit_cast(bf16x8, pw), vf, z1);
                    }
                }
            }
#pragma unroll
            for (int ks = 0; ks < 4; ++ks) if (!(sk & 4)) { const bf16x8 cf = *(const LAS bf16x8*)(LCT + (32 * dvj + r) * LP + 16 * ks + 8 * hi); z2 = MFMA32(qf[ks], cf, z2); }
            den = half_sum(den);
            den += inter_t * qn;
            const float rden = __builtin_amdgcn_rcpf(fmaxf(fabsf(den), emt_t));
            if (hi == 0) { LWS[r] = inter_t; LWS[32 + r] = rden; }
            LDS_WAIT();
#pragma unroll
            for (int g = 0; g < 4; ++g) { const f32x4 iv = *(const LAS f32x4*)(LWS + 8 * g + 4 * hi), rv = *(const LAS f32x4*)(LWS + 32 + 8 * g + 4 * hi);
#pragma unroll
                for (int e = 0; e < 4; ++e) if (!(sk & 256)) LH[(32 * ti + 8 * g + 4 * hi + e) * 132 + 32 * dvj + r] = (z1[4 * g + e] + iv[e] * z2[4 * g + e]) * rv[e]; }
        }
        if (dyn && tid == 0) qslot[0] = 2u * (unsigned)F.G + qa;
        LDS_WAIT(); __syncthreads();
        const int un2 = dyn ? __builtin_amdgcn_readfirstlane((int)qslot[0]) : un + F.G;
        if (!(sk & 8)) {
            float v[16]; float sm = 0.f;
#pragma unroll
            for (int j = 0; j < 4; ++j) { const f32x4 x = *(const LAS f32x4*)(LH + tt * 132 + 16 * cg + 4 * j); v[4 * j] = x.x; v[4 * j + 1] = x.y; v[4 * j + 2] = x.z; v[4 * j + 3] = x.w; sm += (x.x + x.y) + (x.z + x.w); }
            sm += dppf<DPP_XOR1>(sm, sm); sm += dppf<DPP_XOR2>(sm, sm); sm += dppf<DPP_HMIRROR>(sm, sm);
            const float mean = sm * (1.f / MDV); float q = 0.f;
#pragma unroll
            for (int e = 0; e < 16; ++e) { v[e] -= mean; q += v[e] * v[e]; }
            q += dppf<DPP_XOR1>(q, q); q += dppf<DPP_XOR2>(q, q); q += dppf<DPP_HMIRROR>(q, q);
            const float rstd = __builtin_amdgcn_rsqf(q * (1.f / MDV) + EPS);
            const float gn[16] = {gnv[0].x, gnv[0].y, gnv[0].z, gnv[0].w, gnv[1].x, gnv[1].y, gnv[1].z, gnv[1].w, gnv[2].x, gnv[2].y, gnv[2].z, gnv[2].w, gnv[3].x, gnv[3].y, gnv[3].z, gnv[3].w};
            const unsigned ow[4] = {mo0.x, mo0.y, mo0.z, mo0.w};
            unsigned res[8];
#pragma unroll
            for (int e = 0; e < 8; ++e) { const unsigned od = ow[e >> 1] >> (16 * (e & 1)); const float g0 = (float)(od & 0xffu) * (1.0f / 255.0f), g1 = (float)((od >> 8) & 0xffu) * (1.0f / 255.0f);
                const float y0 = v[2 * e] * rstd * gn[2 * e] * g0, y1 = v[2 * e + 1] * rstd * gn[2 * e + 1] * g1; res[e] = pk2(y0, y1); }
            bf16* ya = (bf16*)(ws + WS_XN) + (size_t)(tok0 + tt) * 1024 + 128 * h + 16 * cg;
            if (rp == 0 || M3_SKIP == 0) { *(v4u*)ya = (v4u){res[0], res[1], res[2], res[3]}; *(v4u*)(ya + 8) = (v4u){res[4], res[5], res[6], res[7]}; }
        }
        LDS_WAIT();
        u = un; un = un2;
    }
    __syncthreads();
    }
}
#ifndef MK_N_LAUNCHES
#define MK_N_LAUNCHES 1
#endif
constexpr int NPHASE = 16;
#ifndef FOX_MARGIN
#define FOX_MARGIN 32.0f
#endif
#ifndef ALIGN2
#define ALIGN2 true
#endif
#ifndef FOX_THR
#define FOX_THR 24
#endif
#ifndef REV2
#define REV2 0
#endif
#ifndef FOX_PRE
#define FOX_PRE 1
#endif
#ifndef TEAM_FAST
#define TEAM_FAST 1
#endif

__device__ __forceinline__ void p7_mixer(Frame& F) {
    unsigned char* ws = F.ws;
    const fox_body::bf16* FQ = (const fox_body::bf16*)(ws + WS_SEG0 + 96 * AMiB);
    const fox_body::bf16* FK = (const fox_body::bf16*)(ws + WS_SEG0 + 128 * AMiB);
    const fox_body::bf16* FV = (const fox_body::bf16*)(ws + WS_SEG0 + 160 * AMiB);
    fox_body::bf16* YB = (fox_body::bf16*)(ws + WS_XN);
#ifndef DUP_FOX
#define DUP_FOX 0
#endif
#ifndef DUP_M3
#define DUP_M3 0
#endif
#ifndef NO_FOX
    for (int rf_ = 0; rf_ <= DUP_FOX; ++rf_)
    for (int job = F.vcu; job < BATCH * 32; job += F.G) {
        const int b = job >> 5, r = job & 31, f = r & 3, j = r >> 2;
        int t0s[4]; float xbs[4];
        { const Tc tc = get_tc();
#pragma unroll
          for (int i = 0; i < 4; ++i) { const int fh = (i & 1) ? 7 - f : f, qb = (i & 2) ? 15 - j : j; const int bh = b * FH + fh;
            const unsigned* nr = (const unsigned*)(F.ctl + CW_NRM) + bh * 4;
            const float xb = 1.02f * (sqrtf(__uint_as_float(xb_ld((unsigned*)nr)) * __uint_as_float(xb_ld((unsigned*)nr + 2))) + sqrtf(__uint_as_float(xb_ld((unsigned*)nr + 1)) * __uint_as_float(xb_ld((unsigned*)nr + 3))));
            xbs[i] = fminf(xb, 48.0f);     t0s[i] = fox_body::fox_t0((const float*)(ws + WS_FCS) + (size_t)bh * SEQ, qb, 2.0f * xb + FOX_MARGIN, tc.lane); } }
        const int t0a = t0s[0], t0b = t0s[1], t0c = t0s[2], t0d = t0s[3]; const float xba = xbs[0], xbb = xbs[1], xbc = xbs[2], xbd = xbs[3];
#pragma unroll 1
        for (int i = 0; i < 4; ++i) { const int fh = (i & 1) ? 7 - f : f, qb = (i & 2) ? 15 - j : j; const int bh = b * FH + fh;
            const float* cs = (const float*)(ws + WS_FCS) + (size_t)bh * SEQ;
            const int in_ = i + 1, fhn = (in_ & 1) ? 7 - f : f, t0n = (in_ == 1) ? t0b : (in_ == 2) ? t0c : t0d;
            const fox_body::bf16* nK = (FOX_PRE && in_ < 4) ? FK + ((size_t)b * SEQ + (size_t)t0n * 64) * 512 + 64 * fhn : nullptr;
            const fox_body::bf16* nV = (FOX_PRE && in_ < 4) ? FV + ((size_t)b * SEQ + (size_t)t0n * 64) * 512 + 64 * fhn : nullptr;
            fox_body::attn_unit<FOX_THR>(b, fh, qb, FQ, FK, FV, YB, 512 + 64 * fh, cs, (i == 0) ? t0a : (i == 1) ? t0b : (i == 2) ? t0c : t0d, (char*)F.lds, (i == 0) ? xba : (i == 1) ? xbb : (i == 2) ? xbc : xbd, FOX_PRE && i > 0, nK, nV); }
    }
#endif
    __syncthreads();
#ifndef NO_M3
    m3_phase(F, 1 + DUP_M3);
#endif
}

__global__ void __launch_bounds__(NWAVES * 64, 2) mega_fwd(Args args) {
    extern __shared__ __attribute__((aligned(16))) unsigned char lds[];
    Frame F;
    F.lds = (LAS unsigned char*)lds;
    F.MISC = (volatile LAS unsigned*)(F.lds + MISC_OFF);
    { const int bx = blockIdx.x; F.GG = gridDim.x; F.G = F.GG / NTEAM; F.dupi = 0; F.team = bx % NTEAM; F.vcu = bx / NTEAM; F.gv = F.team * F.G + F.vcu; F.fast = 0; }
    F.wg = args.ws; F.ws = args.ws + WS_TEAM0 + (size_t)F.team * WS_TEAM_STRIDE;
    F.x = args.in[0] + (size_t)F.team * SEQ * DM; F.p = args.in[1] + (size_t)F.team * SEQ * 256; F.out = args.out + (size_t)F.team * SEQ * DM;
    F.A = &args;
    F.gctl = (gu32*)(F.wg + WS_CTL); F.ctl = F.gctl + CW_TEAM0 + F.team * CW_TEAM_STRIDE;
    if (threadIdx.x == 0) (void)__hip_atomic_fetch_or((unsigned*)(F.gctl + CW_XOK) + F.team, 1u << xb_xcc_id(), RLX_AGENT);
    for (int u = threadIdx.x; u < (LDS_BYTES - LDSCTL_OFF) / 4; u += NWAVES * 64) ((LAS unsigned*)(F.lds + LDSCTL_OFF))[u] = 0u;
    __syncthreads();
    const int lo = args.ph_lo, hi = args.ph_hi;
    const bool use_bar = (hi - lo) > 1;
    XcdBarrier bar; bar.bar = (unsigned*)(F.gctl + CW_BAR); bar.x = 0; bar.st = nullptr;
    if (use_bar) bar = xcd_barrier_post((unsigned*)(F.gctl + CW_BAR), F.MISC + 8);
#ifndef PHMASK
#define PHMASK 0xffff
#endif
#define IN(k) (((PHMASK >> (k)) & 1) && lo <= (k) && (k) < hi)
#ifndef DUP_PHASE
#define DUP_PHASE -1
#endif
#ifndef DUP_N
#define DUP_N 1
#endif
#define REPS(k) (((k) == DUP_PHASE) ? 1 + DUP_N : 1)
#ifndef XBAR
#define XBAR 0
#endif
#define SEAM(k) do { if ((IN(k) && IN((k) + 1)) || rep_ + 1 < REPS(k)) { \
        if ((k) == 0) { xcd_barrier(bar); if (threadIdx.x == 0) { unsigned ok_ = 1u; for (int t_ = 0; t_ < NTEAM; ++t_) { const unsigned m_ = xb_ld((unsigned*)(F.gctl + CW_XOK) + t_); ok_ &= (m_ != 0u && (m_ & (m_ - 1u)) == 0u) ? 1u : 0u; } F.MISC[44] = ok_; } __syncthreads(); F.fast = TEAM_FAST ? __builtin_amdgcn_readfirstlane((int)F.MISC[44]) : 0; } \
        else team_barrier((unsigned*)F.ctl, (unsigned*)(F.gctl + CW_BAR), (unsigned)F.G, F.fast, tbk); \
        for (int xb_ = 0; xb_ < XBAR; ++xb_) team_barrier((unsigned*)F.ctl, (unsigned*)(F.gctl + CW_BAR), (unsigned)F.G, F.fast, tbk); } } while (0)
    unsigned char* ws = F.ws; unsigned char* wg = F.wg; unsigned tbk = 0u;
    bf16* XN = (bf16*)(ws + WS_XN); bf16* Y = (bf16*)(ws + WS_Y); bf16* H = (bf16*)(ws + WS_H);
    const int cid = F.vcu;

#ifdef CLK_PHASE
    unsigned long long ck_t0 = 0, ck_r0 = 0;
#define CKB(k) do { if ((k) == CLK_PHASE && blockIdx.x == 0 && threadIdx.x == 0) { ck_t0 = __builtin_amdgcn_s_memtime(); ck_r0 = __builtin_amdgcn_s_memrealtime(); } } while (0)
#define CKE(k) do { if ((k) == CLK_PHASE && blockIdx.x == 0 && threadIdx.x == 0) { const unsigned long long t1 = __builtin_amdgcn_s_memtime(), r1 = __builtin_amdgcn_s_memrealtime(); \
        const float v = (CLK_MODE == 0) ? (float)(t1 - ck_t0) / (float)(r1 - ck_r0) : (CLK_MODE == 1) ? (float)(r1 - ck_r0) * 0.01f * CLK_SCALE : (float)CLK_SCALE; __hip_atomic_store((float*)(F.gctl + CW_DBG), CLK_Q * floorf(v / CLK_Q + 0.5f), RLX_AGENT); } } while (0)
#else
#define CKB(k) do {} while (0)
#define CKE(k) do {} while (0)
#endif
    if (IN(0)) for (int rep_ = 0; rep_ < REPS(0); ++rep_) { CKB(0); p0_prologue(F); CKE(0); SEAM(0); }
    if (IN(1)) for (int rep_ = 0; rep_ < REPS(1); ++rep_) { CKB(1);
        pg8::Gemm g{XN, (const bf16*)(wg + WS_W1GU), DM, DM, DM, 256, 256}; pg8::StaticOrder S; S.init(TOK, 2 * DFF, F.G, cid, 0, 0);
        pg8::EpiSwiGLU E{(const float*)(ws + WS_RMS), H};
        pg8::gemm_phase<pg8::EpiSwiGLU, pg8::StaticOrder, true>(F.lds + RING_OFF, g, S, E); CKE(1); SEAM(1); }
    if (IN(2)) for (int rep_ = 0; rep_ < REPS(2); ++rep_) { CKB(2);
        pg8::Gemm g{H, (const bf16*)(wg + WS_W1D), 128, 128, DFF, (size_t)TOK * 256, (size_t)DM * 256}; pg8::StaticOrder S; S.init(TOK, DM, F.G, cid, 0, 0);
        pg8::EpiBf16 E{Y, DM};
        pg8::gemm_phase<pg8::EpiBf16, pg8::StaticOrder, ALIGN2>(F.lds + RING_OFF, g, S, E); CKE(2); SEAM(2); }
    if (IN(3)) for (int rep_ = 0; rep_ < REPS(3); ++rep_) { CKB(3); ew_phase<2, true, 1, true>(F, Y, XN, F.out, 0.5f, args.in[6], nullptr, nullptr, nullptr, nullptr, (float*)(ws + WS_RMS));     CKE(3); SEAM(3); }
    if (IN(4)) for (int rep_ = 0; rep_ < REPS(4); ++rep_) { CKB(4);
        pg8::Gemm g{(const bf16*)F.out, (const bf16*)(wg + WS_WIN), DM, DM, DM, 256, 256}; pg8::StaticOrder S; S.init(TOK, NWIN, F.G, cid, 0, 0);
        pg8::EpiWin E{(const float*)(ws + WS_RMS), (bf16*)(ws + WS_SEG0), (bf16*)(ws + WS_GA), (bf16*)(ws + WS_GB), args.in[15], QC2, (unsigned*)(F.ctl + CW_NRM)};
        pg8::gemm_phase<pg8::EpiWin, pg8::StaticOrder, true>(F.lds + RING_OFF, g, S, E); CKE(4); SEAM(4); }
    if (IN(5)) for (int rep_ = 0; rep_ < REPS(5); ++rep_) { CKB(5); F.dupi = rep_; m1_phase(F); CKE(5); SEAM(5); }
    if (IN(6)) for (int rep_ = 0; rep_ < REPS(6); ++rep_) { CKB(6); m2_phase(F); CKE(6); SEAM(6); }
    if (IN(7)) for (int rep_ = 0; rep_ < REPS(7); ++rep_) { CKB(7); p7_mixer(F); CKE(7); SEAM(7); }
    if (IN(8)) for (int rep_ = 0; rep_ < REPS(8); ++rep_) { CKB(8);
        pg8::Gemm g{XN, (const bf16*)(wg + WS_WAB), DM, DM, DM, 256, 256}; pg8::StaticOrder S; S.init(TOK, DM, F.G, cid, 0, 0);
        pg8::EpiMerge E{Y, (const bf16*)(ws + WS_GA), (const bf16*)(ws + WS_GB)};
        pg8::gemm_phase<pg8::EpiMerge, pg8::StaticOrder, ALIGN2>(F.lds + RING_OFF, g, S, E); CKE(8); SEAM(8); }
    if (IN(9)) for (int rep_ = 0; rep_ < REPS(9); ++rep_) { CKB(9);
        pg8::Gemm g{Y, (const bf16*)(wg + WS_WOUT), DM, DM, DM, 256, 256}; pg8::StaticOrder S; S.init(TOK, DM, F.G, cid, 0, 0);
        pg8::EpiBf16 E{XN, DM};
        pg8::gemm_phase<pg8::EpiBf16, pg8::StaticOrder, ALIGN2>(F.lds + RING_OFF, g, S, E); CKE(9); SEAM(9); }
    if (IN(10)) for (int rep_ = 0; rep_ < REPS(10); ++rep_) { CKB(10); ew_phase<2, false, 1, true>(F, XN, F.out, F.out, 1.0f, args.in[19], nullptr, nullptr, nullptr, nullptr, (float*)(ws + WS_RMS));     CKE(10); SEAM(10); }
    if (IN(11)) for (int rep_ = 0; rep_ < REPS(11); ++rep_) { CKB(11);
        pg8::Gemm g{(const bf16*)F.out, (const bf16*)(wg + WS_W2GU), DM, DM, DM, 256, 256}; pg8::StaticOrder S; S.init(TOK, 2 * DFF, F.G, cid, 0, 0);
        pg8::EpiSwiGLU E{(const float*)(ws + WS_RMS), H};
        pg8::gemm_phase<pg8::EpiSwiGLU, pg8::StaticOrder, true>(F.lds + RING_OFF, g, S, E); CKE(11); SEAM(11); }
    if (IN(12)) for (int rep_ = 0; rep_ < REPS(12); ++rep_) { CKB(12);
        pg8::Gemm g{H, (const bf16*)(wg + WS_W2D), 128, 128, DFF, (size_t)TOK * 256, (size_t)DM * 256}; pg8::StaticOrder S; S.init(TOK, DM, F.G, cid, 0, 0);
        pg8::EpiBf16 E{XN, DM};
        pg8::gemm_phase<pg8::EpiBf16, pg8::StaticOrder, ALIGN2>(F.lds + RING_OFF, g, S, E); CKE(12); SEAM(12); }
    if (IN(13)) for (int rep_ = 0; rep_ < REPS(13); ++rep_) { CKB(13);
        ew_phase<2, false, 1, true>(F, XN, F.out, H, 0.5f, args.in[24], nullptr, nullptr, nullptr, nullptr, (float*)(ws + WS_RMS), DM * 2, PLE_LD * 2);
        const Tc tc = get_tc(); const int gw = F.vcu * NWAVES + tc.wave, NGW = F.G * NWAVES; bf16* PB = H + DM;
#pragma unroll 4
        for (int m2 = 2 * gw; m2 < TOK; m2 += 2 * NGW) { const int m = m2 + (tc.lane >> 5), c8 = 8 * (tc.lane & 31);
            const float* pr = F.p + (size_t)m * 256 + c8; const f32x4 a = *(const f32x4*)pr, b = *(const f32x4*)(pr + 4);
            *(v4u*)(PB + (size_t)m * PLE_LD + c8) = f32_to_bf8(a, b); }
        CKE(13); SEAM(13); }
    if (IN(14)) for (int rep_ = 0; rep_ < REPS(14); ++rep_) { CKB(14);
        { pg8::Gemm g{H, (const bf16*)(wg + WS_WPG), PLE_LD, PLE_LD, PLE_LD, 256, 256, DM / 64}; pg8::StaticOrder S; S.init(TOK, DM, F.G, cid, 0, 0);
          pg8::EpiPle2 E{(const float*)(ws + WS_RMS), XN, args.in[27]};
          pg8::gemm_phase<pg8::EpiPle2, pg8::StaticOrder, ALIGN2>(F.lds + RING_OFF, g, S, E); }
        CKE(14); SEAM(14); }
    if (IN(15)) for (int rep_ = 0; rep_ < REPS(15); ++rep_) { ew_phase<0, false, 1, false>(F, XN, H, F.out, 1.0f, args.in[29], nullptr, nullptr, nullptr, nullptr, nullptr, PLE_LD * 2);
#ifdef CLK_PHASE
        { xcd_barrier(bar); const float dv = __hip_atomic_load((float*)(F.gctl + CW_DBG), RLX_AGENT); const Tc tc = get_tc(); const int gw = F.vcu * NWAVES + tc.wave, NGW = F.G * NWAVES;
          for (int m = gw; m < TOK; m += NGW) { GAS f32x4* o = (GAS f32x4*)(F.out + (size_t)m * DM) + tc.lane;
#pragma unroll
              for (int j = 0; j < 4; ++j) { f32x4 v = o[64 * j]; v = v + dv; o[64 * j] = v; } } }
#endif
    }
#ifdef EWP_PROBE
    for (int rp = 0; rp < EWP_PROBE; ++rp) { xcd_barrier(bar);
        ew_phase<1, false, 1, true>(F, XN, H, (bf16*)(ws + WS_H + 64 * MiB), 1.0f, args.in[19], args.in[20], (bf16*)(ws + WS_H + 128 * MiB)); }
#endif
#ifdef COPY_PROBE
    for (int rp = 0; rp < COPY_PROBE; ++rp) { xcd_barrier(bar);
        const Tc tc = get_tc(); const size_t nvec = (size_t)128 * MiB / 16; const size_t gtid = (size_t)(F.vcu * NWAVES + tc.wave) * 64 + tc.lane, gsz = (size_t)F.G * NWAVES * 64;
        const v4u* src = (const v4u*)(ws + WS_H + 192 * MiB); v4u* dst = (v4u*)(ws + WS_H + 64 * MiB);
        for (size_t i = gtid; i < nvec; i += gsz * COPY_U) { v4u t[COPY_U];
#pragma unroll
            for (int j = 0; j < COPY_U; ++j) t[j] = src[i + j * gsz];
#pragma unroll
            for (int j = 0; j < COPY_U; ++j) dst[i + j * gsz] = t[j]; } }
#endif
#undef IN
#undef SEAM
}

extern "C" void kernel_launch(void* const* d_in, const int* in_sizes, int n_in, void* d_out, int out_size, void* d_ws, size_t ws_size, hipStream_t stream) {
    static int grid = 0;
    if (grid == 0) {
        if (n_in != 30 || in_sizes[0] != TOKALL * DM || out_size != TOKALL * DM || ws_size < WS_END) { fprintf(stderr, "kernel_launch: unexpected shapes (n_in %d, in0 %d, out %d, ws %zu); nothing launched\n", n_in, n_in > 0 ? in_sizes[0] : -1, out_size, ws_size); grid = -1; return; }
        int dev = 0, cus = 0, per_cu = 0;
        if (hipGetDevice(&dev) != hipSuccess || hipDeviceGetAttribute(&cus, hipDeviceAttributeMultiprocessorCount, dev) != hipSuccess) { grid = -1; return; }
        if (hipFuncSetAttribute((const void*)mega_fwd, hipFuncAttributeMaxDynamicSharedMemorySize, LDS_BYTES) != hipSuccess) { fprintf(stderr, "kernel_launch: hipFuncSetAttribute failed\n"); grid = -1; return; }
        if (hipOccupancyMaxActiveBlocksPerMultiprocessor(&per_cu, (const void*)mega_fwd, NWAVES * 64, LDS_BYTES) != hipSuccess || per_cu < 1) { fprintf(stderr, "kernel_launch: occupancy query reports %d\n", per_cu); }
        (void)hipGetLastError();
        grid = cus - cus % NTEAM;
        if (grid != 256) fprintf(stderr, "kernel_launch: %d CUs (built for 256)\n", grid);
    }
    if (grid < 0) return;
    hipMemsetAsync((char*)d_ws + WS_CTL, 0, CTL_ZERO_BYTES, stream);
    Args a{};
    for (int i = 0; i < 30; ++i) a.in[i] = (const float*)d_in[i];
    a.out = (float*)d_out; a.ws = (unsigned char*)d_ws;
#if MK_N_LAUNCHES == 1
    a.ph_lo = 0; a.ph_hi = NPHASE;
    hipLaunchKernelGGL(mega_fwd, dim3(grid), dim3(NWAVES * 64), LDS_BYTES, stream, a);
#else
    for (int p = 0; p < NPHASE; ++p) { a.ph_lo = p; a.ph_hi = p + 1; hipLaunchKernelGGL(mega_fwd, dim3(grid), dim3(NWAVES * 64), LDS_BYTES, stream, a); }
#endif
}
```
